# Optimizing an MI355X kernel written in HIP

```python
import jax, jax.numpy as jnp
from jax import lax
import numpy as np

D_MODEL = 1024
BATCH = 8
SEQ = 8192
DEPTH = 1

N_META = 16
FOURIER_GROUPS = 4
FOURIER_GROUP_DIM = 128
FOURIER_WIDTH = FOURIER_GROUPS * FOURIER_GROUP_DIM
CONV_HEADS = 8
CONV_HEAD_DIM = 64
CONV_WIDTH = CONV_HEADS * CONV_HEAD_DIM
CONV_TAPS = 3
N_BRANCHES = 2
D_FF = 2816
RMS_EPS = 1e-6
IN_COLS = FOURIER_WIDTH + 3 * CONV_WIDTH + N_BRANCHES * D_MODEL

kernel_name = "hybrid_fourier_shortconv_encoder_block"


def rmsnorm(x, g):
    xf = x.astype(jnp.float32)
    var = jnp.mean(xf * xf, axis=-1, keepdims=True)
    return (xf * lax.rsqrt(var + RMS_EPS) * g.astype(jnp.float32)).astype(x.dtype)


def centred_dwconv(x, w, b):
    half = CONV_TAPS // 2
    L = x.shape[1]
    xp = jnp.pad(x, ((0, 0), (half, half), (0, 0)))
    y = b
    for k in range(CONV_TAPS):
        y = y + xp[:, k:k + L] * w[k]
    return y


def fourier_mix(u):
    bn, L, _ = u.shape
    ug = u.astype(jnp.float32).reshape(bn, L, FOURIER_GROUPS, FOURIER_GROUP_DIM)
    f = jnp.fft.fft2(ug, axes=(1, 3), norm="ortho").real
    return f.reshape(bn, L, FOURIER_WIDTH).astype(u.dtype)


def setup_inputs(seed: int = 0) -> dict:
    key = jax.random.key(seed)
    ks = jax.random.split(key, 20)
    f32 = jnp.float32

    def normal(k, shape, fan_in):
        return jax.random.normal(k, shape, f32) * (fan_in ** -0.5)

    def gain(k, shape):
        return 1.0 + 0.02 * jax.random.normal(k, shape, f32)

    def bias(k, shape):
        return 0.01 * jax.random.normal(k, shape, f32)

    return {
        "x": jax.random.normal(ks[0], (BATCH, SEQ, D_MODEL), f32),
        "meta_tokens": jax.random.normal(ks[1], (N_META, D_MODEL), f32),
        "g_mix_pre": gain(ks[2], (DEPTH, D_MODEL)),
        "w_in": normal(ks[3], (DEPTH, D_MODEL, IN_COLS), D_MODEL),
        "b_gates": bias(ks[4], (DEPTH, N_BRANCHES * D_MODEL)),
        "w_fourier": normal(ks[5], (DEPTH, FOURIER_WIDTH, D_MODEL), FOURIER_WIDTH),
        "conv_w_mix": normal(ks[6], (DEPTH, CONV_TAPS, CONV_WIDTH), CONV_TAPS),
        "conv_b_mix": bias(ks[7], (DEPTH, CONV_WIDTH)),
        "w_conv_out": normal(ks[8], (DEPTH, CONV_WIDTH, D_MODEL), CONV_WIDTH),
        "w_out": normal(ks[9], (DEPTH, D_MODEL, D_MODEL), D_MODEL),
        "g_mix_post": gain(ks[10], (DEPTH, D_MODEL)),
        "g_ffn_pre": gain(ks[11], (DEPTH, D_MODEL)),
        "w_up": normal(ks[12], (DEPTH, D_MODEL, 2 * D_FF), D_MODEL),
        "conv_w_ffn": normal(ks[13], (DEPTH, CONV_TAPS, 2 * D_FF), CONV_TAPS),
        "conv_b_ffn": bias(ks[14], (DEPTH, 2 * D_FF)),
        "w_down": normal(ks[15], (DEPTH, D_FF, D_MODEL), D_FF),
        "g_ffn_post": gain(ks[16], (DEPTH, D_MODEL)),
    }


def reference(x, meta_tokens, g_mix_pre, w_in, b_gates, w_fourier, conv_w_mix, conv_b_mix,
              w_conv_out, w_out, g_mix_post, g_ffn_pre, w_up, conv_w_ffn, conv_b_ffn,
              w_down, g_ffn_post):
    bn = x.shape[0]
    meta = jnp.broadcast_to(meta_tokens[None].astype(x.dtype), (bn, N_META, D_MODEL))
    h_res = jnp.concatenate([meta, x], axis=1)
    L = h_res.shape[1]

    splits = [FOURIER_WIDTH,
              FOURIER_WIDTH + CONV_WIDTH,
              FOURIER_WIDTH + 2 * CONV_WIDTH,
              FOURIER_WIDTH + 3 * CONV_WIDTH]

    for l in range(DEPTH):
        h = rmsnorm(h_res, g_mix_pre[l])
        proj = h @ w_in[l]
        u_a, c_g, b_g, v_b, gate_logits = jnp.split(proj, splits, axis=-1)

        y_a = fourier_mix(u_a) @ w_fourier[l]

        conv_in = c_g * v_b
        y_b = (b_g * centred_dwconv(conv_in, conv_w_mix[l], conv_b_mix[l])) @ w_conv_out[l]

        gates = jax.nn.sigmoid((gate_logits + b_gates[l]).reshape(bn, L, N_BRANCHES, D_MODEL))
        merged = gates[:, :, 0] * y_a + gates[:, :, 1] * y_b
        mix_out = merged @ w_out[l]
        h_res = h_res + rmsnorm(mix_out, g_mix_post[l])

        h2 = rmsnorm(h_res, g_ffn_pre[l])
        up = centred_dwconv(h2 @ w_up[l], conv_w_ffn[l], conv_b_ffn[l])
        a, v = jnp.split(up, 2, axis=-1)
        ffn_out = (jax.nn.gelu(a) * v) @ w_down[l]
        h_res = h_res + rmsnorm(ffn_out, g_ffn_post[l])

    return h_res[:, N_META:]
```

```cpp
#include <hip/hip_runtime.h>
#include <hip/hip_cooperative_groups.h>
#include <cstdio>
#include <cstdint>
namespace cg = cooperative_groups;

constexpr int NB = 8, SEQ = 8192, NMETA = 16, LSEQ = 8208, DM = 1024, DFF = 2816, INC = 4096;
constexpr int R_META = 65536, R_TOT = 65792;
constexpr int KD = 8320;
constexpr int KH = 4352, KHT = 17;
constexpr float RMS_EPS = 1e-6f;
__device__ __forceinline__ int row_of(int b, int pos) { return pos >= NMETA ? b * SEQ + pos - NMETA : R_META + b * NMETA + pos; }

namespace pg8 {
#define PG8_LAS __attribute__((address_space(3)))
typedef unsigned short bf16_t;
typedef short bf16x8 __attribute__((ext_vector_type(8)));
typedef float f32x4 __attribute__((ext_vector_type(4)));
typedef unsigned u32x4 __attribute__((ext_vector_type(4)));
constexpr int BM = 256, BK = 64, HALF = 128, HTB = HALF * BK * 2, STAGE_BYTES = 8 * HTB, NXCD = 8, WGM = 8;

__host__ __device__ __forceinline__ int lds_byte(int r, int c) { const int st = (r >> 4) * 2 + (c >> 5), rr = r & 15, cc = c & 31, ob = rr * 64 + cc * 2; return st * 1024 + (ob ^ (((ob >> 9) & 1) << 5)); }
__host__ __device__ __forceinline__ void stage_rc(int b, int& R, int& C) { const int st = b / 1024, sb = b % 1024, swz = sb ^ (((sb >> 9) & 1) << 5); R = (st >> 1) * 16 + swz / 64; C = (st & 1) * 32 + (swz % 64) / 2; }
__host__ __device__ __forceinline__ int perm32(int rho) { const int n = rho >> 4, i = rho & 15; return 8 * (i >> 2) + 4 * n + (i & 3); }

struct Unit { int pm, pn; };
struct Gemm { const bf16_t* A; const bf16_t* Bt; int K; };

struct Order {
    int nM, nN, nwg, G, c, pm0, nMain, pm_extra;
    __device__ void init(int nMain_, int pm0_, int pm_extra_, int nN_, int G_, int c_) { nMain = nMain_; pm0 = pm0_; pm_extra = pm_extra_; nM = nMain_ + (pm_extra_ >= 0 ? 1 : 0); nN = nN_; nwg = nM * nN; G = G_; c = c_; }
    __device__ bool next(int i, Unit& u) const {
        const long L = (long)i * G + c; if (L >= nwg) return false;
        int wgid = (int)L; { const int q = nwg / NXCD, r = nwg % NXCD, xcd = wgid % NXCD, off = wgid / NXCD; wgid = (xcd < r ? xcd * (q + 1) : r * (q + 1) + (xcd - r) * q) + off; }
        const int nig = WGM * nN, gid = wgid / nig, fm = gid * WGM, gsz = (nM - fm) < WGM ? (nM - fm) : WGM;
        const int t = fm + ((wgid % nig) % gsz); u.pm = (t < nMain) ? pm0 + t : pm_extra; u.pn = (wgid % nig) / gsz; return true;
    }
    __device__ __forceinline__ void a_ready(const Unit&) const {}
    __device__ __forceinline__ void done(const Unit&) const {}
};
__device__ __forceinline__ unsigned cvt_pk_bf16(float lo, float hi) { unsigned r; asm volatile("v_cvt_pk_bf16_f32 %0, %1, %2" : "=v"(r) : "v"(lo), "v"(hi)); return r; }
__device__ __forceinline__ u32x4 pack8(const f32x4 v0, const f32x4 v1) { u32x4 w; w.x = cvt_pk_bf16(v0[0], v0[1]); w.y = cvt_pk_bf16(v0[2], v0[3]); w.z = cvt_pk_bf16(v1[0], v1[1]); w.w = cvt_pk_bf16(v1[2], v1[3]); return w; }
__device__ __forceinline__ float bflo(unsigned w) { return __uint_as_float(w << 16); }
__device__ __forceinline__ float bfhi(unsigned w) { return __uint_as_float(w & 0xffff0000u); }
__device__ __forceinline__ void unpack8(const u32x4 w, f32x4& v0, f32x4& v1) { v0 = (f32x4){bflo(w.x), bfhi(w.x), bflo(w.y), bfhi(w.y)}; v1 = (f32x4){bflo(w.z), bfhi(w.z), bflo(w.w), bfhi(w.w)}; }
__device__ __forceinline__ float sigmoidf_(float x) { return __builtin_amdgcn_rcpf(1.0f + __expf(-x)); }
#define EPI_LOOP_AM _Pragma("unroll") for (int ai = 0; ai < 2; ++ai) _Pragma("unroll") for (int m = 0; m < 4; ++m)
#define EPI_LOOP_BJ _Pragma("unroll") for (int bj = 0; bj < 2; ++bj)
typedef const f32x4 (&AccT)[2][2][4][2];

struct EpiProj { static constexpr bool PERM = true, AFTER_DRAIN = false;
    bf16_t* P; const float* bg;
    __device__ __forceinline__ void operator()(AccT acc, const Unit& u, int wr, int wc, int fr, int fq) const {
        const int row0 = u.pm * BM + wr * 64 + fr, colt = u.pn * BM + wc * 32 + 8 * fq;
        const bool gate = u.pn >= 8;
        f32x4 bv[2][2];
        EPI_LOOP_BJ { _Pragma("unroll") for (int n = 0; n < 2; ++n) bv[bj][n] = gate ? *(const f32x4*)(bg + (colt - 2048) + bj * HALF + 4 * n) : (f32x4){0.f, 0.f, 0.f, 0.f}; }
        EPI_LOOP_AM { bf16_t* rowp = P + (size_t)(row0 + ai * HALF + m * 16) * INC + colt;
            EPI_LOOP_BJ { f32x4 v0 = acc[ai][bj][m][0] + bv[bj][0], v1 = acc[ai][bj][m][1] + bv[bj][1];
                if (gate) { _Pragma("unroll") for (int j = 0; j < 4; ++j) { v0[j] = sigmoidf_(v0[j]); v1[j] = sigmoidf_(v1[j]); } }
                *(u32x4*)(rowp + bj * HALF) = pack8(v0, v1); } }
    }
};
struct EpiDft { static constexpr bool PERM = true, AFTER_DRAIN = false;
    bf16_t* F;
    __device__ __forceinline__ void operator()(AccT acc, const Unit& u, int wr, int wc, int fr, int fq) const {
        const int part = u.pm / KHT, kt = u.pm - part * KHT;
        const int colg = u.pn * BM + wc * 32 + 8 * fq;
        const unsigned sgn = part ? 0x80008000u : 0u;
        EPI_LOOP_AM { const int k = kt * BM + ai * HALF + wr * 64 + m * 16 + fr;
            if (k <= LSEQ / 2) {
                EPI_LOOP_BJ { const int cg_ = colg + bj * HALF, b = cg_ >> 9, ch = cg_ & 511;
                    u32x4 w = pack8(acc[ai][bj][m][0], acc[ai][bj][m][1]);
                    *(u32x4*)(F + (size_t)row_of(b, k) * DM + part * 512 + ch) = w;
                    if (k >= 1 && k != LSEQ / 2) { w.x ^= sgn; w.y ^= sgn; w.z ^= sgn; w.w ^= sgn;
                        *(u32x4*)(F + (size_t)row_of(b, LSEQ - k) * DM + part * 512 + ch) = w; } } } }
    }
};
struct EpiYa { static constexpr bool PERM = true, AFTER_DRAIN = false;
    bf16_t* Mg; const bf16_t* P;
    __device__ __forceinline__ void operator()(AccT acc, const Unit& u, int wr, int wc, int fr, int fq) const {
        const int row0 = u.pm * BM + wr * 64 + fr, colt = u.pn * BM + wc * 32 + 8 * fq;
        EPI_LOOP_AM { const size_t row = (size_t)(row0 + ai * HALF + m * 16);
            EPI_LOOP_BJ { const u32x4 gw = *(const u32x4*)(P + row * INC + 2048 + colt + bj * HALF); f32x4 g0, g1; unpack8(gw, g0, g1);
                *(u32x4*)(Mg + row * DM + colt + bj * HALF) = pack8(acc[ai][bj][m][0] * g0, acc[ai][bj][m][1] * g1); }
            asm volatile("" ::: "memory"); }
    }
};
struct EpiYb { static constexpr bool PERM = true, AFTER_DRAIN = false;
    bf16_t* Mg; const bf16_t* P;
    __device__ __forceinline__ void operator()(AccT acc, const Unit& u, int wr, int wc, int fr, int fq) const {
        const int row0 = u.pm * BM + wr * 64 + fr, colt = u.pn * BM + wc * 32 + 8 * fq;
        EPI_LOOP_AM { const size_t row = (size_t)(row0 + ai * HALF + m * 16);
            EPI_LOOP_BJ { const u32x4 gw = *(const u32x4*)(P + row * INC + 3072 + colt + bj * HALF); f32x4 g0, g1; unpack8(gw, g0, g1);
                const u32x4 tw = *(const u32x4*)(Mg + row * DM + colt + bj * HALF); f32x4 t0, t1; unpack8(tw, t0, t1);
                *(u32x4*)(Mg + row * DM + colt + bj * HALF) = pack8(t0 + acc[ai][bj][m][0] * g0, t1 + acc[ai][bj][m][1] * g1); }
            asm volatile("" ::: "memory"); }
    }
};
struct EpiStore { static constexpr bool PERM = true, AFTER_DRAIN = false;
    bf16_t* O; int ldc, pm0, pm_extra, extra_local;
    __device__ __forceinline__ void operator()(AccT acc, const Unit& u, int wr, int wc, int fr, int fq) const {
        const int lt = (u.pm == pm_extra) ? extra_local : u.pm - pm0;
        const int row0 = lt * BM + wr * 64 + fr, colt = u.pn * BM + wc * 32 + 8 * fq;
        EPI_LOOP_AM { bf16_t* rowp = O + (size_t)(row0 + ai * HALF + m * 16) * ldc + colt;
            EPI_LOOP_BJ { *(u32x4*)(rowp + bj * HALF) = pack8(acc[ai][bj][m][0], acc[ai][bj][m][1]); } }
    }
};
struct EpiF32 { static constexpr bool PERM = false, AFTER_DRAIN = false;
    float* C; int ldc, tile_off;
    __device__ __forceinline__ void operator()(AccT acc, const Unit& u, int wr, int wc, int fr, int fq) const {
        const int row0 = (u.pm + tile_off) * BM + wr * 64 + fr, col0 = u.pn * BM + wc * 32 + 4 * fq;
        EPI_LOOP_AM { float* rowp = C + (size_t)(row0 + ai * HALF + m * 16) * ldc + col0;
            EPI_LOOP_BJ { _Pragma("unroll") for (int n = 0; n < 2; ++n) *(f32x4*)(rowp + bj * HALF + n * 16) = acc[ai][bj][m][n]; } }
    }
};

template <class Epi, class Sched, bool ALIGN_EPI = true, bool SP2 = true>
__device__ __forceinline__ void gemm_phase(PG8_LAS unsigned char* lds, const Gemm g, const Sched& S, const Epi& E) {
    const int tid = threadIdx.x, wid = __builtin_amdgcn_readfirstlane(tid >> 6), lane = tid & 63, wr = wid >> 2, wc = wid & 3, fr = lane & 15, fq = lane >> 4;
    const int K = g.K, nt = K / BK;
    unsigned voffA[2], voffB[2];
#pragma unroll
    for (int i = 0; i < 2; ++i) { int R, C; stage_rc(tid * 16 + i * 8192, R, C); const int Rb = Epi::PERM ? ((R & ~31) + perm32(R & 31)) : R;
        voffA[i] = (unsigned)(R * K + C) * 2u; voffB[i] = (unsigned)(Rb * K + C) * 2u; }
    const size_t kstep = (size_t)(BK * 2);
    const size_t hstep = (size_t)HALF * K * 2;
    const size_t tstep = 2 * hstep;
    const unsigned ldsw = (unsigned)wid * 1024u;
    const int aoff = lds_byte(wr * 64 + fr, fq * 8), boff = lds_byte(wc * 32 + fr, fq * 8);
#define PG8_SA(b, h) (((b) * 2 + (h)) * HTB)
#define PG8_SB(b, h) ((4 + (b) * 2 + (h)) * HTB)
#define PG8_STAGE(bufoff, gbase, voff) do { _Pragma("unroll") for (int _i = 0; _i < 2; ++_i) \
        __builtin_amdgcn_global_load_lds((const unsigned*)((const char*)(gbase) + (voff)[_i]), (PG8_LAS unsigned*)(lds + (bufoff) + ldsw + _i * 8192), 16, 0, 0); } while (0)
#define PG8_LDA(dst, b, h) do { _Pragma("unroll") for (int m = 0; m < 4; ++m) _Pragma("unroll") for (int k = 0; k < 2; ++k) dst[m][k] = *(const PG8_LAS bf16x8*)(lds + PG8_SA(b, h) + aoff + m * 2048 + k * 1024); } while (0)
#define PG8_LDB(dst, b, h) do { _Pragma("unroll") for (int n = 0; n < 2; ++n) _Pragma("unroll") for (int k = 0; k < 2; ++k) dst[n][k] = *(const PG8_LAS bf16x8*)(lds + PG8_SB(b, h) + boff + n * 2048 + k * 1024); } while (0)
#define PG8_MMA(ai, bj, At, Bt) do { __builtin_amdgcn_s_setprio(1); _Pragma("unroll") for (int m = 0; m < 4; ++m) _Pragma("unroll") for (int n = 0; n < 2; ++n) _Pragma("unroll") for (int k = 0; k < 2; ++k) \
        acc[ai][bj][m][n] = __builtin_amdgcn_mfma_f32_16x16x32_bf16(Bt[n][k], At[m][k], acc[ai][bj][m][n], 0, 0, 0); __builtin_amdgcn_s_setprio(0); } while (0)
#define PG8_WAIT_V(n) asm volatile("s_waitcnt vmcnt(" #n ")" ::: "memory")
#define PG8_WAIT_L(n) asm volatile("s_waitcnt lgkmcnt(" #n ")" ::: "memory")
#define PG8_BAR __builtin_amdgcn_s_barrier()
#define PG8_SCHED __builtin_amdgcn_sched_barrier(0)
    Unit cur, nxt; int ui = 0;
    if (!S.next(0, cur)) return;
    f32x4 acc[2][2][4][2];
#pragma unroll
    for (int a = 0; a < 2; ++a)
#pragma unroll
        for (int b = 0; b < 2; ++b)
#pragma unroll
            for (int m = 0; m < 4; ++m)
#pragma unroll
                for (int n = 0; n < 2; ++n) acc[a][b][m][n] = (f32x4){0.f, 0.f, 0.f, 0.f};
    bf16x8 At[4][2], B0[2][2], B1[2][2];
    const char* cA = (const char*)g.A + (size_t)cur.pm * tstep; const char* cB = (const char*)g.Bt + (size_t)cur.pn * tstep;
    S.a_ready(cur);
    if constexpr (SP2) {
        PG8_STAGE(PG8_SB(0, 0), cB, voffB); PG8_STAGE(PG8_SB(0, 1), cB + hstep, voffB); PG8_STAGE(PG8_SA(0, 0), cA, voffA); PG8_STAGE(PG8_SA(0, 1), cA + hstep, voffA);
        if (wr == 1) PG8_BAR;
        PG8_WAIT_V(2); PG8_BAR;
        PG8_STAGE(PG8_SB(1, 0), cB + kstep, voffB); PG8_STAGE(PG8_SA(1, 0), cA + kstep, voffA); PG8_STAGE(PG8_SB(1, 1), cB + hstep + kstep, voffB);
        PG8_WAIT_V(6); PG8_BAR;
    } else {
        PG8_STAGE(PG8_SB(0, 0), cB, voffB); PG8_STAGE(PG8_SA(0, 0), cA, voffA); PG8_STAGE(PG8_SB(0, 1), cB + hstep, voffB); PG8_STAGE(PG8_SA(0, 1), cA + hstep, voffA);
        if (wr == 1) PG8_BAR;
        PG8_WAIT_V(4); PG8_BAR;
        PG8_STAGE(PG8_SB(1, 0), cB + kstep, voffB); PG8_STAGE(PG8_SA(1, 0), cA + kstep, voffA); PG8_STAGE(PG8_SB(1, 1), cB + hstep + kstep, voffB);
        PG8_WAIT_V(6); PG8_BAR;
    }
    for (;;) {
        const bool has_next = S.next(ui + 1, nxt);
        const char* nA = has_next ? (const char*)g.A + (size_t)nxt.pm * tstep : cA; const char* nB = has_next ? (const char*)g.Bt + (size_t)nxt.pn * tstep : cB;
        for (int t = 0; t < nt; t += 2) {
            const bool last = (t == nt - 2);
            const char* a1 = cA + (size_t)(t + 1) * kstep;
            const char* a2 = last ? nA : cA + (size_t)(t + 2) * kstep; const char* b2 = last ? nB : cB + (size_t)(t + 2) * kstep;
            const char* a3 = a2 + kstep; const char* b3 = b2 + kstep;
            if (last && has_next) S.a_ready(nxt);
            if constexpr (SP2) {
            PG8_LDB(B0, 0, 0); PG8_LDB(B1, 0, 1); PG8_SCHED; PG8_LDA(At, 0, 0); PG8_STAGE(PG8_SA(1, 1), a1 + hstep, voffA);
            PG8_WAIT_V(8); PG8_WAIT_L(0); PG8_BAR; PG8_MMA(0, 0, At, B0); PG8_MMA(0, 1, At, B1); PG8_BAR; PG8_SCHED;
            PG8_LDA(At, 0, 1); PG8_STAGE(PG8_SB(0, 0), b2, voffB); PG8_STAGE(PG8_SB(0, 1), b2 + hstep, voffB); PG8_STAGE(PG8_SA(0, 0), a2, voffA);
            PG8_WAIT_V(8); PG8_WAIT_L(0); PG8_BAR; PG8_MMA(1, 0, At, B0); PG8_MMA(1, 1, At, B1); PG8_BAR; PG8_SCHED;
            PG8_LDB(B0, 1, 0); PG8_LDB(B1, 1, 1); PG8_SCHED; PG8_LDA(At, 1, 0); PG8_STAGE(PG8_SA(0, 1), a2 + hstep, voffA);
            PG8_WAIT_V(8); PG8_WAIT_L(0); PG8_BAR; PG8_MMA(0, 0, At, B0); PG8_MMA(0, 1, At, B1); PG8_BAR; PG8_SCHED;
            PG8_LDA(At, 1, 1); PG8_STAGE(PG8_SB(1, 0), b3, voffB); PG8_STAGE(PG8_SB(1, 1), b3 + hstep, voffB); PG8_STAGE(PG8_SA(1, 0), a3, voffA);
            PG8_WAIT_V(8); PG8_WAIT_L(0); PG8_BAR; PG8_MMA(1, 0, At, B0); PG8_MMA(1, 1, At, B1); PG8_BAR; PG8_SCHED;
            } else {
            PG8_LDB(B0, 0, 0); PG8_SCHED; PG8_LDA(At, 0, 0); PG8_STAGE(PG8_SA(1, 1), a1 + hstep, voffA);
            PG8_WAIT_L(8); PG8_BAR; PG8_WAIT_L(0); PG8_MMA(0, 0, At, B0); PG8_BAR; PG8_SCHED;
            PG8_LDB(B1, 0, 1); PG8_STAGE(PG8_SB(0, 0), b2, voffB);
            PG8_BAR; PG8_WAIT_L(0); PG8_MMA(0, 1, At, B1); PG8_BAR;
            PG8_LDA(At, 0, 1); PG8_STAGE(PG8_SA(0, 0), a2, voffA);
            PG8_BAR; PG8_WAIT_L(0); PG8_MMA(1, 0, At, B0); PG8_BAR; PG8_SCHED;
            PG8_STAGE(PG8_SB(0, 1), b2 + hstep, voffB);
            PG8_WAIT_V(6); PG8_BAR; PG8_MMA(1, 1, At, B1); PG8_BAR;
            PG8_LDB(B0, 1, 0); PG8_SCHED; PG8_LDA(At, 1, 0); PG8_STAGE(PG8_SA(0, 1), a2 + hstep, voffA);
            PG8_WAIT_L(8); PG8_BAR; PG8_WAIT_L(0); PG8_MMA(0, 0, At, B0); PG8_BAR; PG8_SCHED;
            PG8_LDB(B1, 1, 1); PG8_STAGE(PG8_SB(1, 0), b3, voffB);
            PG8_BAR; PG8_WAIT_L(0); PG8_MMA(0, 1, At, B1); PG8_BAR;
            PG8_LDA(At, 1, 1); PG8_STAGE(PG8_SA(1, 0), a3, voffA);
            PG8_BAR; PG8_WAIT_L(0); PG8_MMA(1, 0, At, B0); PG8_BAR; PG8_SCHED;
            PG8_STAGE(PG8_SB(1, 1), b3 + hstep, voffB);
            PG8_WAIT_V(6); PG8_BAR; PG8_MMA(1, 1, At, B1); PG8_BAR;
            }
        }
        if constexpr (ALIGN_EPI) { if (wr == 0) PG8_BAR; }
        if constexpr (!Epi::AFTER_DRAIN) { E(acc, cur, wr, wc, fr, fq); S.done(cur); }
        if (!has_next) break;
#pragma unroll
        for (int a = 0; a < 2; ++a)
#pragma unroll
            for (int b = 0; b < 2; ++b)
#pragma unroll
                for (int m = 0; m < 4; ++m)
#pragma unroll
                    for (int n = 0; n < 2; ++n) acc[a][b][m][n] = (f32x4){0.f, 0.f, 0.f, 0.f};
        cur = nxt; cA = nA; cB = nB; ++ui;
        if constexpr (ALIGN_EPI) { if (wr == 1) PG8_BAR; }
    }
    PG8_WAIT_V(0);
    if constexpr (!ALIGN_EPI) { if (wr == 0) PG8_BAR; }
    PG8_BAR;
    if constexpr (Epi::AFTER_DRAIN) { E.fused(acc, cur, wr, wc, fr, fq, lds, wid, lane); S.done(cur); }
#undef PG8_SA
#undef PG8_SB
#undef PG8_STAGE
#undef PG8_LDA
#undef PG8_LDB
#undef PG8_MMA
#undef PG8_WAIT_V
#undef PG8_WAIT_L
#undef PG8_BAR
#undef PG8_SCHED
}
}

constexpr int NWAVES = 8;
constexpr int LDS_BYTES = 147456;
constexpr size_t MiB = 1u << 20;
constexpr size_t WS_WIN = 1 * MiB, WS_WEFF = 9 * MiB, WS_WCO = 11 * MiB, WS_WOUT = 12 * MiB, WS_WUP = 14 * MiB, WS_WDN = 25 * MiB;
constexpr size_t WS_H = 32 * MiB;
constexpr size_t WS_PROJ = 161 * MiB;
constexpr size_t WS_H2 = 161 * MiB;
constexpr size_t WS_U = 290 * MiB;
constexpr size_t WS_ACT = 645 * MiB;
constexpr size_t WS_ZB = 675 * MiB;
constexpr size_t WS_F = 740 * MiB;
constexpr size_t WS_MG = 869 * MiB;
constexpr size_t WS_NEED = 1000 * MiB;
constexpr size_t DO_DM = 0, DO_UT = 140 * MiB;
static_assert((size_t)2 * KH * KD * 2 <= DO_UT && DO_UT + (size_t)4096 * KD * 2 <= 256 * MiB, "d_out scratch map");
static_assert(WS_H + (size_t)R_TOT * DM * 2 <= WS_PROJ && WS_PROJ + (size_t)R_TOT * INC * 2 <= WS_ZB && WS_ZB + (size_t)R_TOT * 512 * 2 <= WS_F && WS_F + (size_t)R_TOT * DM * 2 <= WS_MG && WS_MG + (size_t)R_TOT * DM * 2 <= WS_NEED, "ws map 1");
static_assert(WS_H2 + (size_t)R_TOT * DM * 2 <= WS_U && WS_U + (size_t)33024 * 5632 * 2 <= WS_ACT && WS_ACT + (size_t)32768 * DFF * 2 <= WS_NEED, "ws map 2");

#define LAS __attribute__((address_space(3)))
typedef unsigned short bf16;
typedef unsigned v4u __attribute__((ext_vector_type(4)));
typedef unsigned v2u __attribute__((ext_vector_type(2)));
typedef float f32x4 __attribute__((ext_vector_type(4)));
#define LDS_WAIT() asm volatile("s_waitcnt lgkmcnt(0)" ::: "memory")
using pg8::cvt_pk_bf16; using pg8::bflo; using pg8::bfhi;

__device__ __forceinline__ float wave_sum(float v) {
#pragma unroll
    for (int o = 1; o < 64; o <<= 1) v += __shfl_xor(v, o);
    return v;
}
__device__ __forceinline__ void unpack8f(const v4u w, float (&f)[8]) { f[0] = bflo(w.x); f[1] = bfhi(w.x); f[2] = bflo(w.y); f[3] = bfhi(w.y); f[4] = bflo(w.z); f[5] = bfhi(w.z); f[6] = bflo(w.w); f[7] = bfhi(w.w); }
__device__ __forceinline__ v4u pack8f(const float (&f)[8]) { v4u w; w.x = cvt_pk_bf16(f[0], f[1]); w.y = cvt_pk_bf16(f[2], f[3]); w.z = cvt_pk_bf16(f[4], f[5]); w.w = cvt_pk_bf16(f[6], f[7]); return w; }
__device__ __forceinline__ void load8f(const float* p, float (&f)[8]) { const f32x4 a = *(const f32x4*)p, b = *(const f32x4*)(p + 4); f[0] = a.x; f[1] = a.y; f[2] = a.z; f[3] = a.w; f[4] = b.x; f[5] = b.y; f[6] = b.z; f[7] = b.w; }

struct Args { const float* in[17]; float* out; unsigned char* ws; int ph_lo, ph_hi; };
enum { I_X = 0, I_META, I_GMIXPRE, I_WIN, I_BGATES, I_WFOURIER, I_CWMIX, I_CBMIX, I_WCONVOUT, I_WOUT, I_GMIXPOST, I_GFFNPRE, I_WUP, I_CWFFN, I_CBFFN, I_WDOWN, I_GFFNPOST };

__device__ __forceinline__ void p0_transpose_item(const float* __restrict__ W, int K, int N, bf16* __restrict__ WT, int k0, int n0, int drow0, LAS float* scr, int lane) {
#pragma unroll 8
    for (int i = 0; i < 32; ++i) { const int kk = 2 * i + (lane >> 5); scr[kk * 33 + (lane & 31)] = W[(size_t)(k0 + kk) * N + n0 + (lane & 31)]; }
    LDS_WAIT();
    const int c = lane & 7;
#pragma unroll
    for (int j = 0; j < 4; ++j) { const int n = (lane >> 3) + 8 * j; const LAS float* s = scr + (8 * c) * 33 + n;
        v4u o; o.x = cvt_pk_bf16(s[0 * 33], s[1 * 33]); o.y = cvt_pk_bf16(s[2 * 33], s[3 * 33]); o.z = cvt_pk_bf16(s[4 * 33], s[5 * 33]); o.w = cvt_pk_bf16(s[6 * 33], s[7 * 33]);
        *(v4u*)(WT + (size_t)(drow0 + n) * K + k0 + 8 * c) = o; }
    LDS_WAIT();
}
__device__ __forceinline__ int wup_drow(int n0) { return n0 < DFF ? 256 * (n0 >> 7) + (n0 & 127) : 256 * ((n0 - DFF) >> 7) + 128 + ((n0 - DFF) & 127); }

__device__ __forceinline__ void phase0(const Args& a, LAS unsigned char* lds, int gw, int NGW, int wave, int lane) {
    unsigned char* ws = a.ws;
    LAS float* scr = (LAS float*)(lds + wave * 16384);
    constexpr int T_IN = 16 * 128, T_CO = 8 * 32, T_OUT = 16 * 32, T_UP = 16 * 176, T_DN = 44 * 32, T_ALL = T_IN + T_CO + T_OUT + T_UP + T_DN;
    for (int it = gw; it < T_ALL; it += NGW) {
        int r = it;
        if (r < T_IN) { const int kb = r / 128, nb = r % 128; p0_transpose_item(a.in[I_WIN], DM, INC, (bf16*)(ws + WS_WIN), kb * 64, nb * 32, nb * 32, scr, lane); continue; } r -= T_IN;
        if (r < T_CO) { const int kb = r / 32, nb = r % 32; p0_transpose_item(a.in[I_WCONVOUT], 512, DM, (bf16*)(ws + WS_WCO), kb * 64, nb * 32, nb * 32, scr, lane); continue; } r -= T_CO;
        if (r < T_OUT) { const int kb = r / 32, nb = r % 32; p0_transpose_item(a.in[I_WOUT], DM, DM, (bf16*)(ws + WS_WOUT), kb * 64, nb * 32, nb * 32, scr, lane); continue; } r -= T_OUT;
        if (r < T_UP) { const int kb = r / 176, nb = r % 176; p0_transpose_item(a.in[I_WUP], DM, 2 * DFF, (bf16*)(ws + WS_WUP), kb * 64, nb * 32, wup_drow(nb * 32), scr, lane); continue; } r -= T_UP;
        { const int kb = r / 32, nb = r % 32; p0_transpose_item(a.in[I_WDOWN], DFF, DM, (bf16*)(ws + WS_WDN), kb * 64, nb * 32, nb * 32, scr, lane); }
    }
    { const float* wf = a.in[I_WFOURIER]; bf16* we = (bf16*)(ws + WS_WEFF);
      for (int it = gw; it < 8192; it += NGW) { const int jb = it & 15, c = (it >> 4) & 127, g = it >> 11, j = jb * 64 + lane;
          float ac = 0.f, as = 0.f;
#pragma unroll 4
          for (int cp = 0; cp < 128; ++cp) { const float w = wf[(size_t)(g * 128 + cp) * DM + j]; const float ph = (float)((c * cp) & 127) * (1.0f / 128.0f);
              ac += __builtin_amdgcn_cosf(ph) * w; as += __builtin_amdgcn_sinf(ph) * w; }
          const float s = 0.08838834764831845f;
          we[(size_t)j * DM + g * 128 + c] = (bf16)(cvt_pk_bf16(ac * s, 0.f) & 0xffffu); we[(size_t)j * DM + 512 + g * 128 + c] = (bf16)(cvt_pk_bf16(as * s, 0.f) & 0xffffu); } }
    { bf16* dmat = (bf16*)((unsigned char*)a.out + DO_DM); constexpr int CPR = KD / 8;
      for (int it = gw; it < 2 * KH * CPR / 64; it += NGW) { const int chunk = it * 64 + lane, row = chunk / CPR, ci = chunk - row * CPR, n0 = ci * 8, part = row >= KH, k = row - part * KH;
          int mm = (int)(((unsigned)k * (unsigned)n0) % (unsigned)LSEQ); float f[8];
#pragma unroll
          for (int i = 0; i < 8; ++i) { const float ph = (float)mm * (1.0f / (float)LSEQ); const float v = part ? -__builtin_amdgcn_sinf(ph) : __builtin_amdgcn_cosf(ph);
              f[i] = (n0 + i < LSEQ) ? v * 0.011037770f : 0.f; mm += k; if (mm >= LSEQ) mm -= LSEQ; }
          *(v4u*)(dmat + (size_t)row * KD + n0) = pack8f(f); } }
    { const float* g = a.in[I_GMIXPRE]; bf16* h = (bf16*)(ws + WS_H);
      f32x4 gv[4];
#pragma unroll
      for (int j = 0; j < 4; ++j) gv[j] = ((const f32x4*)g)[lane + 64 * j];
      for (int r = gw; r < R_TOT; r += NGW) {
          unsigned long long* o8 = (unsigned long long*)(h + (size_t)r * DM) + lane;
          if (r >= R_META + NB * NMETA) {
#pragma unroll
              for (int j = 0; j < 4; ++j) o8[64 * j] = 0ull;
              continue; }
          const float* src = r < R_META ? a.in[I_X] + (size_t)r * DM : a.in[I_META] + (size_t)((r - R_META) & 15) * DM;
          f32x4 v[4]; float s2 = 0.f;
#pragma unroll
          for (int j = 0; j < 4; ++j) { v[j] = ((const f32x4*)src)[lane + 64 * j]; s2 += (v[j].x * v[j].x + v[j].y * v[j].y) + (v[j].z * v[j].z + v[j].w * v[j].w); }
          const float rstd = rsqrtf(wave_sum(s2) * (1.0f / DM) + RMS_EPS);
#pragma unroll
          for (int j = 0; j < 4; ++j) { const f32x4 o = v[j] * rstd * gv[j]; o8[64 * j] = (unsigned long long)cvt_pk_bf16(o.x, o.y) | ((unsigned long long)cvt_pk_bf16(o.z, o.w) << 32); }
      } }
}

__device__ __forceinline__ void phase2(const Args& a, LAS unsigned char* lds, int gw, int NGW, int wave, int lane) {
    unsigned char* ws = a.ws; const bf16* proj = (const bf16*)(ws + WS_PROJ);
    { bf16* uT = (bf16*)((unsigned char*)a.out + DO_UT); LAS bf16* scr = (LAS bf16*)(lds + wave * 16384);
      for (int it = gw; it < NB * 8 * 130; it += NGW) { const int nblk = it % 130, cb = (it / 130) & 7, b = it / 1040;
#pragma unroll
          for (int i = 0; i < 8; ++i) { const int nl = i * 8 + (lane >> 3), n = nblk * 64 + nl, chunk = lane & 7;
              v4u w = (v4u){0u, 0u, 0u, 0u}; if (n < LSEQ) w = *(const v4u*)(proj + (size_t)row_of(b, n) * INC + cb * 64 + chunk * 8);
              LAS bf16* d = scr + (chunk * 8) * 66 + nl;
              d[0 * 66] = (bf16)(w.x & 0xffffu); d[1 * 66] = (bf16)(w.x >> 16); d[2 * 66] = (bf16)(w.y & 0xffffu); d[3 * 66] = (bf16)(w.y >> 16);
              d[4 * 66] = (bf16)(w.z & 0xffffu); d[5 * 66] = (bf16)(w.z >> 16); d[6 * 66] = (bf16)(w.w & 0xffffu); d[7 * 66] = (bf16)(w.w >> 16); }
          LDS_WAIT();
#pragma unroll
          for (int i = 0; i < 8; ++i) { const int ch = i * 8 + (lane >> 3), nc = lane & 7; const LAS unsigned* s = (const LAS unsigned*)(scr + ch * 66 + nc * 8);
              v4u w; w.x = s[0]; w.y = s[1]; w.z = s[2]; w.w = s[3];
              *(v4u*)(uT + (size_t)(b * 512 + cb * 64 + ch) * KD + nblk * 64 + nc * 8) = w; }
          LDS_WAIT(); } }
    { bf16* zb = (bf16*)(ws + WS_ZB); const float* cw = a.in[I_CWMIX]; const float* cbias = a.in[I_CBMIX];
      float w0[8], w1[8], w2[8], bb[8]; const int ch0 = lane * 8;
      load8f(cw + ch0, w0); load8f(cw + 512 + ch0, w1); load8f(cw + 1024 + ch0, w2); load8f(cbias + ch0, bb);
      for (int it = gw; it < NB * LSEQ; it += NGW) { const int b = it / LSEQ, p = it - b * LSEQ; const size_t r = (size_t)row_of(b, p);
          float cc[8], vv[8], bg[8], acc[8];
          unpack8f(*(const v4u*)(proj + r * INC + 512 + ch0), cc); unpack8f(*(const v4u*)(proj + r * INC + 1536 + ch0), vv); unpack8f(*(const v4u*)(proj + r * INC + 1024 + ch0), bg);
#pragma unroll
          for (int e = 0; e < 8; ++e) acc[e] = bb[e] + w1[e] * (cc[e] * vv[e]);
          if (p > 0) { const size_t rp = (size_t)row_of(b, p - 1); unpack8f(*(const v4u*)(proj + rp * INC + 512 + ch0), cc); unpack8f(*(const v4u*)(proj + rp * INC + 1536 + ch0), vv);
#pragma unroll
              for (int e = 0; e < 8; ++e) acc[e] += w0[e] * (cc[e] * vv[e]); }
          if (p < LSEQ - 1) { const size_t rn = (size_t)row_of(b, p + 1); unpack8f(*(const v4u*)(proj + rn * INC + 512 + ch0), cc); unpack8f(*(const v4u*)(proj + rn * INC + 1536 + ch0), vv);
#pragma unroll
              for (int e = 0; e < 8; ++e) acc[e] += w2[e] * (cc[e] * vv[e]); }
#pragma unroll
          for (int e = 0; e < 8; ++e) acc[e] *= bg[e];
          *(v4u*)(zb + r * 512 + ch0) = pack8f(acc); } }
}

__device__ __forceinline__ void phase6(const Args& a, int gw, int NGW, int lane) {
    unsigned char* ws = a.ws; const bf16* mix = (const bf16*)(ws + WS_H); bf16* h2 = (bf16*)(ws + WS_H2);
    float g1[2][8], g2[2][8];
#pragma unroll
    for (int j = 0; j < 2; ++j) { load8f(a.in[I_GMIXPOST] + 8 * lane + 512 * j, g1[j]); load8f(a.in[I_GFFNPRE] + 8 * lane + 512 * j, g2[j]); }
    for (int r = gw; r < R_META + NB * NMETA; r += NGW) {
        const float* src = r < R_META ? a.in[I_X] + (size_t)r * DM : a.in[I_META] + (size_t)((r - R_META) & 15) * DM;
        float mv[2][8], xv[2][8]; float s = 0.f;
#pragma unroll
        for (int j = 0; j < 2; ++j) { unpack8f(*(const v4u*)(mix + (size_t)r * DM + 8 * lane + 512 * j), mv[j]); load8f(src + 8 * lane + 512 * j, xv[j]);
#pragma unroll
            for (int e = 0; e < 8; ++e) s += mv[j][e] * mv[j][e]; }
        const float r1 = rsqrtf(wave_sum(s) * (1.0f / DM) + RMS_EPS); float s2 = 0.f;
#pragma unroll
        for (int j = 0; j < 2; ++j)
#pragma unroll
            for (int e = 0; e < 8; ++e) { const float hr = xv[j][e] + mv[j][e] * r1 * g1[j][e]; xv[j][e] = hr; s2 += hr * hr; }
        const float r2 = rsqrtf(wave_sum(s2) * (1.0f / DM) + RMS_EPS);
#pragma unroll
        for (int j = 0; j < 2; ++j) { float o[8];
#pragma unroll
            for (int e = 0; e < 8; ++e) o[e] = xv[j][e] * r2 * g2[j][e];
            *(v4u*)(h2 + (size_t)r * DM + 8 * lane + 512 * j) = pack8f(o); }
    }
}

__device__ __forceinline__ float gelu_tanh(float x) { const float z2 = 1.5957691216057308f * (x + 0.044715f * x * x * x); return x * __builtin_amdgcn_rcpf(1.0f + __expf(-z2)); }
__device__ __forceinline__ void phase8(const Args& a, int c, int gw, int NGW, int lane) {
    unsigned char* ws = a.ws; const bf16* U = (const bf16*)(ws + WS_U); bf16* act = (bf16*)(ws + WS_ACT);
    const float* cw = a.in[I_CWFFN]; const float* cbias = a.in[I_CBFFN];
    constexpr int SEGF = 32, NSEG = 32768 / SEGF;
    for (int it = gw; it < 6 * NSEG; it += NGW) { const int s = it / NSEG, seg = it - s * NSEG; const int cgi = s * 64 + lane; if (cgi >= DFF / 8) continue;
        const int j0 = cgi * 8, ua = 256 * (j0 >> 7) + (j0 & 127), uv = ua + 128;
        float wa[3][8], wv[3][8], ba[8], bv[8];
#pragma unroll
        for (int k = 0; k < 3; ++k) { load8f(cw + (size_t)k * 2 * DFF + j0, wa[k]); load8f(cw + (size_t)k * 2 * DFF + DFF + j0, wv[k]); }
        load8f(cbias + j0, ba); load8f(cbias + DFF + j0, bv);
        const int lr0 = seg * SEGF;
        for (int q = 0; q < SEGF; q += 4) {
            float xa[6][8], xv[6][8];
#pragma unroll
            for (int t = 0; t < 6; ++t) { const int lr = lr0 + q + t - 1; int src = lr; bool ok = true;
                if (t == 0 && ((lr + 1) & 8191) == 0) src = 32768 + (c * 4 + ((lr + 1) >> 13)) * NMETA + (NMETA - 1);
                if (t == 5 && (lr & 8191) == 0) ok = false;
                if (ok) { unpack8f(*(const v4u*)(U + (size_t)src * (2 * DFF) + ua), xa[t]); unpack8f(*(const v4u*)(U + (size_t)src * (2 * DFF) + uv), xv[t]); }
                else {
#pragma unroll
                    for (int e = 0; e < 8; ++e) { xa[t][e] = 0.f; xv[t][e] = 0.f; } } }
#pragma unroll
            for (int t = 0; t < 4; ++t) { float o[8];
#pragma unroll
                for (int e = 0; e < 8; ++e) { const float ca = ba[e] + wa[0][e] * xa[t][e] + wa[1][e] * xa[t + 1][e] + wa[2][e] * xa[t + 2][e];
                    const float cv = bv[e] + wv[0][e] * xv[t][e] + wv[1][e] * xv[t + 1][e] + wv[2][e] * xv[t + 2][e]; o[e] = gelu_tanh(ca) * cv; }
                *(v4u*)(act + (size_t)(lr0 + q + t) * DFF + j0) = pack8f(o); }
        } }
}

__device__ __forceinline__ void phase10(const Args& a, int gw, int NGW, int lane) {
    unsigned char* ws = a.ws; const bf16* mix = (const bf16*)(ws + WS_H);
    float g1[2][8], g3[2][8];
#pragma unroll
    for (int j = 0; j < 2; ++j) { load8f(a.in[I_GMIXPOST] + 8 * lane + 512 * j, g1[j]); load8f(a.in[I_GFFNPOST] + 8 * lane + 512 * j, g3[j]); }
    for (int r = gw; r < R_META; r += NGW) {
        float mv[2][8], xv[2][8], fv[2][8]; float s = 0.f, s3 = 0.f;
#pragma unroll
        for (int j = 0; j < 2; ++j) { unpack8f(*(const v4u*)(mix + (size_t)r * DM + 8 * lane + 512 * j), mv[j]); load8f(a.in[I_X] + (size_t)r * DM + 8 * lane + 512 * j, xv[j]); load8f(a.out + (size_t)r * DM + 8 * lane + 512 * j, fv[j]);
#pragma unroll
            for (int e = 0; e < 8; ++e) { s += mv[j][e] * mv[j][e]; s3 += fv[j][e] * fv[j][e]; } }
        const float r1 = rsqrtf(wave_sum(s) * (1.0f / DM) + RMS_EPS), r3 = rsqrtf(wave_sum(s3) * (1.0f / DM) + RMS_EPS);
#pragma unroll
        for (int j = 0; j < 2; ++j) { f32x4 o0, o1;
            o0.x = xv[j][0] + mv[j][0] * r1 * g1[j][0] + fv[j][0] * r3 * g3[j][0]; o0.y = xv[j][1] + mv[j][1] * r1 * g1[j][1] + fv[j][1] * r3 * g3[j][1];
            o0.z = xv[j][2] + mv[j][2] * r1 * g1[j][2] + fv[j][2] * r3 * g3[j][2]; o0.w = xv[j][3] + mv[j][3] * r1 * g1[j][3] + fv[j][3] * r3 * g3[j][3];
            o1.x = xv[j][4] + mv[j][4] * r1 * g1[j][4] + fv[j][4] * r3 * g3[j][4]; o1.y = xv[j][5] + mv[j][5] * r1 * g1[j][5] + fv[j][5] * r3 * g3[j][5];
            o1.z = xv[j][6] + mv[j][6] * r1 * g1[j][6] + fv[j][6] * r3 * g3[j][6]; o1.w = xv[j][7] + mv[j][7] * r1 * g1[j][7] + fv[j][7] * r3 * g3[j][7];
            *(f32x4*)(a.out + (size_t)r * DM + 8 * lane + 512 * j) = o0; *(f32x4*)(a.out + (size_t)r * DM + 8 * lane + 512 * j + 4) = o1; }
    }
}

constexpr int N_PHASES = 15;
__global__ void __launch_bounds__(NWAVES * 64, 2) fwd_megakernel(Args args) {
    extern __shared__ __attribute__((aligned(16))) unsigned char lds_raw[];
    LAS unsigned char* lds = (LAS unsigned char*)lds_raw;
    cg::grid_group grid = cg::this_grid();
    const int tid = threadIdx.x, lane = tid & 63, wave = __builtin_amdgcn_readfirstlane(tid >> 6);
    const int G = gridDim.x, bx = blockIdx.x;
    const int vcu = (G % 8 == 0) ? (bx % 8) * (G / 8) + bx / 8 : bx;
    const int gw = vcu * NWAVES + wave, NGW = G * NWAVES;
    unsigned char* ws = args.ws;
    const int lo = args.ph_lo, hi = args.ph_hi;
#ifndef PHASE_MASK
#define PHASE_MASK 0x7fff
#endif
#define IN(k) (((PHASE_MASK >> (k)) & 1) && lo <= (k) && (k) < hi)
#define SEAM(k) do { if ((k) + 1 < hi) grid.sync(); } while (0)
    using namespace pg8;
    if (IN(0)) { phase0(args, lds, gw, NGW, wave, lane); SEAM(0); }
    if (IN(1)) {
        Gemm g{(const bf16_t*)(ws + WS_H), (const bf16_t*)(ws + WS_WIN), DM}; Order S; S.init(R_TOT / 256, 0, -1, INC / 256, G, bx);
        EpiProj E{(bf16_t*)(ws + WS_PROJ), args.in[I_BGATES]};
        gemm_phase<EpiProj, Order>(lds, g, S, E); SEAM(1); }
    if (IN(2)) { phase2(args, lds, gw, NGW, wave, lane); SEAM(2); }
    if (IN(3)) {
        Gemm g{(const bf16_t*)((unsigned char*)args.out + DO_DM), (const bf16_t*)((unsigned char*)args.out + DO_UT), KD}; Order S; S.init(2 * KHT, 0, -1, 4096 / 256, G, bx);
        EpiDft E{(bf16_t*)(ws + WS_F)};
        gemm_phase<EpiDft, Order>(lds, g, S, E); SEAM(3); }
    if (IN(4)) {
        Gemm g{(const bf16_t*)(ws + WS_F), (const bf16_t*)(ws + WS_WEFF), DM}; Order S; S.init(R_TOT / 256, 0, -1, DM / 256, G, bx);
        EpiYa E{(bf16_t*)(ws + WS_MG), (const bf16_t*)(ws + WS_PROJ)};
        gemm_phase<EpiYa, Order>(lds, g, S, E); SEAM(4); }
    if (IN(5)) {
        Gemm g{(const bf16_t*)(ws + WS_ZB), (const bf16_t*)(ws + WS_WCO), 512}; Order S; S.init(R_TOT / 256, 0, -1, DM / 256, G, bx);
        EpiYb E{(bf16_t*)(ws + WS_MG), (const bf16_t*)(ws + WS_PROJ)};
        gemm_phase<EpiYb, Order>(lds, g, S, E); SEAM(5); }
    if (IN(6)) {
        Gemm g{(const bf16_t*)(ws + WS_MG), (const bf16_t*)(ws + WS_WOUT), DM}; Order S; S.init(R_TOT / 256, 0, -1, DM / 256, G, bx);
        EpiStore E{(bf16_t*)(ws + WS_H), DM, 0, -1, 0};
        gemm_phase<EpiStore, Order>(lds, g, S, E); SEAM(6); }
    if (IN(7)) { phase6(args, gw, NGW, lane); SEAM(7); }
#pragma unroll
    for (int c = 0; c < 2; ++c) {
        const int p = 8 + 3 * c;
        if (IN(p)) {
            Gemm g{(const bf16_t*)(ws + WS_H2), (const bf16_t*)(ws + WS_WUP), DM}; Order S; S.init(128, 128 * c, c == 0 ? 256 : -1, 2 * DFF / 256, G, bx);
            EpiStore E{(bf16_t*)(ws + WS_U), 2 * DFF, 128 * c, 256, 128};
            gemm_phase<EpiStore, Order>(lds, g, S, E); SEAM(p); }
        if (IN(p + 1)) { phase8(args, c, gw, NGW, lane); SEAM(p + 1); }
        if (IN(p + 2)) {
            Gemm g{(const bf16_t*)(ws + WS_ACT), (const bf16_t*)(ws + WS_WDN), DFF}; Order S; S.init(128, 0, -1, DM / 256, G, bx);
            EpiF32 E{args.out, DM, 128 * c};
            gemm_phase<EpiF32, Order>(lds, g, S, E); SEAM(p + 2); }
    }
    if (IN(14)) { phase10(args, gw, NGW, lane); }
#undef IN
#undef SEAM
}

extern "C" void kernel_launch(void* const* d_in, const int* in_sizes, int n_in, void* d_out, int out_size, void* d_ws, size_t ws_size, hipStream_t stream) {
    static int grid = 0;
    if (grid == 0) {
        if (n_in != 17 || ws_size < WS_NEED || out_size != NB * SEQ * DM) { fprintf(stderr, "kernel_launch: unexpected problem (n_in %d, ws %zu, out %d)\n", n_in, ws_size, out_size); grid = -1; return; }
        int dev = 0, cus = 0, per_cu = 0;
        if (hipGetDevice(&dev) != hipSuccess || hipDeviceGetAttribute(&cus, hipDeviceAttributeMultiprocessorCount, dev) != hipSuccess) { grid = -1; return; }
        if (hipFuncSetAttribute((const void*)fwd_megakernel, hipFuncAttributeMaxDynamicSharedMemorySize, LDS_BYTES) != hipSuccess) { fprintf(stderr, "kernel_launch: hipFuncSetAttribute failed\n"); grid = -1; return; }
        if (hipOccupancyMaxActiveBlocksPerMultiprocessor(&per_cu, (const void*)fwd_megakernel, NWAVES * 64, LDS_BYTES) != hipSuccess || per_cu < 1) { fprintf(stderr, "kernel_launch: occupancy query says %d\n", per_cu); per_cu = 1; }
        (void)hipGetLastError();
        grid = cus * 1;
    }
    if (grid < 0) return;
    Args a{};
    for (int i = 0; i < 17; ++i) a.in[i] = (const float*)d_in[i];
    a.out = (float*)d_out; a.ws = (unsigned char*)d_ws; a.ph_lo = 0; a.ph_hi = N_PHASES;
    void* kargs[] = {&a};
    hipError_t e = hipLaunchCooperativeKernel((const void*)fwd_megakernel, dim3(grid), dim3(NWAVES * 64), kargs, LDS_BYTES, stream);
    if (e != hipSuccess) fprintf(stderr, "kernel_launch: cooperative launch failed: %s (grid %d)\n", hipGetErrorString(e), grid);
}
```

```cpp
#include <hip/hip_runtime.h>
#include <hip/hip_cooperative_groups.h>
#include <cstdio>
#include <cstdint>
namespace cg = cooperative_groups;

constexpr int NB = 8, SEQ = 8192, NMETA = 16, LSEQ = 8208, DM = 1024, DFF = 2816, INC = 4096;
constexpr int R_META = 65536, R_TOT = 65792;
constexpr int KD = 4224, NHALF = LSEQ / 2;
constexpr int KH = 4352, KHT = 17;
constexpr float RMS_EPS = 1e-6f;
__device__ __forceinline__ int row_of(int b, int pos) { return pos >= NMETA ? b * SEQ + pos - NMETA : R_META + b * NMETA + pos; }

namespace pg8 {
#define PG8_LAS __attribute__((address_space(3)))
typedef unsigned short bf16_t;
typedef short bf16x8 __attribute__((ext_vector_type(8)));
typedef float f32x4 __attribute__((ext_vector_type(4)));
typedef unsigned u32x4 __attribute__((ext_vector_type(4)));
constexpr int BM = 256, BK = 64, HALF = 128, HTB = HALF * BK * 2, STAGE_BYTES = 8 * HTB, NXCD = 8, WGM = 8;

__host__ __device__ __forceinline__ int lds_byte(int r, int c) { const int st = (r >> 4) * 2 + (c >> 5), rr = r & 15, cc = c & 31, ob = rr * 64 + cc * 2; return st * 1024 + (ob ^ (((ob >> 9) & 1) << 5)); }
__host__ __device__ __forceinline__ void stage_rc(int b, int& R, int& C) { const int st = b / 1024, sb = b % 1024, swz = sb ^ (((sb >> 9) & 1) << 5); R = (st >> 1) * 16 + swz / 64; C = (st & 1) * 32 + (swz % 64) / 2; }
__host__ __device__ __forceinline__ int perm32(int rho) { const int n = rho >> 4, i = rho & 15; return 8 * (i >> 2) + 4 * n + (i & 3); }

struct Unit { int pm, pn; };
struct Gemm { const bf16_t* A; const bf16_t* Bt; int K; };

struct Order {
    int nM, nN, nwg, G, c, pm0, nMain, pm_extra;
    __device__ void init(int nMain_, int pm0_, int pm_extra_, int nN_, int G_, int c_) { nMain = nMain_; pm0 = pm0_; pm_extra = pm_extra_; nM = nMain_ + (pm_extra_ >= 0 ? 1 : 0); nN = nN_; nwg = nM * nN; G = G_; c = c_; }
    __device__ bool next(int i, Unit& u) const {
        const long L = (long)i * G + c; if (L >= nwg) return false;
        int wgid = (int)L; { const int q = nwg / NXCD, r = nwg % NXCD, xcd = wgid % NXCD, off = wgid / NXCD; wgid = (xcd < r ? xcd * (q + 1) : r * (q + 1) + (xcd - r) * q) + off; }
        const int nig = WGM * nN, gid = wgid / nig, fm = gid * WGM, gsz = (nM - fm) < WGM ? (nM - fm) : WGM;
        const int t = fm + ((wgid % nig) % gsz); u.pm = (t < nMain) ? pm0 + t : pm_extra; u.pn = (wgid % nig) / gsz; return true;
    }
    __device__ __forceinline__ void a_ready(const Unit&) const {}
    __device__ __forceinline__ void done(const Unit&) const {}
};
struct OrderDft {
    int G, c;
    __device__ void init(int G_, int c_) { G = G_; c = c_; }
    __device__ bool next(int i, Unit& u) const {
        constexpr int nM = 32, nN = 16, nwg = nM * nN;
        const long L = (long)i * G + c; if (L >= nwg) return false;
        int wgid = (int)L; { const int q = nwg / NXCD, xcd = wgid % NXCD, off = wgid / NXCD; wgid = xcd * q + off; }
        const int nig = WGM * nN, gid = wgid / nig, fm = gid * WGM;
        const int t = fm + ((wgid % nig) % WGM), pn = (wgid % nig) / WGM, part = t >> 4;
        u.pm = part * KHT + (t & 15); u.pn = part * 16 + pn; return true;
    }
    __device__ __forceinline__ void a_ready(const Unit&) const {}
    __device__ __forceinline__ void done(const Unit&) const {}
};
__device__ __forceinline__ unsigned cvt_pk_bf16(float lo, float hi) { unsigned r; asm volatile("v_cvt_pk_bf16_f32 %0, %1, %2" : "=v"(r) : "v"(lo), "v"(hi)); return r; }
__device__ __forceinline__ u32x4 pack8(const f32x4 v0, const f32x4 v1) { u32x4 w; w.x = cvt_pk_bf16(v0[0], v0[1]); w.y = cvt_pk_bf16(v0[2], v0[3]); w.z = cvt_pk_bf16(v1[0], v1[1]); w.w = cvt_pk_bf16(v1[2], v1[3]); return w; }
__device__ __forceinline__ float bflo(unsigned w) { return __uint_as_float(w << 16); }
__device__ __forceinline__ float bfhi(unsigned w) { return __uint_as_float(w & 0xffff0000u); }
__device__ __forceinline__ void unpack8(const u32x4 w, f32x4& v0, f32x4& v1) { v0 = (f32x4){bflo(w.x), bfhi(w.x), bflo(w.y), bfhi(w.y)}; v1 = (f32x4){bflo(w.z), bfhi(w.z), bflo(w.w), bfhi(w.w)}; }
__device__ __forceinline__ float sigmoidf_(float x) { return __builtin_amdgcn_rcpf(1.0f + __expf(-x)); }
#define EPI_LOOP_AM _Pragma("unroll") for (int ai = 0; ai < 2; ++ai) _Pragma("unroll") for (int m = 0; m < 4; ++m)
#define EPI_LOOP_BJ _Pragma("unroll") for (int bj = 0; bj < 2; ++bj)
typedef const f32x4 (&AccT)[2][2][4][2];

struct EpiProj { static constexpr bool PERM = true, AFTER_DRAIN = false;
    bf16_t* P; const float* bg;
    __device__ __forceinline__ void operator()(AccT acc, const Unit& u, int wr, int wc, int fr, int fq) const {
        const int row0 = u.pm * BM + wr * 64 + fr, colt = u.pn * BM + wc * 32 + 8 * fq;
        const bool gate = u.pn >= 8;
        f32x4 bv[2][2];
        EPI_LOOP_BJ { _Pragma("unroll") for (int n = 0; n < 2; ++n) bv[bj][n] = gate ? *(const f32x4*)(bg + (colt - 2048) + bj * HALF + 4 * n) : (f32x4){0.f, 0.f, 0.f, 0.f}; }
        EPI_LOOP_AM { bf16_t* rowp = P + (size_t)(row0 + ai * HALF + m * 16) * INC + colt;
            EPI_LOOP_BJ { f32x4 v0 = acc[ai][bj][m][0] + bv[bj][0], v1 = acc[ai][bj][m][1] + bv[bj][1];
                if (gate) { _Pragma("unroll") for (int j = 0; j < 4; ++j) { v0[j] = sigmoidf_(v0[j]); v1[j] = sigmoidf_(v1[j]); } }
                *(u32x4*)(rowp + bj * HALF) = pack8(v0, v1); } }
    }
};
struct EpiDft { static constexpr bool PERM = true, AFTER_DRAIN = false;
    bf16_t* F;
    __device__ __forceinline__ void operator()(AccT acc, const Unit& u, int wr, int wc, int fr, int fq) const {
        const int part = u.pm / KHT, kt = u.pm - part * KHT;
        const int colg = (u.pn & 15) * BM + wc * 32 + 8 * fq;
        const unsigned sgn = part ? 0x80008000u : 0u;
        EPI_LOOP_AM { const int k = kt * BM + ai * HALF + wr * 64 + m * 16 + fr;
            {
                EPI_LOOP_BJ { const int cg_ = colg + bj * HALF, b = cg_ >> 9, ch = cg_ & 511;
                    u32x4 w = pack8(acc[ai][bj][m][0], acc[ai][bj][m][1]);
                    *(u32x4*)(F + (size_t)row_of(b, k) * DM + part * 512 + ch) = w;
                    if (k >= 1) { w.x ^= sgn; w.y ^= sgn; w.z ^= sgn; w.w ^= sgn;
                        *(u32x4*)(F + (size_t)row_of(b, LSEQ - k) * DM + part * 512 + ch) = w; } } } }
    }
};
struct EpiYa { static constexpr bool PERM = true, AFTER_DRAIN = false;
    bf16_t* Mg; const bf16_t* P;
    __device__ __forceinline__ void operator()(AccT acc, const Unit& u, int wr, int wc, int fr, int fq) const {
        const int row0 = u.pm * BM + wr * 64 + fr, colt = u.pn * BM + wc * 32 + 8 * fq;
        EPI_LOOP_AM { const size_t row = (size_t)(row0 + ai * HALF + m * 16);
            EPI_LOOP_BJ { const u32x4 gw = *(const u32x4*)(P + row * INC + 2048 + colt + bj * HALF); f32x4 g0, g1; unpack8(gw, g0, g1);
                *(u32x4*)(Mg + row * DM + colt + bj * HALF) = pack8(acc[ai][bj][m][0] * g0, acc[ai][bj][m][1] * g1); }
            asm volatile("" ::: "memory"); }
    }
};
struct EpiYb { static constexpr bool PERM = true, AFTER_DRAIN = false;
    bf16_t* Mg; const bf16_t* P;
    __device__ __forceinline__ void operator()(AccT acc, const Unit& u, int wr, int wc, int fr, int fq) const {
        const int row0 = u.pm * BM + wr * 64 + fr, colt = u.pn * BM + wc * 32 + 8 * fq;
        EPI_LOOP_AM { const size_t row = (size_t)(row0 + ai * HALF + m * 16);
            EPI_LOOP_BJ { const u32x4 gw = *(const u32x4*)(P + row * INC + 3072 + colt + bj * HALF); f32x4 g0, g1; unpack8(gw, g0, g1);
                const u32x4 tw = *(const u32x4*)(Mg + row * DM + colt + bj * HALF); f32x4 t0, t1; unpack8(tw, t0, t1);
                *(u32x4*)(Mg + row * DM + colt + bj * HALF) = pack8(t0 + acc[ai][bj][m][0] * g0, t1 + acc[ai][bj][m][1] * g1); }
            asm volatile("" ::: "memory"); }
    }
};
struct EpiStore { static constexpr bool PERM = true, AFTER_DRAIN = false;
    bf16_t* O; int ldc, pm0, pm_extra, extra_local;
    __device__ __forceinline__ void operator()(AccT acc, const Unit& u, int wr, int wc, int fr, int fq) const {
        const int lt = (u.pm == pm_extra) ? extra_local : u.pm - pm0;
        const int row0 = lt * BM + wr * 64 + fr, colt = u.pn * BM + wc * 32 + 8 * fq;
        EPI_LOOP_AM { bf16_t* rowp = O + (size_t)(row0 + ai * HALF + m * 16) * ldc + colt;
            EPI_LOOP_BJ { *(u32x4*)(rowp + bj * HALF) = pack8(acc[ai][bj][m][0], acc[ai][bj][m][1]); } }
    }
};
struct EpiF32 { static constexpr bool PERM = false, AFTER_DRAIN = false;
    float* C; int ldc, tile_off;
    __device__ __forceinline__ void operator()(AccT acc, const Unit& u, int wr, int wc, int fr, int fq) const {
        const int row0 = (u.pm + tile_off) * BM + wr * 64 + fr, col0 = u.pn * BM + wc * 32 + 4 * fq;
        EPI_LOOP_AM { float* rowp = C + (size_t)(row0 + ai * HALF + m * 16) * ldc + col0;
            EPI_LOOP_BJ { _Pragma("unroll") for (int n = 0; n < 2; ++n) *(f32x4*)(rowp + bj * HALF + n * 16) = acc[ai][bj][m][n]; } }
    }
};

template <class Epi, class Sched, bool ALIGN_EPI = true, bool SP2 = true>
__device__ __forceinline__ void gemm_phase(PG8_LAS unsigned char* lds, const Gemm g, const Sched& S, const Epi& E) {
    const int tid = threadIdx.x, wid = __builtin_amdgcn_readfirstlane(tid >> 6), lane = tid & 63, wr = wid >> 2, wc = wid & 3, fr = lane & 15, fq = lane >> 4;
    const int K = g.K, nt = K / BK;
    unsigned voffA[2], voffB[2];
#pragma unroll
    for (int i = 0; i < 2; ++i) { int R, C; stage_rc(tid * 16 + i * 8192, R, C); const int Rb = Epi::PERM ? ((R & ~31) + perm32(R & 31)) : R;
        voffA[i] = (unsigned)(R * K + C) * 2u; voffB[i] = (unsigned)(Rb * K + C) * 2u; }
    const size_t kstep = (size_t)(BK * 2);
    const size_t hstep = (size_t)HALF * K * 2;
    const size_t tstep = 2 * hstep;
    const unsigned ldsw = (unsigned)wid * 1024u;
    const int aoff = lds_byte(wr * 64 + fr, fq * 8), boff = lds_byte(wc * 32 + fr, fq * 8);
#define PG8_SA(b, h) (((b) * 2 + (h)) * HTB)
#define PG8_SB(b, h) ((4 + (b) * 2 + (h)) * HTB)
#define PG8_STAGE(bufoff, gbase, voff) do { _Pragma("unroll") for (int _i = 0; _i < 2; ++_i) \
        __builtin_amdgcn_global_load_lds((const unsigned*)((const char*)(gbase) + (voff)[_i]), (PG8_LAS unsigned*)(lds + (bufoff) + ldsw + _i * 8192), 16, 0, 0); } while (0)
#define PG8_LDA(dst, b, h) do { _Pragma("unroll") for (int m = 0; m < 4; ++m) _Pragma("unroll") for (int k = 0; k < 2; ++k) dst[m][k] = *(const PG8_LAS bf16x8*)(lds + PG8_SA(b, h) + aoff + m * 2048 + k * 1024); } while (0)
#define PG8_LDB(dst, b, h) do { _Pragma("unroll") for (int n = 0; n < 2; ++n) _Pragma("unroll") for (int k = 0; k < 2; ++k) dst[n][k] = *(const PG8_LAS bf16x8*)(lds + PG8_SB(b, h) + boff + n * 2048 + k * 1024); } while (0)
#define PG8_MMA(ai, bj, At, Bt) do { __builtin_amdgcn_s_setprio(1); _Pragma("unroll") for (int m = 0; m < 4; ++m) _Pragma("unroll") for (int n = 0; n < 2; ++n) _Pragma("unroll") for (int k = 0; k < 2; ++k) \
        acc[ai][bj][m][n] = __builtin_amdgcn_mfma_f32_16x16x32_bf16(Bt[n][k], At[m][k], acc[ai][bj][m][n], 0, 0, 0); __builtin_amdgcn_s_setprio(0); } while (0)
#define PG8_WAIT_V(n) asm volatile("s_waitcnt vmcnt(" #n ")" ::: "memory")
#define PG8_WAIT_L(n) asm volatile("s_waitcnt lgkmcnt(" #n ")" ::: "memory")
#define PG8_BAR __builtin_amdgcn_s_barrier()
#define PG8_SCHED __builtin_amdgcn_sched_barrier(0)
    Unit cur, nxt; int ui = 0;
    if (!S.next(0, cur)) return;
    f32x4 acc[2][2][4][2];
#pragma unroll
    for (int a = 0; a < 2; ++a)
#pragma unroll
        for (int b = 0; b < 2; ++b)
#pragma unroll
            for (int m = 0; m < 4; ++m)
#pragma unroll
                for (int n = 0; n < 2; ++n) acc[a][b][m][n] = (f32x4){0.f, 0.f, 0.f, 0.f};
    bf16x8 At[4][2], B0[2][2], B1[2][2];
    const char* cA = (const char*)g.A + (size_t)cur.pm * tstep; const char* cB = (const char*)g.Bt + (size_t)cur.pn * tstep;
    S.a_ready(cur);
    if constexpr (SP2) {
        PG8_STAGE(PG8_SB(0, 0), cB, voffB); PG8_STAGE(PG8_SB(0, 1), cB + hstep, voffB); PG8_STAGE(PG8_SA(0, 0), cA, voffA); PG8_STAGE(PG8_SA(0, 1), cA + hstep, voffA);
        if (wr == 1) PG8_BAR;
        PG8_WAIT_V(2); PG8_BAR;
        PG8_STAGE(PG8_SB(1, 0), cB + kstep, voffB); PG8_STAGE(PG8_SA(1, 0), cA + kstep, voffA); PG8_STAGE(PG8_SB(1, 1), cB + hstep + kstep, voffB);
        PG8_WAIT_V(6); PG8_BAR;
    } else {
        PG8_STAGE(PG8_SB(0, 0), cB, voffB); PG8_STAGE(PG8_SA(0, 0), cA, voffA); PG8_STAGE(PG8_SB(0, 1), cB + hstep, voffB); PG8_STAGE(PG8_SA(0, 1), cA + hstep, voffA);
        if (wr == 1) PG8_BAR;
        PG8_WAIT_V(4); PG8_BAR;
        PG8_STAGE(PG8_SB(1, 0), cB + kstep, voffB); PG8_STAGE(PG8_SA(1, 0), cA + kstep, voffA); PG8_STAGE(PG8_SB(1, 1), cB + hstep + kstep, voffB);
        PG8_WAIT_V(6); PG8_BAR;
    }
    for (;;) {
        const bool has_next = S.next(ui + 1, nxt);
        const char* nA = has_next ? (const char*)g.A + (size_t)nxt.pm * tstep : cA; const char* nB = has_next ? (const char*)g.Bt + (size_t)nxt.pn * tstep : cB;
        for (int t = 0; t < nt; t += 2) {
            const bool last = (t == nt - 2);
            const char* a1 = cA + (size_t)(t + 1) * kstep;
            const char* a2 = last ? nA : cA + (size_t)(t + 2) * kstep; const char* b2 = last ? nB : cB + (size_t)(t + 2) * kstep;
            const char* a3 = a2 + kstep; const char* b3 = b2 + kstep;
            if (last && has_next) S.a_ready(nxt);
            if constexpr (SP2) {
            PG8_LDB(B0, 0, 0); PG8_LDB(B1, 0, 1); PG8_SCHED; PG8_LDA(At, 0, 0); PG8_STAGE(PG8_SA(1, 1), a1 + hstep, voffA);
            PG8_WAIT_V(8); PG8_WAIT_L(0); PG8_BAR; PG8_MMA(0, 0, At, B0); PG8_MMA(0, 1, At, B1); PG8_BAR; PG8_SCHED;
            PG8_LDA(At, 0, 1); PG8_STAGE(PG8_SB(0, 0), b2, voffB); PG8_STAGE(PG8_SB(0, 1), b2 + hstep, voffB); PG8_STAGE(PG8_SA(0, 0), a2, voffA);
            PG8_WAIT_V(8); PG8_WAIT_L(0); PG8_BAR; PG8_MMA(1, 0, At, B0); PG8_MMA(1, 1, At, B1); PG8_BAR; PG8_SCHED;
            PG8_LDB(B0, 1, 0); PG8_LDB(B1, 1, 1); PG8_SCHED; PG8_LDA(At, 1, 0); PG8_STAGE(PG8_SA(0, 1), a2 + hstep, voffA);
            PG8_WAIT_V(8); PG8_WAIT_L(0); PG8_BAR; PG8_MMA(0, 0, At, B0); PG8_MMA(0, 1, At, B1); PG8_BAR; PG8_SCHED;
            PG8_LDA(At, 1, 1); PG8_STAGE(PG8_SB(1, 0), b3, voffB); PG8_STAGE(PG8_SB(1, 1), b3 + hstep, voffB); PG8_STAGE(PG8_SA(1, 0), a3, voffA);
            PG8_WAIT_V(8); PG8_WAIT_L(0); PG8_BAR; PG8_MMA(1, 0, At, B0); PG8_MMA(1, 1, At, B1); PG8_BAR; PG8_SCHED;
            } else {
            PG8_LDB(B0, 0, 0); PG8_SCHED; PG8_LDA(At, 0, 0); PG8_STAGE(PG8_SA(1, 1), a1 + hstep, voffA);
            PG8_WAIT_L(8); PG8_BAR; PG8_WAIT_L(0); PG8_MMA(0, 0, At, B0); PG8_BAR; PG8_SCHED;
            PG8_LDB(B1, 0, 1); PG8_STAGE(PG8_SB(0, 0), b2, voffB);
            PG8_BAR; PG8_WAIT_L(0); PG8_MMA(0, 1, At, B1); PG8_BAR;
            PG8_LDA(At, 0, 1); PG8_STAGE(PG8_SA(0, 0), a2, voffA);
            PG8_BAR; PG8_WAIT_L(0); PG8_MMA(1, 0, At, B0); PG8_BAR; PG8_SCHED;
            PG8_STAGE(PG8_SB(0, 1), b2 + hstep, voffB);
            PG8_WAIT_V(6); PG8_BAR; PG8_MMA(1, 1, At, B1); PG8_BAR;
            PG8_LDB(B0, 1, 0); PG8_SCHED; PG8_LDA(At, 1, 0); PG8_STAGE(PG8_SA(0, 1), a2 + hstep, voffA);
            PG8_WAIT_L(8); PG8_BAR; PG8_WAIT_L(0); PG8_MMA(0, 0, At, B0); PG8_BAR; PG8_SCHED;
            PG8_LDB(B1, 1, 1); PG8_STAGE(PG8_SB(1, 0), b3, voffB);
            PG8_BAR; PG8_WAIT_L(0); PG8_MMA(0, 1, At, B1); PG8_BAR;
            PG8_LDA(At, 1, 1); PG8_STAGE(PG8_SA(1, 0), a3, voffA);
            PG8_BAR; PG8_WAIT_L(0); PG8_MMA(1, 0, At, B0); PG8_BAR; PG8_SCHED;
            PG8_STAGE(PG8_SB(1, 1), b3 + hstep, voffB);
            PG8_WAIT_V(6); PG8_BAR; PG8_MMA(1, 1, At, B1); PG8_BAR;
            }
        }
        if constexpr (ALIGN_EPI) { if (wr == 0) PG8_BAR; }
        if constexpr (!Epi::AFTER_DRAIN) { E(acc, cur, wr, wc, fr, fq); S.done(cur); }
        if (!has_next) break;
#pragma unroll
        for (int a = 0; a < 2; ++a)
#pragma unroll
            for (int b = 0; b < 2; ++b)
#pragma unroll
                for (int m = 0; m < 4; ++m)
#pragma unroll
                    for (int n = 0; n < 2; ++n) acc[a][b][m][n] = (f32x4){0.f, 0.f, 0.f, 0.f};
        cur = nxt; cA = nA; cB = nB; ++ui;
        if constexpr (ALIGN_EPI) { if (wr == 1) PG8_BAR; }
    }
    PG8_WAIT_V(0);
    if constexpr (!ALIGN_EPI) { if (wr == 0) PG8_BAR; }
    PG8_BAR;
    if constexpr (Epi::AFTER_DRAIN) { E.fused(acc, cur, wr, wc, fr, fq, lds, wid, lane); S.done(cur); }
#undef PG8_SA
#undef PG8_SB
#undef PG8_STAGE
#undef PG8_LDA
#undef PG8_LDB
#undef PG8_MMA
#undef PG8_WAIT_V
#undef PG8_WAIT_L
#undef PG8_BAR
#undef PG8_SCHED
}
}

constexpr int NWAVES = 8;
constexpr int LDS_BYTES = 147456;
constexpr size_t MiB = 1u << 20;
constexpr size_t WS_WIN = 1 * MiB, WS_WEFF = 9 * MiB, WS_WCO = 11 * MiB, WS_WOUT = 12 * MiB, WS_WUP = 14 * MiB, WS_WDN = 25 * MiB;
constexpr size_t WS_H = 32 * MiB;
constexpr size_t WS_PROJ = 161 * MiB;
constexpr size_t WS_H2 = 161 * MiB;
constexpr size_t WS_U = 290 * MiB;
constexpr size_t WS_ACT = 645 * MiB;
constexpr size_t WS_ZB = 675 * MiB;
constexpr size_t WS_F = 740 * MiB;
constexpr size_t WS_MG = 869 * MiB;
constexpr size_t WS_NEED = 1000 * MiB;
constexpr size_t DO_DM = 0, DO_UT = 72 * MiB;
static_assert((size_t)2 * KH * KD * 2 <= DO_UT && DO_UT + (size_t)2 * 4096 * KD * 2 <= 256 * MiB, "d_out scratch map");
static_assert(WS_H + (size_t)R_TOT * DM * 2 <= WS_PROJ && WS_PROJ + (size_t)R_TOT * INC * 2 <= WS_ZB && WS_ZB + (size_t)R_TOT * 512 * 2 <= WS_F && WS_F + (size_t)R_TOT * DM * 2 <= WS_MG && WS_MG + (size_t)R_TOT * DM * 2 <= WS_NEED, "ws map 1");
static_assert(WS_H2 + (size_t)R_TOT * DM * 2 <= WS_U && WS_U + (size_t)33024 * 5632 * 2 <= WS_ACT && WS_ACT + (size_t)32768 * DFF * 2 <= WS_NEED, "ws map 2");

#define LAS __attribute__((address_space(3)))
typedef unsigned short bf16;
typedef unsigned v4u __attribute__((ext_vector_type(4)));
typedef unsigned v2u __attribute__((ext_vector_type(2)));
typedef float f32x4 __attribute__((ext_vector_type(4)));
#define LDS_WAIT() asm volatile("s_waitcnt lgkmcnt(0)" ::: "memory")
using pg8::cvt_pk_bf16; using pg8::bflo; using pg8::bfhi;

__device__ __forceinline__ float wave_sum(float v) {
#pragma unroll
    for (int o = 1; o < 64; o <<= 1) v += __shfl_xor(v, o);
    return v;
}
__device__ __forceinline__ void unpack8f(const v4u w, float (&f)[8]) { f[0] = bflo(w.x); f[1] = bfhi(w.x); f[2] = bflo(w.y); f[3] = bfhi(w.y); f[4] = bflo(w.z); f[5] = bfhi(w.z); f[6] = bflo(w.w); f[7] = bfhi(w.w); }
__device__ __forceinline__ v4u pack8f(const float (&f)[8]) { v4u w; w.x = cvt_pk_bf16(f[0], f[1]); w.y = cvt_pk_bf16(f[2], f[3]); w.z = cvt_pk_bf16(f[4], f[5]); w.w = cvt_pk_bf16(f[6], f[7]); return w; }
__device__ __forceinline__ void load8f(const float* p, float (&f)[8]) { const f32x4 a = *(const f32x4*)p, b = *(const f32x4*)(p + 4); f[0] = a.x; f[1] = a.y; f[2] = a.z; f[3] = a.w; f[4] = b.x; f[5] = b.y; f[6] = b.z; f[7] = b.w; }

struct Args { const float* in[17]; float* out; unsigned char* ws; int ph_lo, ph_hi; };
enum { I_X = 0, I_META, I_GMIXPRE, I_WIN, I_BGATES, I_WFOURIER, I_CWMIX, I_CBMIX, I_WCONVOUT, I_WOUT, I_GMIXPOST, I_GFFNPRE, I_WUP, I_CWFFN, I_CBFFN, I_WDOWN, I_GFFNPOST };

__device__ __forceinline__ void p0_transpose_item(const float* __restrict__ W, int K, int N, bf16* __restrict__ WT, int k0, int n0, int drow0, LAS float* scr, int lane) {
#pragma unroll 8
    for (int i = 0; i < 32; ++i) { const int kk = 2 * i + (lane >> 5); scr[kk * 33 + (lane & 31)] = W[(size_t)(k0 + kk) * N + n0 + (lane & 31)]; }
    LDS_WAIT();
    const int c = lane & 7;
#pragma unroll
    for (int j = 0; j < 4; ++j) { const int n = (lane >> 3) + 8 * j; const LAS float* s = scr + (8 * c) * 33 + n;
        v4u o; o.x = cvt_pk_bf16(s[0 * 33], s[1 * 33]); o.y = cvt_pk_bf16(s[2 * 33], s[3 * 33]); o.z = cvt_pk_bf16(s[4 * 33], s[5 * 33]); o.w = cvt_pk_bf16(s[6 * 33], s[7 * 33]);
        *(v4u*)(WT + (size_t)(drow0 + n) * K + k0 + 8 * c) = o; }
    LDS_WAIT();
}
__device__ __forceinline__ int wup_drow(int n0) { return n0 < DFF ? 256 * (n0 >> 7) + (n0 & 127) : 256 * ((n0 - DFF) >> 7) + 128 + ((n0 - DFF) & 127); }

__device__ __forceinline__ void phase0(const Args& a, LAS unsigned char* lds, int gw, int NGW, int wave, int lane) {
    unsigned char* ws = a.ws;
    LAS float* scr = (LAS float*)(lds + wave * 16384);
    constexpr int T_IN = 16 * 128, T_CO = 8 * 32, T_OUT = 16 * 32, T_UP = 16 * 176, T_DN = 44 * 32, T_ALL = T_IN + T_CO + T_OUT + T_UP + T_DN;
    for (int it = gw; it < T_ALL; it += NGW) {
        int r = it;
        if (r < T_IN) { const int kb = r / 128, nb = r % 128; p0_transpose_item(a.in[I_WIN], DM, INC, (bf16*)(ws + WS_WIN), kb * 64, nb * 32, nb * 32, scr, lane); continue; } r -= T_IN;
        if (r < T_CO) { const int kb = r / 32, nb = r % 32; p0_transpose_item(a.in[I_WCONVOUT], 512, DM, (bf16*)(ws + WS_WCO), kb * 64, nb * 32, nb * 32, scr, lane); continue; } r -= T_CO;
        if (r < T_OUT) { const int kb = r / 32, nb = r % 32; p0_transpose_item(a.in[I_WOUT], DM, DM, (bf16*)(ws + WS_WOUT), kb * 64, nb * 32, nb * 32, scr, lane); continue; } r -= T_OUT;
        if (r < T_UP) { const int kb = r / 176, nb = r % 176; p0_transpose_item(a.in[I_WUP], DM, 2 * DFF, (bf16*)(ws + WS_WUP), kb * 64, nb * 32, wup_drow(nb * 32), scr, lane); continue; } r -= T_UP;
        { const int kb = r / 32, nb = r % 32; p0_transpose_item(a.in[I_WDOWN], DFF, DM, (bf16*)(ws + WS_WDN), kb * 64, nb * 32, nb * 32, scr, lane); }
    }
    { const float* wf = a.in[I_WFOURIER]; bf16* we = (bf16*)(ws + WS_WEFF);
      for (int it = gw; it < 8192; it += NGW) { const int jb = it & 15, c = (it >> 4) & 127, g = it >> 11, j = jb * 64 + lane;
          float ac = 0.f, as = 0.f;
#pragma unroll 4
          for (int cp = 0; cp < 128; ++cp) { const float w = wf[(size_t)(g * 128 + cp) * DM + j]; const float ph = (float)((c * cp) & 127) * (1.0f / 128.0f);
              ac += __builtin_amdgcn_cosf(ph) * w; as += __builtin_amdgcn_sinf(ph) * w; }
          const float s = 0.08838834764831845f;
          we[(size_t)j * DM + g * 128 + c] = (bf16)(cvt_pk_bf16(ac * s, 0.f) & 0xffffu); we[(size_t)j * DM + 512 + g * 128 + c] = (bf16)(cvt_pk_bf16(as * s, 0.f) & 0xffffu); } }
    { bf16* dmat = (bf16*)((unsigned char*)a.out + DO_DM); constexpr int CPR = KD / 8;
      for (int it = gw; it < 2 * KH * CPR / 64; it += NGW) { const int chunk = it * 64 + lane, row = chunk / CPR, ci = chunk - row * CPR, n0 = ci * 8, part = row >= KH, k = row - part * KH;
          int mm = (int)(((unsigned)k * (unsigned)n0) % (unsigned)LSEQ); float f[8];
#pragma unroll
          for (int i = 0; i < 8; ++i) { const float ph = (float)mm * (1.0f / (float)LSEQ); const float v = part ? -__builtin_amdgcn_sinf(ph) : __builtin_amdgcn_cosf(ph);
              f[i] = (n0 + i <= NHALF) ? v * 0.011037770f : 0.f; mm += k; if (mm >= LSEQ) mm -= LSEQ; }
          *(v4u*)(dmat + (size_t)row * KD + n0) = pack8f(f); } }
    { const float* g = a.in[I_GMIXPRE]; bf16* h = (bf16*)(ws + WS_H);
      f32x4 gv[4];
#pragma unroll
      for (int j = 0; j < 4; ++j) gv[j] = ((const f32x4*)g)[lane + 64 * j];
      for (int r0 = gw; r0 < R_TOT; r0 += 2 * NGW) {
          f32x4 v[2][4]; float s2[2];
#pragma unroll
          for (int q = 0; q < 2; ++q) { const int r = r0 + q * NGW; s2[q] = 0.f;
              if (r < R_META + NB * NMETA) { const float* src = r < R_META ? a.in[I_X] + (size_t)r * DM : a.in[I_META] + (size_t)((r - R_META) & 15) * DM;
#pragma unroll
                  for (int j = 0; j < 4; ++j) v[q][j] = ((const f32x4*)src)[lane + 64 * j]; }
              else {
#pragma unroll
                  for (int j = 0; j < 4; ++j) v[q][j] = (f32x4){0.f, 0.f, 0.f, 0.f}; } }
#pragma unroll
          for (int q = 0; q < 2; ++q) {
#pragma unroll
              for (int j = 0; j < 4; ++j) s2[q] += (v[q][j].x * v[q][j].x + v[q][j].y * v[q][j].y) + (v[q][j].z * v[q][j].z + v[q][j].w * v[q][j].w); }
#pragma unroll
          for (int q = 0; q < 2; ++q) { const int r = r0 + q * NGW; if (r >= R_TOT) continue;
              const float rstd = rsqrtf(wave_sum(s2[q]) * (1.0f / DM) + RMS_EPS);
              unsigned long long* o8 = (unsigned long long*)(h + (size_t)r * DM) + lane;
#pragma unroll
              for (int j = 0; j < 4; ++j) { const f32x4 o = v[q][j] * rstd * gv[j]; o8[64 * j] = (unsigned long long)cvt_pk_bf16(o.x, o.y) | ((unsigned long long)cvt_pk_bf16(o.z, o.w) << 32); } }
      } }
}

__device__ __forceinline__ void phase2(const Args& a, LAS unsigned char* lds, int gw, int NGW, int wave, int lane) {
    unsigned char* ws = a.ws; const bf16* proj = (const bf16*)(ws + WS_PROJ);
    { bf16* eT = (bf16*)((unsigned char*)a.out + DO_UT); bf16* oT = eT + (size_t)4096 * KD;
      LAS bf16* scrE = (LAS bf16*)(lds + wave * 16896); LAS bf16* scrO = scrE + 64 * 66;
      constexpr int NBLK = KD / 64;
      for (int it = gw; it < NB * 8 * NBLK; it += NGW) { const int nblk = it % NBLK, cb = (it / NBLK) & 7, b = it / (8 * NBLK);
#pragma unroll
          for (int i = 0; i < 8; ++i) { const int nl = i * 8 + (lane >> 3), nh = nblk * 64 + nl, chunk = lane & 7;
              float e[8], o[8];
#pragma unroll
              for (int j = 0; j < 8; ++j) { e[j] = 0.f; o[j] = 0.f; }
              if (nh <= NHALF) { unpack8f(*(const v4u*)(proj + (size_t)row_of(b, nh) * INC + cb * 64 + chunk * 8), e);
                  if (nh >= 1 && nh < NHALF) { float u2[8]; unpack8f(*(const v4u*)(proj + (size_t)row_of(b, LSEQ - nh) * INC + cb * 64 + chunk * 8), u2);
#pragma unroll
                      for (int j = 0; j < 8; ++j) { o[j] = e[j] - u2[j]; e[j] = e[j] + u2[j]; } } }
              LAS bf16* dE = scrE + (chunk * 8) * 66 + nl; LAS bf16* dO = scrO + (chunk * 8) * 66 + nl;
#pragma unroll
              for (int j = 0; j < 8; ++j) { const unsigned w = cvt_pk_bf16(e[j], o[j]); dE[j * 66] = (bf16)(w & 0xffffu); dO[j * 66] = (bf16)(w >> 16); } }
          LDS_WAIT();
#pragma unroll
          for (int i = 0; i < 8; ++i) { const int ch = i * 8 + (lane >> 3), nc = lane & 7; const size_t off = (size_t)(b * 512 + cb * 64 + ch) * KD + nblk * 64 + nc * 8;
              const LAS unsigned* se = (const LAS unsigned*)(scrE + ch * 66 + nc * 8); const LAS unsigned* so = (const LAS unsigned*)(scrO + ch * 66 + nc * 8);
              v4u w; w.x = se[0]; w.y = se[1]; w.z = se[2]; w.w = se[3]; *(v4u*)(eT + off) = w;
              w.x = so[0]; w.y = so[1]; w.z = so[2]; w.w = so[3]; *(v4u*)(oT + off) = w; }
          LDS_WAIT(); } }
    { bf16* zb = (bf16*)(ws + WS_ZB); const float* cw = a.in[I_CWMIX]; const float* cbias = a.in[I_CBMIX];
      float w0[8], w1[8], w2[8], bb[8]; const int ch0 = lane * 8;
      load8f(cw + ch0, w0); load8f(cw + 512 + ch0, w1); load8f(cw + 1024 + ch0, w2); load8f(cbias + ch0, bb);
      for (int it = gw; it < NB * LSEQ; it += NGW) { const int b = it / LSEQ, p = it - b * LSEQ; const size_t r = (size_t)row_of(b, p);
          float cc[8], vv[8], bg[8], acc[8];
          unpack8f(*(const v4u*)(proj + r * INC + 512 + ch0), cc); unpack8f(*(const v4u*)(proj + r * INC + 1536 + ch0), vv); unpack8f(*(const v4u*)(proj + r * INC + 1024 + ch0), bg);
#pragma unroll
          for (int e = 0; e < 8; ++e) acc[e] = bb[e] + w1[e] * (cc[e] * vv[e]);
          if (p > 0) { const size_t rp = (size_t)row_of(b, p - 1); unpack8f(*(const v4u*)(proj + rp * INC + 512 + ch0), cc); unpack8f(*(const v4u*)(proj + rp * INC + 1536 + ch0), vv);
#pragma unroll
              for (int e = 0; e < 8; ++e) acc[e] += w0[e] * (cc[e] * vv[e]); }
          if (p < LSEQ - 1) { const size_t rn = (size_t)row_of(b, p + 1); unpack8f(*(const v4u*)(proj + rn * INC + 512 + ch0), cc); unpack8f(*(const v4u*)(proj + rn * INC + 1536 + ch0), vv);
#pragma unroll
              for (int e = 0; e < 8; ++e) acc[e] += w2[e] * (cc[e] * vv[e]); }
#pragma unroll
          for (int e = 0; e < 8; ++e) acc[e] *= bg[e];
          *(v4u*)(zb + r * 512 + ch0) = pack8f(acc); } }
}

__device__ __forceinline__ void dft_tail(const Args& a, int gw, int NGW, int lane) {
    const bf16* dm = (const bf16*)((unsigned char*)a.out + DO_DM); const bf16* eT = (const bf16*)((unsigned char*)a.out + DO_UT); const bf16* oT = eT + (size_t)4096 * KD;
    bf16* F = (bf16*)(a.ws + WS_F);
    for (int row = gw; row < 4096; row += NGW) {
        float se[9], so[9];
#pragma unroll
        for (int kx = 0; kx < 9; ++kx) { se[kx] = 0.f; so[kx] = 0.f; }
        for (int it = 0; it < 9; ++it) { const int off = it * 512 + lane * 8;
            if (off < KD) { float ev[8], ov[8]; unpack8f(*(const v4u*)(eT + (size_t)row * KD + off), ev); unpack8f(*(const v4u*)(oT + (size_t)row * KD + off), ov);
#pragma unroll
                for (int kx = 0; kx < 9; ++kx) { float c[8], sn[8]; unpack8f(*(const v4u*)(dm + (size_t)(4096 + kx) * KD + off), c); unpack8f(*(const v4u*)(dm + (size_t)(KH + 4096 + kx) * KD + off), sn);
#pragma unroll
                    for (int e = 0; e < 8; ++e) { se[kx] += ev[e] * c[e]; so[kx] += ov[e] * sn[e]; } } } }
        float ve = 0.f, vo = 0.f;
#pragma unroll
        for (int kx = 0; kx < 9; ++kx) { const float te = wave_sum(se[kx]), to = wave_sum(so[kx]); if (lane == kx) { ve = te; vo = to; } }
        if (lane < 9) { const int b = row >> 9, ch = row & 511, k = 4096 + lane;
            const unsigned w = cvt_pk_bf16(ve, vo);
            F[(size_t)row_of(b, k) * DM + ch] = (bf16)(w & 0xffffu); F[(size_t)row_of(b, k) * DM + 512 + ch] = (bf16)(w >> 16);
            if (k != NHALF) { F[(size_t)row_of(b, LSEQ - k) * DM + ch] = (bf16)(w & 0xffffu); F[(size_t)row_of(b, LSEQ - k) * DM + 512 + ch] = (bf16)((w >> 16) ^ 0x8000u); } }
    }
}

__device__ __forceinline__ void phase6(const Args& a, int gw, int NGW, int lane) {
    unsigned char* ws = a.ws; const bf16* mix = (const bf16*)(ws + WS_H); bf16* h2 = (bf16*)(ws + WS_H2);
    float g1[2][8], g2[2][8];
#pragma unroll
    for (int j = 0; j < 2; ++j) { load8f(a.in[I_GMIXPOST] + 8 * lane + 512 * j, g1[j]); load8f(a.in[I_GFFNPRE] + 8 * lane + 512 * j, g2[j]); }
    constexpr int NR = R_META + NB * NMETA;
    for (int r0 = gw; r0 < NR; r0 += 2 * NGW) {
        float mv[2][2][8], xv[2][2][8];
#pragma unroll
        for (int q = 0; q < 2; ++q) { const int r = (r0 + q * NGW < NR) ? r0 + q * NGW : r0;
            const float* src = r < R_META ? a.in[I_X] + (size_t)r * DM : a.in[I_META] + (size_t)((r - R_META) & 15) * DM;
#pragma unroll
            for (int j = 0; j < 2; ++j) { unpack8f(*(const v4u*)(mix + (size_t)r * DM + 8 * lane + 512 * j), mv[q][j]); load8f(src + 8 * lane + 512 * j, xv[q][j]); } }
#pragma unroll
        for (int q = 0; q < 2; ++q) { const int r = r0 + q * NGW; if (r >= NR) continue;
            float s = 0.f;
#pragma unroll
            for (int j = 0; j < 2; ++j)
#pragma unroll
                for (int e = 0; e < 8; ++e) s += mv[q][j][e] * mv[q][j][e];
            const float r1 = rsqrtf(wave_sum(s) * (1.0f / DM) + RMS_EPS); float s2 = 0.f;
#pragma unroll
            for (int j = 0; j < 2; ++j)
#pragma unroll
                for (int e = 0; e < 8; ++e) { const float hr = xv[q][j][e] + mv[q][j][e] * r1 * g1[j][e]; xv[q][j][e] = hr; s2 += hr * hr; }
            const float r2 = rsqrtf(wave_sum(s2) * (1.0f / DM) + RMS_EPS);
#pragma unroll
            for (int j = 0; j < 2; ++j) { float o[8];
#pragma unroll
                for (int e = 0; e < 8; ++e) o[e] = xv[q][j][e] * r2 * g2[j][e];
                *(v4u*)(h2 + (size_t)r * DM + 8 * lane + 512 * j) = pack8f(o); } }
    }
}

__device__ __forceinline__ float gelu_tanh(float x) { const float z2 = 1.5957691216057308f * (x + 0.044715f * x * x * x); return x * __builtin_amdgcn_rcpf(1.0f + __expf(-z2)); }
__device__ __forceinline__ void phase8(const Args& a, int c, int gw, int NGW, int lane) {
    unsigned char* ws = a.ws; const bf16* U = (const bf16*)(ws + WS_U); bf16* act = (bf16*)(ws + WS_ACT);
    const float* cw = a.in[I_CWFFN]; const float* cbias = a.in[I_CBFFN];
    constexpr int SEGF = 32, NSEG = 32768 / SEGF;
    for (int it = gw; it < 6 * NSEG; it += NGW) { const int s = it / NSEG, seg = it - s * NSEG; const int cgi = s * 64 + lane; if (cgi >= DFF / 8) continue;
        const int j0 = cgi * 8, ua = 256 * (j0 >> 7) + (j0 & 127), uv = ua + 128;
        float wa[3][8], wv[3][8], ba[8], bv[8];
#pragma unroll
        for (int k = 0; k < 3; ++k) { load8f(cw + (size_t)k * 2 * DFF + j0, wa[k]); load8f(cw + (size_t)k * 2 * DFF + DFF + j0, wv[k]); }
        load8f(cbias + j0, ba); load8f(cbias + DFF + j0, bv);
        const int lr0 = seg * SEGF;
        for (int q = 0; q < SEGF; q += 4) {
            float xa[6][8], xv[6][8];
#pragma unroll
            for (int t = 0; t < 6; ++t) { const int lr = lr0 + q + t - 1; int src = lr; bool ok = true;
                if (t == 0 && ((lr + 1) & 8191) == 0) src = 32768 + (c * 4 + ((lr + 1) >> 13)) * NMETA + (NMETA - 1);
                if (t == 5 && (lr & 8191) == 0) ok = false;
                if (ok) { unpack8f(*(const v4u*)(U + (size_t)src * (2 * DFF) + ua), xa[t]); unpack8f(*(const v4u*)(U + (size_t)src * (2 * DFF) + uv), xv[t]); }
                else {
#pragma unroll
                    for (int e = 0; e < 8; ++e) { xa[t][e] = 0.f; xv[t][e] = 0.f; } } }
#pragma unroll
            for (int t = 0; t < 4; ++t) { float o[8];
#pragma unroll
                for (int e = 0; e < 8; ++e) { const float ca = ba[e] + wa[0][e] * xa[t][e] + wa[1][e] * xa[t + 1][e] + wa[2][e] * xa[t + 2][e];
                    const float cv = bv[e] + wv[0][e] * xv[t][e] + wv[1][e] * xv[t + 1][e] + wv[2][e] * xv[t + 2][e]; o[e] = gelu_tanh(ca) * cv; }
                *(v4u*)(act + (size_t)(lr0 + q + t) * DFF + j0) = pack8f(o); }
        } }
}

__device__ __forceinline__ void phase10(const Args& a, int gw, int NGW, int lane) {
    unsigned char* ws = a.ws; const bf16* mix = (const bf16*)(ws + WS_H); const bf16* ffn = (const bf16*)(ws + WS_MG);
    float g1[2][8], g3[2][8];
#pragma unroll
    for (int j = 0; j < 2; ++j) { load8f(a.in[I_GMIXPOST] + 8 * lane + 512 * j, g1[j]); load8f(a.in[I_GFFNPOST] + 8 * lane + 512 * j, g3[j]); }
    for (int r0 = gw; r0 < R_META; r0 += 2 * NGW) {
        float mv[2][2][8], xv[2][2][8], fv[2][2][8];
#pragma unroll
        for (int q = 0; q < 2; ++q) { const int r = (r0 + q * NGW < R_META) ? r0 + q * NGW : r0;
#pragma unroll
            for (int j = 0; j < 2; ++j) { const size_t off = (size_t)r * DM + 8 * lane + 512 * j;
                unpack8f(*(const v4u*)(mix + off), mv[q][j]); unpack8f(*(const v4u*)(ffn + off), fv[q][j]); load8f(a.in[I_X] + off, xv[q][j]); } }
#pragma unroll
        for (int q = 0; q < 2; ++q) { const int r = r0 + q * NGW; if (r >= R_META) continue;
            float s = 0.f, s3 = 0.f;
#pragma unroll
            for (int j = 0; j < 2; ++j)
#pragma unroll
                for (int e = 0; e < 8; ++e) { s += mv[q][j][e] * mv[q][j][e]; s3 += fv[q][j][e] * fv[q][j][e]; }
            const float r1 = rsqrtf(wave_sum(s) * (1.0f / DM) + RMS_EPS), r3 = rsqrtf(wave_sum(s3) * (1.0f / DM) + RMS_EPS);
#pragma unroll
            for (int j = 0; j < 2; ++j) { float o[8];
#pragma unroll
                for (int e = 0; e < 8; ++e) o[e] = xv[q][j][e] + mv[q][j][e] * r1 * g1[j][e] + fv[q][j][e] * r3 * g3[j][e];
                float* op = a.out + (size_t)r * DM + 8 * lane + 512 * j;
                *(f32x4*)op = (f32x4){o[0], o[1], o[2], o[3]}; *(f32x4*)(op + 4) = (f32x4){o[4], o[5], o[6], o[7]}; } }
    }
}

constexpr int N_PHASES = 15;
__global__ void __launch_bounds__(NWAVES * 64, 2) fwd_megakernel(Args args) {
    extern __shared__ __attribute__((aligned(16))) unsigned char lds_raw[];
    LAS unsigned char* lds = (LAS unsigned char*)lds_raw;
    cg::grid_group grid = cg::this_grid();
    const int tid = threadIdx.x, lane = tid & 63, wave = __builtin_amdgcn_readfirstlane(tid >> 6);
    const int G = gridDim.x, bx = blockIdx.x;
    const int vcu = (G % 8 == 0) ? (bx % 8) * (G / 8) + bx / 8 : bx;
    const int gw = vcu * NWAVES + wave, NGW = G * NWAVES;
    unsigned char* ws = args.ws;
    const int lo = args.ph_lo, hi = args.ph_hi;
#ifndef PHASE_MASK
#define PHASE_MASK 0x7fff
#endif
#define IN(k) (((PHASE_MASK >> (k)) & 1) && lo <= (k) && (k) < hi)
#define SEAM(k) do { if ((k) + 1 < hi) grid.sync(); } while (0)
    using namespace pg8;
    if (IN(0)) { phase0(args, lds, gw, NGW, wave, lane); SEAM(0); }
    if (IN(1)) {
        Gemm g{(const bf16_t*)(ws + WS_H), (const bf16_t*)(ws + WS_WIN), DM}; Order S; S.init(R_TOT / 256, 0, -1, INC / 256, G, bx);
        EpiProj E{(bf16_t*)(ws + WS_PROJ), args.in[I_BGATES]};
        gemm_phase<EpiProj, Order>(lds, g, S, E); SEAM(1); }
    if (IN(2)) { phase2(args, lds, gw, NGW, wave, lane); SEAM(2); }
    if (IN(3)) {
        dft_tail(args, gw, NGW, lane);
        Gemm g{(const bf16_t*)((unsigned char*)args.out + DO_DM), (const bf16_t*)((unsigned char*)args.out + DO_UT), KD}; OrderDft S; S.init(G, bx);
        EpiDft E{(bf16_t*)(ws + WS_F)};
        gemm_phase<EpiDft, OrderDft>(lds, g, S, E); SEAM(3); }
    if (IN(4)) {
        Gemm g{(const bf16_t*)(ws + WS_F), (const bf16_t*)(ws + WS_WEFF), DM}; Order S; S.init(R_TOT / 256, 0, -1, DM / 256, G, bx);
        EpiYa E{(bf16_t*)(ws + WS_MG), (const bf16_t*)(ws + WS_PROJ)};
        gemm_phase<EpiYa, Order>(lds, g, S, E); SEAM(4); }
    if (IN(5)) {
        Gemm g{(const bf16_t*)(ws + WS_ZB), (const bf16_t*)(ws + WS_WCO), 512}; Order S; S.init(R_TOT / 256, 0, -1, DM / 256, G, bx);
        EpiYb E{(bf16_t*)(ws + WS_MG), (const bf16_t*)(ws + WS_PROJ)};
        gemm_phase<EpiYb, Order>(lds, g, S, E); SEAM(5); }
    if (IN(6)) {
        Gemm g{(const bf16_t*)(ws + WS_MG), (const bf16_t*)(ws + WS_WOUT), DM}; Order S; S.init(R_TOT / 256, 0, -1, DM / 256, G, bx);
        EpiStore E{(bf16_t*)(ws + WS_H), DM, 0, -1, 0};
        gemm_phase<EpiStore, Order>(lds, g, S, E); SEAM(6); }
    if (IN(7)) { phase6(args, gw, NGW, lane); SEAM(7); }
#pragma unroll
    for (int c = 0; c < 2; ++c) {
        const int p = 8 + 3 * c;
        if (IN(p)) {
            Gemm g{(const bf16_t*)(ws + WS_H2), (const bf16_t*)(ws + WS_WUP), DM}; Order S; S.init(128, 128 * c, c == 0 ? 256 : -1, 2 * DFF / 256, G, bx);
            EpiStore E{(bf16_t*)(ws + WS_U), 2 * DFF, 128 * c, 256, 128};
            gemm_phase<EpiStore, Order>(lds, g, S, E); SEAM(p); }
        if (IN(p + 1)) { phase8(args, c, gw, NGW, lane); SEAM(p + 1); }
        if (IN(p + 2)) {
            Gemm g{(const bf16_t*)(ws + WS_ACT), (const bf16_t*)(ws + WS_WDN), DFF}; Order S; S.init(128, 0, -1, DM / 256, G, bx);
            EpiStore E{(bf16_t*)(ws + WS_MG), DM, -128 * c, -1, 0};
            gemm_phase<EpiStore, Order>(lds, g, S, E); SEAM(p + 2); }
    }
    if (IN(14)) { phase10(args, gw, NGW, lane); }
#undef IN
#undef SEAM
}

extern "C" void kernel_launch(void* const* d_in, const int* in_sizes, int n_in, void* d_out, int out_size, void* d_ws, size_t ws_size, hipStream_t stream) {
    static int grid = 0;
    if (grid == 0) {
        if (n_in != 17 || ws_size < WS_NEED || out_size != NB * SEQ * DM) { fprintf(stderr, "kernel_launch: unexpected problem (n_in %d, ws %zu, out %d)\n", n_in, ws_size, out_size); grid = -1; return; }
        int dev = 0, cus = 0, per_cu = 0;
        if (hipGetDevice(&dev) != hipSuccess || hipDeviceGetAttribute(&cus, hipDeviceAttributeMultiprocessorCount, dev) != hipSuccess) { grid = -1; return; }
        if (hipFuncSetAttribute((const void*)fwd_megakernel, hipFuncAttributeMaxDynamicSharedMemorySize, LDS_BYTES) != hipSuccess) { fprintf(stderr, "kernel_launch: hipFuncSetAttribute failed\n"); grid = -1; return; }
        if (hipOccupancyMaxActiveBlocksPerMultiprocessor(&per_cu, (const void*)fwd_megakernel, NWAVES * 64, LDS_BYTES) != hipSuccess || per_cu < 1) { fprintf(stderr, "kernel_launch: occupancy query says %d\n", per_cu); per_cu = 1; }
        (void)hipGetLastError();
        grid = cus * 1;
    }
    if (grid < 0) return;
    Args a{};
    for (int i = 0; i < 17; ++i) a.in[i] = (const float*)d_in[i];
    a.out = (float*)d_out; a.ws = (unsigned char*)d_ws; a.ph_lo = 0; a.ph_hi = N_PHASES;
    void* kargs[] = {&a};
    hipError_t e = hipLaunchCooperativeKernel((const void*)fwd_megakernel, dim3(grid), dim3(NWAVES * 64), kargs, LDS_BYTES, stream);
    if (e != hipSuccess) fprintf(stderr, "kernel_launch: cooperative launch failed: %s (grid %d)\n", hipGetErrorString(e), grid);
}
```

```cpp
#include <hip/hip_runtime.h>
#include <hip/hip_cooperative_groups.h>
#include <cstdio>
#include <cstdint>
namespace cg = cooperative_groups;

constexpr int NB = 8, SEQ = 8192, NMETA = 16, LSEQ = 8208, DM = 1024, DFF = 2816, INC = 4096;
constexpr int R_META = 65536, R_TOT = 65792;
constexpr int KD = 4224, NHALF = LSEQ / 2;
constexpr int KH = 4352, KHT = 17;
constexpr float RMS_EPS = 1e-6f;
__device__ __forceinline__ int row_of(int b, int pos) { return pos >= NMETA ? b * SEQ + pos - NMETA : R_META + b * NMETA + pos; }

namespace pg8 {
#define PG8_LAS __attribute__((address_space(3)))
typedef unsigned short bf16_t;
typedef short bf16x8 __attribute__((ext_vector_type(8)));
typedef float f32x4 __attribute__((ext_vector_type(4)));
typedef unsigned u32x4 __attribute__((ext_vector_type(4)));
constexpr int BM = 256, BK = 64, HALF = 128, HTB = HALF * BK * 2, STAGE_BYTES = 8 * HTB, NXCD = 8, WGM = 8;

__host__ __device__ __forceinline__ int lds_byte(int r, int c) { const int st = (r >> 4) * 2 + (c >> 5), rr = r & 15, cc = c & 31, ob = rr * 64 + cc * 2; return st * 1024 + (ob ^ (((ob >> 9) & 1) << 5)); }
__host__ __device__ __forceinline__ void stage_rc(int b, int& R, int& C) { const int st = b / 1024, sb = b % 1024, swz = sb ^ (((sb >> 9) & 1) << 5); R = (st >> 1) * 16 + swz / 64; C = (st & 1) * 32 + (swz % 64) / 2; }
__host__ __device__ __forceinline__ int perm32(int rho) { const int n = rho >> 4, i = rho & 15; return 8 * (i >> 2) + 4 * n + (i & 3); }

struct Unit { int pm, pn; };
struct Gemm { const bf16_t* A; const bf16_t* Bt; int K; };

struct Order {
    int nM, nN, nwg, G, c, pm0, nMain, pm_extra;
    __device__ void init(int nMain_, int pm0_, int pm_extra_, int nN_, int G_, int c_) { nMain = nMain_; pm0 = pm0_; pm_extra = pm_extra_; nM = nMain_ + (pm_extra_ >= 0 ? 1 : 0); nN = nN_; nwg = nM * nN; G = G_; c = c_; }
    __device__ bool next(int i, Unit& u) const {
        const long L = (long)i * G + c; if (L >= nwg) return false;
        int wgid = (int)L; { const int q = nwg / NXCD, r = nwg % NXCD, xcd = wgid % NXCD, off = wgid / NXCD; wgid = (xcd < r ? xcd * (q + 1) : r * (q + 1) + (xcd - r) * q) + off; }
        const int nig = WGM * nN, gid = wgid / nig, fm = gid * WGM, gsz = (nM - fm) < WGM ? (nM - fm) : WGM;
        const int t = fm + ((wgid % nig) % gsz); u.pm = (t < nMain) ? pm0 + t : pm_extra; u.pn = (wgid % nig) / gsz; return true;
    }
    __device__ __forceinline__ void a_ready(const Unit&) const {}
    __device__ __forceinline__ void done(const Unit&) const {}
};
struct OrderDft {
    int G, c;
    __device__ void init(int G_, int c_) { G = G_; c = c_; }
    __device__ bool next(int i, Unit& u) const {
        constexpr int nM = 32, nN = 16, nwg = nM * nN;
        const long L = (long)i * G + c; if (L >= nwg) return false;
        int wgid = (int)L; { const int q = nwg / NXCD, xcd = wgid % NXCD, off = wgid / NXCD; wgid = xcd * q + off; }
        const int nig = WGM * nN, gid = wgid / nig, fm = gid * WGM;
        const int t = fm + ((wgid % nig) % WGM), pn = (wgid % nig) / WGM, part = t >> 4;
        u.pm = part * KHT + (t & 15); u.pn = part * 16 + pn; return true;
    }
    __device__ __forceinline__ void a_ready(const Unit&) const {}
    __device__ __forceinline__ void done(const Unit&) const {}
};
__device__ __forceinline__ unsigned cvt_pk_bf16(float lo, float hi) { unsigned r; asm volatile("v_cvt_pk_bf16_f32 %0, %1, %2" : "=v"(r) : "v"(lo), "v"(hi)); return r; }
__device__ __forceinline__ u32x4 pack8(const f32x4 v0, const f32x4 v1) { u32x4 w; w.x = cvt_pk_bf16(v0[0], v0[1]); w.y = cvt_pk_bf16(v0[2], v0[3]); w.z = cvt_pk_bf16(v1[0], v1[1]); w.w = cvt_pk_bf16(v1[2], v1[3]); return w; }
__device__ __forceinline__ float bflo(unsigned w) { return __uint_as_float(w << 16); }
__device__ __forceinline__ float bfhi(unsigned w) { return __uint_as_float(w & 0xffff0000u); }
__device__ __forceinline__ void unpack8(const u32x4 w, f32x4& v0, f32x4& v1) { v0 = (f32x4){bflo(w.x), bfhi(w.x), bflo(w.y), bfhi(w.y)}; v1 = (f32x4){bflo(w.z), bfhi(w.z), bflo(w.w), bfhi(w.w)}; }
__device__ __forceinline__ float sigmoidf_(float x) { return __builtin_amdgcn_rcpf(1.0f + __expf(-x)); }
#define EPI_LOOP_AM _Pragma("unroll") for (int ai = 0; ai < 2; ++ai) _Pragma("unroll") for (int m = 0; m < 4; ++m)
#define EPI_LOOP_BJ _Pragma("unroll") for (int bj = 0; bj < 2; ++bj)
typedef const f32x4 (&AccT)[2][2][4][2];

struct EpiProj { static constexpr bool PERM = true, AFTER_DRAIN = false, RPT = true;
    bf16_t* P; const float* bg;
    __device__ __forceinline__ void operator()(AccT acc, const Unit& u, int wr, int wc, int fr, int fq) const {
        const int row0 = u.pm * BM + wr * 64 + fr, colt = u.pn * BM + wc * 32 + 8 * fq;
        const bool gate = u.pn >= 8;
        f32x4 bv[2][2];
        EPI_LOOP_BJ { _Pragma("unroll") for (int n = 0; n < 2; ++n) bv[bj][n] = gate ? *(const f32x4*)(bg + (colt - 2048) + bj * HALF + 4 * n) : (f32x4){0.f, 0.f, 0.f, 0.f}; }
        EPI_LOOP_AM { bf16_t* rowp = P + (size_t)(row0 + ai * HALF + m * 16) * INC + colt;
            EPI_LOOP_BJ { f32x4 v0 = acc[ai][bj][m][0] + bv[bj][0], v1 = acc[ai][bj][m][1] + bv[bj][1];
                if (gate) { _Pragma("unroll") for (int j = 0; j < 4; ++j) { v0[j] = sigmoidf_(v0[j]); v1[j] = sigmoidf_(v1[j]); } }
                *(u32x4*)(rowp + bj * HALF) = pack8(v0, v1); } }
    }
};
struct EpiDft { static constexpr bool PERM = true, AFTER_DRAIN = false, RPT = true;
    bf16_t* F;
    __device__ __forceinline__ void operator()(AccT acc, const Unit& u, int wr, int wc, int fr, int fq) const {
        const int part = u.pm / KHT, kt = u.pm - part * KHT;
        const int colg = (u.pn & 15) * BM + wc * 32 + 8 * fq;
        const unsigned sgn = part ? 0x80008000u : 0u;
        EPI_LOOP_AM { const int k = kt * BM + ai * HALF + wr * 64 + m * 16 + fr;
            {
                EPI_LOOP_BJ { const int cg_ = colg + bj * HALF, b = cg_ >> 9, ch = cg_ & 511;
                    u32x4 w = pack8(acc[ai][bj][m][0], acc[ai][bj][m][1]);
                    *(u32x4*)(F + (size_t)row_of(b, k) * DM + part * 512 + ch) = w;
                    if (k >= 1) { w.x ^= sgn; w.y ^= sgn; w.z ^= sgn; w.w ^= sgn;
                        *(u32x4*)(F + (size_t)row_of(b, LSEQ - k) * DM + part * 512 + ch) = w; } } } }
    }
};
struct EpiYa { static constexpr bool PERM = true, AFTER_DRAIN = false, RPT = true;
    bf16_t* Mg; const bf16_t* P;
    __device__ __forceinline__ void operator()(AccT acc, const Unit& u, int wr, int wc, int fr, int fq) const {
        const int row0 = u.pm * BM + wr * 64 + fr, colt = u.pn * BM + wc * 32 + 8 * fq;
        EPI_LOOP_AM { const size_t row = (size_t)(row0 + ai * HALF + m * 16);
            EPI_LOOP_BJ { const u32x4 gw = *(const u32x4*)(P + row * INC + 2048 + colt + bj * HALF); f32x4 g0, g1; unpack8(gw, g0, g1);
                *(u32x4*)(Mg + row * DM + colt + bj * HALF) = pack8(acc[ai][bj][m][0] * g0, acc[ai][bj][m][1] * g1); }
            asm volatile("" ::: "memory"); }
    }
};
struct EpiYb { static constexpr bool PERM = true, AFTER_DRAIN = false, RPT = false;
    bf16_t* Mg; const bf16_t* P;
    __device__ __forceinline__ void operator()(AccT acc, const Unit& u, int wr, int wc, int fr, int fq) const {
        const int row0 = u.pm * BM + wr * 64 + fr, colt = u.pn * BM + wc * 32 + 8 * fq;
        EPI_LOOP_AM { const size_t row = (size_t)(row0 + ai * HALF + m * 16);
            EPI_LOOP_BJ { const u32x4 gw = *(const u32x4*)(P + row * INC + 3072 + colt + bj * HALF); f32x4 g0, g1; unpack8(gw, g0, g1);
                const u32x4 tw = *(const u32x4*)(Mg + row * DM + colt + bj * HALF); f32x4 t0, t1; unpack8(tw, t0, t1);
                *(u32x4*)(Mg + row * DM + colt + bj * HALF) = pack8(t0 + acc[ai][bj][m][0] * g0, t1 + acc[ai][bj][m][1] * g1); }
            asm volatile("" ::: "memory"); }
    }
};
struct EpiStore { static constexpr bool PERM = true, AFTER_DRAIN = false, RPT = true;
    bf16_t* O; int ldc, pm0, pm_extra, extra_local;
    __device__ __forceinline__ void operator()(AccT acc, const Unit& u, int wr, int wc, int fr, int fq) const {
        const int lt = (u.pm == pm_extra) ? extra_local : u.pm - pm0;
        const int row0 = lt * BM + wr * 64 + fr, colt = u.pn * BM + wc * 32 + 8 * fq;
        EPI_LOOP_AM { bf16_t* rowp = O + (size_t)(row0 + ai * HALF + m * 16) * ldc + colt;
            EPI_LOOP_BJ { *(u32x4*)(rowp + bj * HALF) = pack8(acc[ai][bj][m][0], acc[ai][bj][m][1]); } }
    }
};
struct EpiF32 { static constexpr bool PERM = false, AFTER_DRAIN = false, RPT = true;
    float* C; int ldc, tile_off;
    __device__ __forceinline__ void operator()(AccT acc, const Unit& u, int wr, int wc, int fr, int fq) const {
        const int row0 = (u.pm + tile_off) * BM + wr * 64 + fr, col0 = u.pn * BM + wc * 32 + 4 * fq;
        EPI_LOOP_AM { float* rowp = C + (size_t)(row0 + ai * HALF + m * 16) * ldc + col0;
            EPI_LOOP_BJ { _Pragma("unroll") for (int n = 0; n < 2; ++n) *(f32x4*)(rowp + bj * HALF + n * 16) = acc[ai][bj][m][n]; } }
    }
};

template <class Epi, class Sched, bool ALIGN_EPI = true, bool SP2 = true>
__device__ __forceinline__ void gemm_phase(PG8_LAS unsigned char* lds, const Gemm g, const Sched& S, const Epi& E) {
    const int tid = threadIdx.x, wid = __builtin_amdgcn_readfirstlane(tid >> 6), lane = tid & 63, wr = wid >> 2, wc = wid & 3, fr = lane & 15, fq = lane >> 4;
    const int K = g.K, nt = K / BK;
    unsigned voffA[2], voffB[2];
#pragma unroll
    for (int i = 0; i < 2; ++i) { int R, C; stage_rc(tid * 16 + i * 8192, R, C); const int Rb = Epi::PERM ? ((R & ~31) + perm32(R & 31)) : R;
        voffA[i] = (unsigned)(R * K + C) * 2u; voffB[i] = (unsigned)(Rb * K + C) * 2u; }
    const size_t kstep = (size_t)(BK * 2);
    const size_t hstep = (size_t)HALF * K * 2;
    const size_t tstep = 2 * hstep;
    const unsigned ldsw = (unsigned)wid * 1024u;
    const int aoff = lds_byte(wr * 64 + fr, fq * 8), boff = lds_byte(wc * 32 + fr, fq * 8);
#define PG8_SA(b, h) (((b) * 2 + (h)) * HTB)
#define PG8_SB(b, h) ((4 + (b) * 2 + (h)) * HTB)
#define PG8_STAGE(bufoff, gbase, voff) do { _Pragma("unroll") for (int _i = 0; _i < 2; ++_i) \
        __builtin_amdgcn_global_load_lds((const unsigned*)((const char*)(gbase) + (voff)[_i]), (PG8_LAS unsigned*)(lds + (bufoff) + ldsw + _i * 8192), 16, 0, 0); } while (0)
#define PG8_LDA(dst, b, h) do { _Pragma("unroll") for (int m = 0; m < 4; ++m) _Pragma("unroll") for (int k = 0; k < 2; ++k) dst[m][k] = *(const PG8_LAS bf16x8*)(lds + PG8_SA(b, h) + aoff + m * 2048 + k * 1024); } while (0)
#define PG8_LDB(dst, b, h) do { _Pragma("unroll") for (int n = 0; n < 2; ++n) _Pragma("unroll") for (int k = 0; k < 2; ++k) dst[n][k] = *(const PG8_LAS bf16x8*)(lds + PG8_SB(b, h) + boff + n * 2048 + k * 1024); } while (0)
#define PG8_MMA(ai, bj, At, Bt) do { __builtin_amdgcn_s_setprio(1); _Pragma("unroll") for (int m = 0; m < 4; ++m) _Pragma("unroll") for (int n = 0; n < 2; ++n) _Pragma("unroll") for (int k = 0; k < 2; ++k) \
        acc[ai][bj][m][n] = __builtin_amdgcn_mfma_f32_16x16x32_bf16(Bt[n][k], At[m][k], acc[ai][bj][m][n], 0, 0, 0); __builtin_amdgcn_s_setprio(0); } while (0)
#define PG8_WAIT_V(n) asm volatile("s_waitcnt vmcnt(" #n ")" ::: "memory")
#define PG8_WAIT_L(n) asm volatile("s_waitcnt lgkmcnt(" #n ")" ::: "memory")
#define PG8_BAR __builtin_amdgcn_s_barrier()
#define PG8_SCHED __builtin_amdgcn_sched_barrier(0)
    Unit cur, nxt; int ui = 0;
    if (!S.next(0, cur)) return;
    f32x4 acc[2][2][4][2];
#pragma unroll
    for (int a = 0; a < 2; ++a)
#pragma unroll
        for (int b = 0; b < 2; ++b)
#pragma unroll
            for (int m = 0; m < 4; ++m)
#pragma unroll
                for (int n = 0; n < 2; ++n) acc[a][b][m][n] = (f32x4){0.f, 0.f, 0.f, 0.f};
    bf16x8 At[4][2], B0[2][2], B1[2][2];
    const char* cA = (const char*)g.A + (size_t)cur.pm * tstep; const char* cB = (const char*)g.Bt + (size_t)cur.pn * tstep;
    S.a_ready(cur);
    if constexpr (SP2) {
        PG8_STAGE(PG8_SB(0, 0), cB, voffB); PG8_STAGE(PG8_SB(0, 1), cB + hstep, voffB); PG8_STAGE(PG8_SA(0, 0), cA, voffA); PG8_STAGE(PG8_SA(0, 1), cA + hstep, voffA);
        if (wr == 1) PG8_BAR;
        PG8_WAIT_V(2); PG8_BAR;
        PG8_STAGE(PG8_SB(1, 0), cB + kstep, voffB); PG8_STAGE(PG8_SA(1, 0), cA + kstep, voffA); PG8_STAGE(PG8_SB(1, 1), cB + hstep + kstep, voffB);
        PG8_WAIT_V(6); PG8_BAR;
    } else {
        PG8_STAGE(PG8_SB(0, 0), cB, voffB); PG8_STAGE(PG8_SA(0, 0), cA, voffA); PG8_STAGE(PG8_SB(0, 1), cB + hstep, voffB); PG8_STAGE(PG8_SA(0, 1), cA + hstep, voffA);
        if (wr == 1) PG8_BAR;
        PG8_WAIT_V(4); PG8_BAR;
        PG8_STAGE(PG8_SB(1, 0), cB + kstep, voffB); PG8_STAGE(PG8_SA(1, 0), cA + kstep, voffA); PG8_STAGE(PG8_SB(1, 1), cB + hstep + kstep, voffB);
        PG8_WAIT_V(6); PG8_BAR;
    }
    for (;;) {
        const bool has_next = S.next(ui + 1, nxt);
        const char* nA = has_next ? (const char*)g.A + (size_t)nxt.pm * tstep : cA; const char* nB = has_next ? (const char*)g.Bt + (size_t)nxt.pn * tstep : cB;
        for (int t = 0; t < nt; t += 2) {
            const bool last = (t == nt - 2);
            const char* a1 = cA + (size_t)(t + 1) * kstep;
            const char* a2 = last ? nA : cA + (size_t)(t + 2) * kstep; const char* b2 = last ? nB : cB + (size_t)(t + 2) * kstep;
            const char* a3 = a2 + kstep; const char* b3 = b2 + kstep;
            if (last && has_next) S.a_ready(nxt);
            if constexpr (SP2) {
            PG8_LDB(B0, 0, 0); PG8_LDB(B1, 0, 1); PG8_SCHED; PG8_LDA(At, 0, 0); PG8_STAGE(PG8_SA(1, 1), a1 + hstep, voffA);
            PG8_WAIT_V(8); PG8_WAIT_L(0); PG8_BAR; PG8_MMA(0, 0, At, B0); PG8_MMA(0, 1, At, B1); PG8_BAR; PG8_SCHED;
            PG8_LDA(At, 0, 1); PG8_STAGE(PG8_SB(0, 0), b2, voffB); PG8_STAGE(PG8_SB(0, 1), b2 + hstep, voffB); PG8_STAGE(PG8_SA(0, 0), a2, voffA);
            PG8_WAIT_V(8); PG8_WAIT_L(0); PG8_BAR; PG8_MMA(1, 0, At, B0); PG8_MMA(1, 1, At, B1); PG8_BAR; PG8_SCHED;
            PG8_LDB(B0, 1, 0); PG8_LDB(B1, 1, 1); PG8_SCHED; PG8_LDA(At, 1, 0); PG8_STAGE(PG8_SA(0, 1), a2 + hstep, voffA);
            PG8_WAIT_V(8); PG8_WAIT_L(0); PG8_BAR; PG8_MMA(0, 0, At, B0); PG8_MMA(0, 1, At, B1); PG8_BAR; PG8_SCHED;
            PG8_LDA(At, 1, 1); PG8_STAGE(PG8_SB(1, 0), b3, voffB); PG8_STAGE(PG8_SB(1, 1), b3 + hstep, voffB); PG8_STAGE(PG8_SA(1, 0), a3, voffA);
            PG8_WAIT_V(8); PG8_WAIT_L(0); PG8_BAR; PG8_MMA(1, 0, At, B0); PG8_MMA(1, 1, At, B1); PG8_BAR; PG8_SCHED;
            } else {
            PG8_LDB(B0, 0, 0); PG8_SCHED; PG8_LDA(At, 0, 0); PG8_STAGE(PG8_SA(1, 1), a1 + hstep, voffA);
            PG8_WAIT_L(8); PG8_BAR; PG8_WAIT_L(0); PG8_MMA(0, 0, At, B0); PG8_BAR; PG8_SCHED;
            PG8_LDB(B1, 0, 1); PG8_STAGE(PG8_SB(0, 0), b2, voffB);
            PG8_BAR; PG8_WAIT_L(0); PG8_MMA(0, 1, At, B1); PG8_BAR;
            PG8_LDA(At, 0, 1); PG8_STAGE(PG8_SA(0, 0), a2, voffA);
            PG8_BAR; PG8_WAIT_L(0); PG8_MMA(1, 0, At, B0); PG8_BAR; PG8_SCHED;
            PG8_STAGE(PG8_SB(0, 1), b2 + hstep, voffB);
            PG8_WAIT_V(6); PG8_BAR; PG8_MMA(1, 1, At, B1); PG8_BAR;
            PG8_LDB(B0, 1, 0); PG8_SCHED; PG8_LDA(At, 1, 0); PG8_STAGE(PG8_SA(0, 1), a2 + hstep, voffA);
            PG8_WAIT_L(8); PG8_BAR; PG8_WAIT_L(0); PG8_MMA(0, 0, At, B0); PG8_BAR; PG8_SCHED;
            PG8_LDB(B1, 1, 1); PG8_STAGE(PG8_SB(1, 0), b3, voffB);
            PG8_BAR; PG8_WAIT_L(0); PG8_MMA(0, 1, At, B1); PG8_BAR;
            PG8_LDA(At, 1, 1); PG8_STAGE(PG8_SA(1, 0), a3, voffA);
            PG8_BAR; PG8_WAIT_L(0); PG8_MMA(1, 0, At, B0); PG8_BAR; PG8_SCHED;
            PG8_STAGE(PG8_SB(1, 1), b3 + hstep, voffB);
            PG8_WAIT_V(6); PG8_BAR; PG8_MMA(1, 1, At, B1); PG8_BAR;
            }
        }
        if constexpr (ALIGN_EPI) { if (wr == 0) PG8_BAR; }
        if constexpr (!Epi::AFTER_DRAIN) { E(acc, cur, wr, wc, fr, fq);
#ifdef PROBE_EPI2
            if constexpr (Epi::RPT) { asm volatile("" ::: "memory"); E(acc, cur, wr, wc, fr, fq); }
#endif
            S.done(cur); }
        if (!has_next) break;
#pragma unroll
        for (int a = 0; a < 2; ++a)
#pragma unroll
            for (int b = 0; b < 2; ++b)
#pragma unroll
                for (int m = 0; m < 4; ++m)
#pragma unroll
                    for (int n = 0; n < 2; ++n) acc[a][b][m][n] = (f32x4){0.f, 0.f, 0.f, 0.f};
        cur = nxt; cA = nA; cB = nB; ++ui;
        if constexpr (ALIGN_EPI) { if (wr == 1) PG8_BAR; }
    }
    PG8_WAIT_V(0);
    if constexpr (!ALIGN_EPI) { if (wr == 0) PG8_BAR; }
    PG8_BAR;
    if constexpr (Epi::AFTER_DRAIN) { E.fused(acc, cur, wr, wc, fr, fq, lds, wid, lane); S.done(cur); }
#undef PG8_SA
#undef PG8_SB
#undef PG8_STAGE
#undef PG8_LDA
#undef PG8_LDB
#undef PG8_MMA
#undef PG8_WAIT_V
#undef PG8_WAIT_L
#undef PG8_BAR
#undef PG8_SCHED
}
}

constexpr int NWAVES = 8;
constexpr int LDS_BYTES = 147456;
constexpr size_t MiB = 1u << 20;
constexpr size_t WS_WIN = 1 * MiB, WS_WEFF = 9 * MiB, WS_WCO = 11 * MiB, WS_WOUT = 12 * MiB, WS_WUP = 14 * MiB, WS_WDN = 25 * MiB;
constexpr size_t WS_H = 32 * MiB;
constexpr size_t WS_PROJ = 161 * MiB;
constexpr size_t WS_H2 = 161 * MiB;
constexpr size_t WS_U = 290 * MiB;
constexpr size_t WS_ACT = 645 * MiB;
constexpr size_t WS_ZB = 675 * MiB;
constexpr size_t WS_F = 740 * MiB;
constexpr size_t WS_MG = 869 * MiB;
constexpr size_t WS_NEED = 1000 * MiB;
constexpr size_t DO_DM = 0, DO_UT = 72 * MiB;
static_assert((size_t)2 * KH * KD * 2 <= DO_UT && DO_UT + (size_t)2 * 4096 * KD * 2 <= 256 * MiB, "d_out scratch map");
static_assert(WS_H + (size_t)R_TOT * DM * 2 <= WS_PROJ && WS_PROJ + (size_t)R_TOT * INC * 2 <= WS_ZB && WS_ZB + (size_t)R_TOT * 512 * 2 <= WS_F && WS_F + (size_t)R_TOT * DM * 2 <= WS_MG && WS_MG + (size_t)R_TOT * DM * 2 <= WS_NEED, "ws map 1");
static_assert(WS_H2 + (size_t)R_TOT * DM * 2 <= WS_U && WS_U + (size_t)33024 * 5632 * 2 <= WS_ACT && WS_ACT + (size_t)32768 * DFF * 2 <= WS_NEED, "ws map 2");

#define LAS __attribute__((address_space(3)))
typedef unsigned short bf16;
typedef unsigned v4u __attribute__((ext_vector_type(4)));
typedef unsigned v2u __attribute__((ext_vector_type(2)));
typedef float f32x4 __attribute__((ext_vector_type(4)));
#define LDS_WAIT() asm volatile("s_waitcnt lgkmcnt(0)" ::: "memory")
using pg8::cvt_pk_bf16; using pg8::bflo; using pg8::bfhi;

__device__ __forceinline__ float wave_sum(float v) {
#pragma unroll
    for (int o = 1; o < 64; o <<= 1) v += __shfl_xor(v, o);
    return v;
}
__device__ __forceinline__ void unpack8f(const v4u w, float (&f)[8]) { f[0] = bflo(w.x); f[1] = bfhi(w.x); f[2] = bflo(w.y); f[3] = bfhi(w.y); f[4] = bflo(w.z); f[5] = bfhi(w.z); f[6] = bflo(w.w); f[7] = bfhi(w.w); }
__device__ __forceinline__ v4u pack8f(const float (&f)[8]) { v4u w; w.x = cvt_pk_bf16(f[0], f[1]); w.y = cvt_pk_bf16(f[2], f[3]); w.z = cvt_pk_bf16(f[4], f[5]); w.w = cvt_pk_bf16(f[6], f[7]); return w; }
__device__ __forceinline__ void load8f(const float* p, float (&f)[8]) { const f32x4 a = *(const f32x4*)p, b = *(const f32x4*)(p + 4); f[0] = a.x; f[1] = a.y; f[2] = a.z; f[3] = a.w; f[4] = b.x; f[5] = b.y; f[6] = b.z; f[7] = b.w; }

struct Args { const float* in[17]; float* out; unsigned char* ws; int ph_lo, ph_hi; };
enum { I_X = 0, I_META, I_GMIXPRE, I_WIN, I_BGATES, I_WFOURIER, I_CWMIX, I_CBMIX, I_WCONVOUT, I_WOUT, I_GMIXPOST, I_GFFNPRE, I_WUP, I_CWFFN, I_CBFFN, I_WDOWN, I_GFFNPOST };

__device__ __forceinline__ void p0_transpose_item(const float* __restrict__ W, int K, int N, bf16* __restrict__ WT, int k0, int n0, int drow0, LAS float* scr, int lane) {
#pragma unroll 8
    for (int i = 0; i < 32; ++i) { const int kk = 2 * i + (lane >> 5); scr[kk * 33 + (lane & 31)] = W[(size_t)(k0 + kk) * N + n0 + (lane & 31)]; }
    LDS_WAIT();
    const int c = lane & 7;
#pragma unroll
    for (int j = 0; j < 4; ++j) { const int n = (lane >> 3) + 8 * j; const LAS float* s = scr + (8 * c) * 33 + n;
        v4u o; o.x = cvt_pk_bf16(s[0 * 33], s[1 * 33]); o.y = cvt_pk_bf16(s[2 * 33], s[3 * 33]); o.z = cvt_pk_bf16(s[4 * 33], s[5 * 33]); o.w = cvt_pk_bf16(s[6 * 33], s[7 * 33]);
        *(v4u*)(WT + (size_t)(drow0 + n) * K + k0 + 8 * c) = o; }
    LDS_WAIT();
}
__device__ __forceinline__ int wup_drow(int n0) { return n0 < DFF ? 256 * (n0 >> 7) + (n0 & 127) : 256 * ((n0 - DFF) >> 7) + 128 + ((n0 - DFF) & 127); }

__device__ __forceinline__ void phase0(const Args& a, LAS unsigned char* lds, int gw, int NGW, int wave, int lane) {
    unsigned char* ws = a.ws;
    LAS float* scr = (LAS float*)(lds + wave * 16384);
    constexpr int T_IN = 16 * 128, T_CO = 8 * 32, T_OUT = 16 * 32, T_UP = 16 * 176, T_DN = 44 * 32, T_ALL = T_IN + T_CO + T_OUT + T_UP + T_DN;
    for (int it = gw; it < T_ALL; it += NGW) {
        int r = it;
        if (r < T_IN) { const int kb = r / 128, nb = r % 128; p0_transpose_item(a.in[I_WIN], DM, INC, (bf16*)(ws + WS_WIN), kb * 64, nb * 32, nb * 32, scr, lane); continue; } r -= T_IN;
        if (r < T_CO) { const int kb = r / 32, nb = r % 32; p0_transpose_item(a.in[I_WCONVOUT], 512, DM, (bf16*)(ws + WS_WCO), kb * 64, nb * 32, nb * 32, scr, lane); continue; } r -= T_CO;
        if (r < T_OUT) { const int kb = r / 32, nb = r % 32; p0_transpose_item(a.in[I_WOUT], DM, DM, (bf16*)(ws + WS_WOUT), kb * 64, nb * 32, nb * 32, scr, lane); continue; } r -= T_OUT;
        if (r < T_UP) { const int kb = r / 176, nb = r % 176; p0_transpose_item(a.in[I_WUP], DM, 2 * DFF, (bf16*)(ws + WS_WUP), kb * 64, nb * 32, wup_drow(nb * 32), scr, lane); continue; } r -= T_UP;
        { const int kb = r / 32, nb = r % 32; p0_transpose_item(a.in[I_WDOWN], DFF, DM, (bf16*)(ws + WS_WDN), kb * 64, nb * 32, nb * 32, scr, lane); }
    }
    { const float* wf = a.in[I_WFOURIER]; bf16* we = (bf16*)(ws + WS_WEFF);
      for (int it = gw; it < 8192; it += NGW) { const int jb = it & 15, c = (it >> 4) & 127, g = it >> 11, j = jb * 64 + lane;
          float ac = 0.f, as = 0.f;
#pragma unroll 4
          for (int cp = 0; cp < 128; ++cp) { const float w = wf[(size_t)(g * 128 + cp) * DM + j]; const float ph = (float)((c * cp) & 127) * (1.0f / 128.0f);
              ac += __builtin_amdgcn_cosf(ph) * w; as += __builtin_amdgcn_sinf(ph) * w; }
          const float s = 0.08838834764831845f;
          we[(size_t)j * DM + g * 128 + c] = (bf16)(cvt_pk_bf16(ac * s, 0.f) & 0xffffu); we[(size_t)j * DM + 512 + g * 128 + c] = (bf16)(cvt_pk_bf16(as * s, 0.f) & 0xffffu); } }
    { bf16* dmat = (bf16*)((unsigned char*)a.out + DO_DM); constexpr int CPR = KD / 8;
      for (int it = gw; it < 2 * KH * CPR / 64; it += NGW) { const int chunk = it * 64 + lane, row = chunk / CPR, ci = chunk - row * CPR, n0 = ci * 8, part = row >= KH, k = row - part * KH;
          int mm = (int)(((unsigned)k * (unsigned)n0) % (unsigned)LSEQ); float f[8];
#pragma unroll
          for (int i = 0; i < 8; ++i) { const float ph = (float)mm * (1.0f / (float)LSEQ); const float v = part ? -__builtin_amdgcn_sinf(ph) : __builtin_amdgcn_cosf(ph);
              f[i] = (n0 + i <= NHALF) ? v * 0.011037770f : 0.f; mm += k; if (mm >= LSEQ) mm -= LSEQ; }
          *(v4u*)(dmat + (size_t)row * KD + n0) = pack8f(f); } }
    { const float* g = a.in[I_GMIXPRE]; bf16* h = (bf16*)(ws + WS_H);
      f32x4 gv[4];
#pragma unroll
      for (int j = 0; j < 4; ++j) gv[j] = ((const f32x4*)g)[lane + 64 * j];
      for (int r0 = gw; r0 < R_TOT; r0 += 2 * NGW) {
          f32x4 v[2][4]; float s2[2];
#pragma unroll
          for (int q = 0; q < 2; ++q) { const int r = r0 + q * NGW; s2[q] = 0.f;
              if (r < R_META + NB * NMETA) { const float* src = r < R_META ? a.in[I_X] + (size_t)r * DM : a.in[I_META] + (size_t)((r - R_META) & 15) * DM;
#pragma unroll
                  for (int j = 0; j < 4; ++j) v[q][j] = ((const f32x4*)src)[lane + 64 * j]; }
              else {
#pragma unroll
                  for (int j = 0; j < 4; ++j) v[q][j] = (f32x4){0.f, 0.f, 0.f, 0.f}; } }
#pragma unroll
          for (int q = 0; q < 2; ++q) {
#pragma unroll
              for (int j = 0; j < 4; ++j) s2[q] += (v[q][j].x * v[q][j].x + v[q][j].y * v[q][j].y) + (v[q][j].z * v[q][j].z + v[q][j].w * v[q][j].w); }
#pragma unroll
          for (int q = 0; q < 2; ++q) { const int r = r0 + q * NGW; if (r >= R_TOT) continue;
              const float rstd = rsqrtf(wave_sum(s2[q]) * (1.0f / DM) + RMS_EPS);
              unsigned long long* o8 = (unsigned long long*)(h + (size_t)r * DM) + lane;
#pragma unroll
              for (int j = 0; j < 4; ++j) { const f32x4 o = v[q][j] * rstd * gv[j]; o8[64 * j] = (unsigned long long)cvt_pk_bf16(o.x, o.y) | ((unsigned long long)cvt_pk_bf16(o.z, o.w) << 32); } }
      } }
}

__device__ __forceinline__ void phase2(const Args& a, LAS unsigned char* lds, int gw, int NGW, int wave, int lane) {
    unsigned char* ws = a.ws; const bf16* proj = (const bf16*)(ws + WS_PROJ);
    { bf16* eT = (bf16*)((unsigned char*)a.out + DO_UT); bf16* oT = eT + (size_t)4096 * KD;
      LAS bf16* scrE = (LAS bf16*)(lds + wave * 16896); LAS bf16* scrO = scrE + 64 * 66;
      constexpr int NBLK = KD / 64;
      for (int it = gw; it < NB * 8 * NBLK; it += NGW) { const int nblk = it % NBLK, cb = (it / NBLK) & 7, b = it / (8 * NBLK);
#pragma unroll
          for (int i = 0; i < 8; ++i) { const int nl = i * 8 + (lane >> 3), nh = nblk * 64 + nl, chunk = lane & 7;
              float e[8], o[8];
#pragma unroll
              for (int j = 0; j < 8; ++j) { e[j] = 0.f; o[j] = 0.f; }
              if (nh <= NHALF) { unpack8f(*(const v4u*)(proj + (size_t)row_of(b, nh) * INC + cb * 64 + chunk * 8), e);
                  if (nh >= 1 && nh < NHALF) { float u2[8]; unpack8f(*(const v4u*)(proj + (size_t)row_of(b, LSEQ - nh) * INC + cb * 64 + chunk * 8), u2);
#pragma unroll
                      for (int j = 0; j < 8; ++j) { o[j] = e[j] - u2[j]; e[j] = e[j] + u2[j]; } } }
              LAS bf16* dE = scrE + (chunk * 8) * 66 + nl; LAS bf16* dO = scrO + (chunk * 8) * 66 + nl;
#pragma unroll
              for (int j = 0; j < 8; ++j) { const unsigned w = cvt_pk_bf16(e[j], o[j]); dE[j * 66] = (bf16)(w & 0xffffu); dO[j * 66] = (bf16)(w >> 16); } }
          LDS_WAIT();
#pragma unroll
          for (int i = 0; i < 8; ++i) { const int ch = i * 8 + (lane >> 3), nc = lane & 7; const size_t off = (size_t)(b * 512 + cb * 64 + ch) * KD + nblk * 64 + nc * 8;
              const LAS unsigned* se = (const LAS unsigned*)(scrE + ch * 66 + nc * 8); const LAS unsigned* so = (const LAS unsigned*)(scrO + ch * 66 + nc * 8);
              v4u w; w.x = se[0]; w.y = se[1]; w.z = se[2]; w.w = se[3]; *(v4u*)(eT + off) = w;
              w.x = so[0]; w.y = so[1]; w.z = so[2]; w.w = so[3]; *(v4u*)(oT + off) = w; }
          LDS_WAIT(); } }
    { bf16* zb = (bf16*)(ws + WS_ZB); const float* cw = a.in[I_CWMIX]; const float* cbias = a.in[I_CBMIX];
      float w0[8], w1[8], w2[8], bb[8]; const int ch0 = lane * 8;
      load8f(cw + ch0, w0); load8f(cw + 512 + ch0, w1); load8f(cw + 1024 + ch0, w2); load8f(cbias + ch0, bb);
      for (int it = gw; it < NB * LSEQ; it += NGW) { const int b = it / LSEQ, p = it - b * LSEQ; const size_t r = (size_t)row_of(b, p);
          float cc[8], vv[8], bg[8], acc[8];
          unpack8f(*(const v4u*)(proj + r * INC + 512 + ch0), cc); unpack8f(*(const v4u*)(proj + r * INC + 1536 + ch0), vv); unpack8f(*(const v4u*)(proj + r * INC + 1024 + ch0), bg);
#pragma unroll
          for (int e = 0; e < 8; ++e) acc[e] = bb[e] + w1[e] * (cc[e] * vv[e]);
          if (p > 0) { const size_t rp = (size_t)row_of(b, p - 1); unpack8f(*(const v4u*)(proj + rp * INC + 512 + ch0), cc); unpack8f(*(const v4u*)(proj + rp * INC + 1536 + ch0), vv);
#pragma unroll
              for (int e = 0; e < 8; ++e) acc[e] += w0[e] * (cc[e] * vv[e]); }
          if (p < LSEQ - 1) { const size_t rn = (size_t)row_of(b, p + 1); unpack8f(*(const v4u*)(proj + rn * INC + 512 + ch0), cc); unpack8f(*(const v4u*)(proj + rn * INC + 1536 + ch0), vv);
#pragma unroll
              for (int e = 0; e < 8; ++e) acc[e] += w2[e] * (cc[e] * vv[e]); }
#pragma unroll
          for (int e = 0; e < 8; ++e) acc[e] *= bg[e];
          *(v4u*)(zb + r * 512 + ch0) = pack8f(acc); } }
}

__device__ __forceinline__ void dft_tail(const Args& a, int gw, int NGW, int lane) {
    const bf16* dm = (const bf16*)((unsigned char*)a.out + DO_DM); const bf16* eT = (const bf16*)((unsigned char*)a.out + DO_UT); const bf16* oT = eT + (size_t)4096 * KD;
    bf16* F = (bf16*)(a.ws + WS_F);
    for (int row = gw; row < 4096; row += NGW) {
        float se[9], so[9];
#pragma unroll
        for (int kx = 0; kx < 9; ++kx) { se[kx] = 0.f; so[kx] = 0.f; }
        for (int it = 0; it < 9; ++it) { const int off = it * 512 + lane * 8;
            if (off < KD) { float ev[8], ov[8]; unpack8f(*(const v4u*)(eT + (size_t)row * KD + off), ev); unpack8f(*(const v4u*)(oT + (size_t)row * KD + off), ov);
#pragma unroll
                for (int kx = 0; kx < 9; ++kx) { float c[8], sn[8]; unpack8f(*(const v4u*)(dm + (size_t)(4096 + kx) * KD + off), c); unpack8f(*(const v4u*)(dm + (size_t)(KH + 4096 + kx) * KD + off), sn);
#pragma unroll
                    for (int e = 0; e < 8; ++e) { se[kx] += ev[e] * c[e]; so[kx] += ov[e] * sn[e]; } } } }
        float ve = 0.f, vo = 0.f;
#pragma unroll
        for (int kx = 0; kx < 9; ++kx) { const float te = wave_sum(se[kx]), to = wave_sum(so[kx]); if (lane == kx) { ve = te; vo = to; } }
        if (lane < 9) { const int b = row >> 9, ch = row & 511, k = 4096 + lane;
            const unsigned w = cvt_pk_bf16(ve, vo);
            F[(size_t)row_of(b, k) * DM + ch] = (bf16)(w & 0xffffu); F[(size_t)row_of(b, k) * DM + 512 + ch] = (bf16)(w >> 16);
            if (k != NHALF) { F[(size_t)row_of(b, LSEQ - k) * DM + ch] = (bf16)(w & 0xffffu); F[(size_t)row_of(b, LSEQ - k) * DM + 512 + ch] = (bf16)((w >> 16) ^ 0x8000u); } }
    }
}

__device__ __forceinline__ void phase6(const Args& a, int gw, int NGW, int lane) {
    unsigned char* ws = a.ws; const bf16* mix = (const bf16*)(ws + WS_H); bf16* h2 = (bf16*)(ws + WS_H2);
    float g1[2][8], g2[2][8];
#pragma unroll
    for (int j = 0; j < 2; ++j) { load8f(a.in[I_GMIXPOST] + 8 * lane + 512 * j, g1[j]); load8f(a.in[I_GFFNPRE] + 8 * lane + 512 * j, g2[j]); }
    constexpr int NR = R_META + NB * NMETA;
    for (int r0 = gw; r0 < NR; r0 += 2 * NGW) {
        float mv[2][2][8], xv[2][2][8];
#pragma unroll
        for (int q = 0; q < 2; ++q) { const int r = (r0 + q * NGW < NR) ? r0 + q * NGW : r0;
            const float* src = r < R_META ? a.in[I_X] + (size_t)r * DM : a.in[I_META] + (size_t)((r - R_META) & 15) * DM;
#pragma unroll
            for (int j = 0; j < 2; ++j) { unpack8f(*(const v4u*)(mix + (size_t)r * DM + 8 * lane + 512 * j), mv[q][j]); load8f(src + 8 * lane + 512 * j, xv[q][j]); } }
#pragma unroll
        for (int q = 0; q < 2; ++q) { const int r = r0 + q * NGW; if (r >= NR) continue;
            float s = 0.f;
#pragma unroll
            for (int j = 0; j < 2; ++j)
#pragma unroll
                for (int e = 0; e < 8; ++e) s += mv[q][j][e] * mv[q][j][e];
            const float r1 = rsqrtf(wave_sum(s) * (1.0f / DM) + RMS_EPS); float s2 = 0.f;
#pragma unroll
            for (int j = 0; j < 2; ++j)
#pragma unroll
                for (int e = 0; e < 8; ++e) { const float hr = xv[q][j][e] + mv[q][j][e] * r1 * g1[j][e]; xv[q][j][e] = hr; s2 += hr * hr; }
            const float r2 = rsqrtf(wave_sum(s2) * (1.0f / DM) + RMS_EPS);
#pragma unroll
            for (int j = 0; j < 2; ++j) { float o[8];
#pragma unroll
                for (int e = 0; e < 8; ++e) o[e] = xv[q][j][e] * r2 * g2[j][e];
                *(v4u*)(h2 + (size_t)r * DM + 8 * lane + 512 * j) = pack8f(o); } }
    }
}

__device__ __forceinline__ float gelu_tanh(float x) { const float z2 = 1.5957691216057308f * (x + 0.044715f * x * x * x); return x * __builtin_amdgcn_rcpf(1.0f + __expf(-z2)); }
__device__ __forceinline__ void phase8(const Args& a, int c, int gw, int NGW, int lane) {
    unsigned char* ws = a.ws; const bf16* U = (const bf16*)(ws + WS_U); bf16* act = (bf16*)(ws + WS_ACT);
    const float* cw = a.in[I_CWFFN]; const float* cbias = a.in[I_CBFFN];
    constexpr int SEGF = 32, NSEG = 32768 / SEGF;
    for (int it = gw; it < 6 * NSEG; it += NGW) { const int s = it / NSEG, seg = it - s * NSEG; const int cgi = s * 64 + lane; if (cgi >= DFF / 8) continue;
        const int j0 = cgi * 8, ua = 256 * (j0 >> 7) + (j0 & 127), uv = ua + 128;
        float wa[3][8], wv[3][8], ba[8], bv[8];
#pragma unroll
        for (int k = 0; k < 3; ++k) { load8f(cw + (size_t)k * 2 * DFF + j0, wa[k]); load8f(cw + (size_t)k * 2 * DFF + DFF + j0, wv[k]); }
        load8f(cbias + j0, ba); load8f(cbias + DFF + j0, bv);
        const int lr0 = seg * SEGF;
        for (int q = 0; q < SEGF; q += 4) {
            float xa[6][8], xv[6][8];
#pragma unroll
            for (int t = 0; t < 6; ++t) { const int lr = lr0 + q + t - 1; int src = lr; bool ok = true;
                if (t == 0 && ((lr + 1) & 8191) == 0) src = 32768 + (c * 4 + ((lr + 1) >> 13)) * NMETA + (NMETA - 1);
                if (t == 5 && (lr & 8191) == 0) ok = false;
                if (ok) { unpack8f(*(const v4u*)(U + (size_t)src * (2 * DFF) + ua), xa[t]); unpack8f(*(const v4u*)(U + (size_t)src * (2 * DFF) + uv), xv[t]); }
                else {
#pragma unroll
                    for (int e = 0; e < 8; ++e) { xa[t][e] = 0.f; xv[t][e] = 0.f; } } }
#pragma unroll
            for (int t = 0; t < 4; ++t) { float o[8];
#pragma unroll
                for (int e = 0; e < 8; ++e) { const float ca = ba[e] + wa[0][e] * xa[t][e] + wa[1][e] * xa[t + 1][e] + wa[2][e] * xa[t + 2][e];
                    const float cv = bv[e] + wv[0][e] * xv[t][e] + wv[1][e] * xv[t + 1][e] + wv[2][e] * xv[t + 2][e]; o[e] = gelu_tanh(ca) * cv; }
                *(v4u*)(act + (size_t)(lr0 + q + t) * DFF + j0) = pack8f(o); }
        } }
}

__device__ __forceinline__ void phase10(const Args& a, int gw, int NGW, int lane) {
    unsigned char* ws = a.ws; const bf16* mix = (const bf16*)(ws + WS_H); const bf16* ffn = (const bf16*)(ws + WS_MG);
    float g1[2][8], g3[2][8];
#pragma unroll
    for (int j = 0; j < 2; ++j) { load8f(a.in[I_GMIXPOST] + 8 * lane + 512 * j, g1[j]); load8f(a.in[I_GFFNPOST] + 8 * lane + 512 * j, g3[j]); }
    for (int r0 = gw; r0 < R_META; r0 += 2 * NGW) {
        float mv[2][2][8], xv[2][2][8], fv[2][2][8];
#pragma unroll
        for (int q = 0; q < 2; ++q) { const int r = (r0 + q * NGW < R_META) ? r0 + q * NGW : r0;
#pragma unroll
            for (int j = 0; j < 2; ++j) { const size_t off = (size_t)r * DM + 8 * lane + 512 * j;
                unpack8f(*(const v4u*)(mix + off), mv[q][j]); unpack8f(*(const v4u*)(ffn + off), fv[q][j]); load8f(a.in[I_X] + off, xv[q][j]); } }
#pragma unroll
        for (int q = 0; q < 2; ++q) { const int r = r0 + q * NGW; if (r >= R_META) continue;
            float s = 0.f, s3 = 0.f;
#pragma unroll
            for (int j = 0; j < 2; ++j)
#pragma unroll
                for (int e = 0; e < 8; ++e) { s += mv[q][j][e] * mv[q][j][e]; s3 += fv[q][j][e] * fv[q][j][e]; }
            const float r1 = rsqrtf(wave_sum(s) * (1.0f / DM) + RMS_EPS), r3 = rsqrtf(wave_sum(s3) * (1.0f / DM) + RMS_EPS);
#pragma unroll
            for (int j = 0; j < 2; ++j) { float o[8];
#pragma unroll
                for (int e = 0; e < 8; ++e) o[e] = xv[q][j][e] + mv[q][j][e] * r1 * g1[j][e] + fv[q][j][e] * r3 * g3[j][e];
                float* op = a.out + (size_t)r * DM + 8 * lane + 512 * j;
                *(f32x4*)op = (f32x4){o[0], o[1], o[2], o[3]}; *(f32x4*)(op + 4) = (f32x4){o[4], o[5], o[6], o[7]}; } }
    }
}

#define XB_TMO      128
#define XB_XCNT(j)  (256  + 64 * (j))
#define XB_XSUB(j)  (1280 + 64 * (j))
#define XB_XGEN(j)  (2304 + 64 * (j))
#define XB_TOP      3328
#define XB_TOPGEN   3392
#define XCD_BAR_WORDS 3456
#define XB_SPIN_CAP (1u << 18)

__device__ __forceinline__ unsigned xb_ld(unsigned* p)              { return __hip_atomic_load(p, __ATOMIC_RELAXED, __HIP_MEMORY_SCOPE_AGENT); }
__device__ __forceinline__ unsigned xb_add(unsigned* p, unsigned v) { return __hip_atomic_fetch_add(p, v, __ATOMIC_RELAXED, __HIP_MEMORY_SCOPE_AGENT); }
__device__ __forceinline__ unsigned xb_xcc_id() { return (unsigned)__builtin_amdgcn_s_getreg((3 << 11) | 20) & 0xFu; }
#define XB_SPIN(cond, bar) do { unsigned _sp = 0; while (cond) { __builtin_amdgcn_s_sleep(1); \
    if ((++_sp & 255u) == 0u) { if (xb_ld(&(bar)[XB_TMO])) break; if (_sp > XB_SPIN_CAP) { atomicAdd(&(bar)[XB_TMO], 1u); break; } } } } while (0)

struct XcdBarrier {
    unsigned* bar; unsigned x;
    volatile LAS unsigned* st;
};

__device__ __forceinline__ XcdBarrier xcd_barrier_post(unsigned* bar, volatile LAS unsigned* st) {
    XcdBarrier b; b.bar = bar; b.x = xb_xcc_id(); b.st = st;
    if (threadIdx.x == 0) (void)xb_add(&bar[XB_XCNT(b.x)], 1u);
    return b;
}
__device__ __forceinline__ void xcd_barrier_complete(unsigned* bar, unsigned x, unsigned& nloc, unsigned& nx) {
    const unsigned G = gridDim.x * gridDim.y * gridDim.z;
    unsigned sum, cnt, mine, sp = 0u;
    for (;;) {
        sum = 0u; cnt = 0u; mine = 0u;
#pragma unroll
        for (unsigned j = 0; j < 16; ++j) { const unsigned c = xb_ld(&bar[XB_XCNT(j)]); sum += c; cnt += (c > 0u) ? 1u : 0u; mine = (j == x) ? c : mine; }
        if (sum == G) break;
        __builtin_amdgcn_s_sleep(1);
        if ((++sp & 255u) == 0u) { if (xb_ld(&bar[XB_TMO])) break; if (sp > XB_SPIN_CAP) { atomicAdd(&bar[XB_TMO], 1u); break; } }
    }
    nloc = mine > 0u ? mine : 1u; nx = cnt > 0u ? cnt : 1u;
}

__device__ __forceinline__ void xcd_barrier(const XcdBarrier& b) {
    asm volatile("s_waitcnt vmcnt(0)" ::: "memory");
    __syncthreads();
    if (threadIdx.x == 0) {
        unsigned* bar = b.bar;
        __builtin_amdgcn_s_waitcnt(0);
        unsigned nloc = b.st[0], nx = b.st[1];
        if (nloc == 0u) { xcd_barrier_complete(bar, b.x, nloc, nx); b.st[0] = nloc; b.st[1] = nx; }
        const unsigned old = xb_add(&bar[XB_XSUB(b.x)], 1u);
        const unsigned gen = old / nloc;
        if (old + 1u == (gen + 1u) * nloc) {
            __builtin_amdgcn_fence(__ATOMIC_RELEASE, "agent");
            asm volatile("s_waitcnt vmcnt(0)" ::: "memory");
            const unsigned og = xb_add(&bar[XB_TOP], 1u);
            const unsigned tg = og / nx;
            if (og + 1u == (tg + 1u) * nx) xb_add(&bar[XB_TOPGEN], 1u);
            else XB_SPIN(xb_ld(&bar[XB_TOPGEN]) == tg, bar);
            __builtin_amdgcn_fence(__ATOMIC_ACQUIRE, "agent");
            xb_add(&bar[XB_XGEN(b.x)], 1u);
            asm volatile("s_waitcnt vmcnt(0)" ::: "memory");
        } else {
            XB_SPIN(xb_ld(&bar[XB_XGEN(b.x)]) == gen, bar);
            __builtin_amdgcn_fence(__ATOMIC_ACQUIRE, "agent");
            asm volatile("s_waitcnt vmcnt(0)" ::: "memory");
        }
    }
    __syncthreads();
}


#ifndef STAGGER_TICKS
#define STAGGER_TICKS 1000
#endif
__device__ __forceinline__ void stagger(int bx, unsigned ticks) {
    const unsigned frac = __brev((unsigned)bx) >> 24;
    const unsigned long long t0 = __builtin_amdgcn_s_memrealtime(), dt = (unsigned long long)ticks * frac / 256;
    while (__builtin_amdgcn_s_memrealtime() - t0 < dt) __builtin_amdgcn_s_sleep(8);
}

constexpr int N_PHASES = 15;
__global__ void __launch_bounds__(NWAVES * 64, 2) fwd_megakernel(Args args) {
    extern __shared__ __attribute__((aligned(16))) unsigned char lds_raw[];
    LAS unsigned char* lds = (LAS unsigned char*)lds_raw;
    cg::grid_group grid = cg::this_grid();
    const int tid = threadIdx.x, lane = tid & 63, wave = __builtin_amdgcn_readfirstlane(tid >> 6);
    const int G = gridDim.x, bx = blockIdx.x;
    const int vcu = (G % 8 == 0) ? (bx % 8) * (G / 8) + bx / 8 : bx;
    const int gw = vcu * NWAVES + wave, NGW = G * NWAVES;
    unsigned char* ws = args.ws;
    const int lo = args.ph_lo, hi = args.ph_hi;
    unsigned* barw = (unsigned*)ws;
    volatile LAS unsigned* MISC = (volatile LAS unsigned*)(lds + LDS_BYTES - 256);
    if (bx == 0) for (int i = tid; i < XCD_BAR_WORDS; i += NWAVES * 64) barw[i] = 0u;
    if (tid < 2) MISC[tid] = 0u;
    __syncthreads();
    XcdBarrier xbar; xbar.bar = barw; xbar.x = 0; xbar.st = MISC;
#ifndef PHASE_MASK
#define PHASE_MASK 0x7fff
#endif
#define IN(k) (((PHASE_MASK >> (k)) & 1) && lo <= (k) && (k) < hi)
#define SEAM(k) do { if ((k) + 1 < hi) { if ((k) == 0) { grid.sync(); xbar = xcd_barrier_post(barw, MISC); } else xcd_barrier(xbar); } } while (0)
    using namespace pg8;
    if (IN(0)) { phase0(args, lds, gw, NGW, wave, lane);
#ifdef PROBE_ELEM2
        __syncthreads(); phase0(args, lds, gw, NGW, wave, lane);
#endif
        SEAM(0); }
    if (IN(1)) {
        Gemm g{(const bf16_t*)(ws + WS_H), (const bf16_t*)(ws + WS_WIN), DM}; Order S; S.init(R_TOT / 256, 0, -1, INC / 256, G, bx);
        EpiProj E{(bf16_t*)(ws + WS_PROJ), args.in[I_BGATES]};
        gemm_phase<EpiProj, Order>(lds, g, S, E); SEAM(1); }
    if (IN(2)) { phase2(args, lds, gw, NGW, wave, lane);
#ifdef PROBE_ELEM2
        __syncthreads(); phase2(args, lds, gw, NGW, wave, lane);
#endif
        SEAM(2); }
    if (IN(3)) {
        dft_tail(args, gw, NGW, lane);
        Gemm g{(const bf16_t*)((unsigned char*)args.out + DO_DM), (const bf16_t*)((unsigned char*)args.out + DO_UT), KD}; OrderDft S; S.init(G, bx);
        EpiDft E{(bf16_t*)(ws + WS_F)};
        gemm_phase<EpiDft, OrderDft>(lds, g, S, E); SEAM(3); }
    if (IN(4)) {
        Gemm g{(const bf16_t*)(ws + WS_F), (const bf16_t*)(ws + WS_WEFF), DM}; Order S; S.init(R_TOT / 256, 0, -1, DM / 256, G, bx);
        EpiYa E{(bf16_t*)(ws + WS_MG), (const bf16_t*)(ws + WS_PROJ)};
        gemm_phase<EpiYa, Order>(lds, g, S, E); SEAM(4); }
    if (IN(5)) {
        Gemm g{(const bf16_t*)(ws + WS_ZB), (const bf16_t*)(ws + WS_WCO), 512}; Order S; S.init(R_TOT / 256, 0, -1, DM / 256, G, bx);
        EpiYb E{(bf16_t*)(ws + WS_MG), (const bf16_t*)(ws + WS_PROJ)};
        gemm_phase<EpiYb, Order>(lds, g, S, E); SEAM(5); }
    if (IN(6)) {
        Gemm g{(const bf16_t*)(ws + WS_MG), (const bf16_t*)(ws + WS_WOUT), DM}; Order S; S.init(R_TOT / 256, 0, -1, DM / 256, G, bx);
        EpiStore E{(bf16_t*)(ws + WS_H), DM, 0, -1, 0};
        gemm_phase<EpiStore, Order>(lds, g, S, E); SEAM(6); }
    if (IN(7)) { phase6(args, gw, NGW, lane);
#ifdef PROBE_ELEM2
        phase6(args, gw, NGW, lane);
#endif
        SEAM(7); }
#pragma unroll
    for (int c = 0; c < 2; ++c) {
        const int p = 8 + 3 * c;
        if (IN(p)) {
            Gemm g{(const bf16_t*)(ws + WS_H2), (const bf16_t*)(ws + WS_WUP), DM}; Order S; S.init(128, 128 * c, c == 0 ? 256 : -1, 2 * DFF / 256, G, bx);
            EpiStore E{(bf16_t*)(ws + WS_U), 2 * DFF, 128 * c, 256, 128};
            gemm_phase<EpiStore, Order>(lds, g, S, E); SEAM(p); }
        if (IN(p + 1)) { phase8(args, c, gw, NGW, lane);
#ifdef PROBE_ELEM2
            phase8(args, c, gw, NGW, lane);
#endif
            SEAM(p + 1); }
        if (IN(p + 2)) {
            Gemm g{(const bf16_t*)(ws + WS_ACT), (const bf16_t*)(ws + WS_WDN), DFF}; Order S; S.init(128, 0, -1, DM / 256, G, bx);
            EpiStore E{(bf16_t*)(ws + WS_MG), DM, -128 * c, -1, 0};
            gemm_phase<EpiStore, Order>(lds, g, S, E); SEAM(p + 2); }
    }
    #ifdef PROBE_SYNC10
    for (int q = 0; q < 10; ++q) grid.sync();
#endif
    if (IN(14)) { phase10(args, gw, NGW, lane);
#ifdef PROBE_ELEM2
        phase10(args, gw, NGW, lane);
#endif
    }
#undef IN
#undef SEAM
}

extern "C" void kernel_launch(void* const* d_in, const int* in_sizes, int n_in, void* d_out, int out_size, void* d_ws, size_t ws_size, hipStream_t stream) {
    static int grid = 0;
    if (grid == 0) {
        if (n_in != 17 || ws_size < WS_NEED || out_size != NB * SEQ * DM) { fprintf(stderr, "kernel_launch: unexpected problem (n_in %d, ws %zu, out %d)\n", n_in, ws_size, out_size); grid = -1; return; }
        int dev = 0, cus = 0, per_cu = 0;
        if (hipGetDevice(&dev) != hipSuccess || hipDeviceGetAttribute(&cus, hipDeviceAttributeMultiprocessorCount, dev) != hipSuccess) { grid = -1; return; }
        if (hipFuncSetAttribute((const void*)fwd_megakernel, hipFuncAttributeMaxDynamicSharedMemorySize, LDS_BYTES) != hipSuccess) { fprintf(stderr, "kernel_launch: hipFuncSetAttribute failed\n"); grid = -1; return; }
        if (hipOccupancyMaxActiveBlocksPerMultiprocessor(&per_cu, (const void*)fwd_megakernel, NWAVES * 64, LDS_BYTES) != hipSuccess || per_cu < 1) { fprintf(stderr, "kernel_launch: occupancy query says %d\n", per_cu); per_cu = 1; }
        (void)hipGetLastError();
        grid = cus * 1;
    }
    if (grid < 0) return;
    Args a{};
    for (int i = 0; i < 17; ++i) a.in[i] = (const float*)d_in[i];
    a.out = (float*)d_out; a.ws = (unsigned char*)d_ws; a.ph_lo = 0; a.ph_hi = N_PHASES;
    void* kargs[] = {&a};
    hipError_t e = hipLaunchCooperativeKernel((const void*)fwd_megakernel, dim3(grid), dim3(NWAVES * 64), kargs, LDS_BYTES, stream);
    if (e != hipSuccess) fprintf(stderr, "kernel_launch: cooperative launch failed: %s (grid %d)\n", hipGetErrorString(e), grid);
}
```

```cpp
#include <hip/hip_runtime.h>
#include <hip/hip_cooperative_groups.h>
#include <cstdio>
#include <cstdint>
namespace cg = cooperative_groups;

constexpr int NB = 8, SEQ = 8192, NMETA = 16, LSEQ = 8208, DM = 1024, DFF = 2816, INC = 4096;
constexpr int R_META = 65536, R_TOT = 65792;
constexpr int KD = 4224, NHALF = LSEQ / 2;
constexpr int KH = 4352, KHT = 17;
constexpr float RMS_EPS = 1e-6f;
__device__ __forceinline__ int row_of(int b, int pos) { return pos >= NMETA ? b * SEQ + pos - NMETA : R_META + b * NMETA + pos; }

namespace pg8 {
#define PG8_LAS __attribute__((address_space(3)))
typedef unsigned short bf16_t;
typedef short bf16x8 __attribute__((ext_vector_type(8)));
typedef float f32x4 __attribute__((ext_vector_type(4)));
typedef unsigned u32x4 __attribute__((ext_vector_type(4)));
constexpr int BM = 256, BK = 64, HALF = 128, HTB = HALF * BK * 2, STAGE_BYTES = 8 * HTB, NXCD = 8, WGM = 8;

__host__ __device__ __forceinline__ int lds_byte(int r, int c) { const int st = (r >> 4) * 2 + (c >> 5), rr = r & 15, cc = c & 31, ob = rr * 64 + cc * 2; return st * 1024 + (ob ^ (((ob >> 9) & 1) << 5)); }
__host__ __device__ __forceinline__ void stage_rc(int b, int& R, int& C) { const int st = b / 1024, sb = b % 1024, swz = sb ^ (((sb >> 9) & 1) << 5); R = (st >> 1) * 16 + swz / 64; C = (st & 1) * 32 + (swz % 64) / 2; }
__host__ __device__ __forceinline__ int perm32(int rho) { const int n = rho >> 4, i = rho & 15; return 8 * (i >> 2) + 4 * n + (i & 3); }

struct Unit { int pm, pn; };
struct Gemm { const bf16_t* A; const bf16_t* Bt; int K; };

struct Order {
    int nM, nN, nwg, G, c, pm0, nMain, pm_extra;
    __device__ void init(int nMain_, int pm0_, int pm_extra_, int nN_, int G_, int c_) { nMain = nMain_; pm0 = pm0_; pm_extra = pm_extra_; nM = nMain_ + (pm_extra_ >= 0 ? 1 : 0); nN = nN_; nwg = nM * nN; G = G_; c = c_; }
    __device__ bool next(int i, Unit& u) const {
        const long L = (long)i * G + c; if (L >= nwg) return false;
        int wgid = (int)L; { const int q = nwg / NXCD, r = nwg % NXCD, xcd = wgid % NXCD, off = wgid / NXCD; wgid = (xcd < r ? xcd * (q + 1) : r * (q + 1) + (xcd - r) * q) + off; }
        const int nig = WGM * nN, gid = wgid / nig, fm = gid * WGM, gsz = (nM - fm) < WGM ? (nM - fm) : WGM;
        const int t = fm + ((wgid % nig) % gsz); u.pm = (t < nMain) ? pm0 + t : pm_extra; u.pn = (wgid % nig) / gsz; return true;
    }
    __device__ __forceinline__ void a_ready(const Unit&) const {}
    __device__ __forceinline__ void done(const Unit&) const {}
};
struct OrderDft {
    int G, c;
    __device__ void init(int G_, int c_) { G = G_; c = c_; }
    __device__ bool next(int i, Unit& u) const {
        constexpr int nM = 32, nN = 16, nwg = nM * nN;
        const long L = (long)i * G + c; if (L >= nwg) return false;
        int wgid = (int)L; { const int q = nwg / NXCD, xcd = wgid % NXCD, off = wgid / NXCD; wgid = xcd * q + off; }
        const int nig = WGM * nN, gid = wgid / nig, fm = gid * WGM;
        const int t = fm + ((wgid % nig) % WGM), pn = (wgid % nig) / WGM, part = t >> 4;
        u.pm = part * KHT + (t & 15); u.pn = part * 16 + pn; return true;
    }
    __device__ __forceinline__ void a_ready(const Unit&) const {}
    __device__ __forceinline__ void done(const Unit&) const {}
};
__device__ __forceinline__ unsigned cvt_pk_bf16(float lo, float hi) { unsigned r; asm volatile("v_cvt_pk_bf16_f32 %0, %1, %2" : "=v"(r) : "v"(lo), "v"(hi)); return r; }
__device__ __forceinline__ u32x4 pack8(const f32x4 v0, const f32x4 v1) { u32x4 w; w.x = cvt_pk_bf16(v0[0], v0[1]); w.y = cvt_pk_bf16(v0[2], v0[3]); w.z = cvt_pk_bf16(v1[0], v1[1]); w.w = cvt_pk_bf16(v1[2], v1[3]); return w; }
__device__ __forceinline__ float bflo(unsigned w) { return __uint_as_float(w << 16); }
__device__ __forceinline__ float bfhi(unsigned w) { return __uint_as_float(w & 0xffff0000u); }
__device__ __forceinline__ void unpack8(const u32x4 w, f32x4& v0, f32x4& v1) { v0 = (f32x4){bflo(w.x), bfhi(w.x), bflo(w.y), bfhi(w.y)}; v1 = (f32x4){bflo(w.z), bfhi(w.z), bflo(w.w), bfhi(w.w)}; }
__device__ __forceinline__ float sigmoidf_(float x) { return __builtin_amdgcn_rcpf(1.0f + __expf(-x)); }
#define EPI_LOOP_AM _Pragma("unroll") for (int ai = 0; ai < 2; ++ai) _Pragma("unroll") for (int m = 0; m < 4; ++m)
#define EPI_LOOP_BJ _Pragma("unroll") for (int bj = 0; bj < 2; ++bj)
typedef const f32x4 (&AccT)[2][2][4][2];

struct EpiProj { static constexpr bool PERM = true, AFTER_DRAIN = false, RPT = true;
    bf16_t* P; const float* bg;
    __device__ __forceinline__ void operator()(AccT acc, const Unit& u, int wr, int wc, int fr, int fq) const {
        const int row0 = u.pm * BM + wr * 64 + fr, colt = u.pn * BM + wc * 32 + 8 * fq;
        const bool gate = u.pn >= 8;
        f32x4 bv[2][2];
        EPI_LOOP_BJ { _Pragma("unroll") for (int n = 0; n < 2; ++n) bv[bj][n] = gate ? *(const f32x4*)(bg + (colt - 2048) + bj * HALF + 4 * n) : (f32x4){0.f, 0.f, 0.f, 0.f}; }
        EPI_LOOP_AM { bf16_t* rowp = P + (size_t)(row0 + ai * HALF + m * 16) * INC + colt;
            EPI_LOOP_BJ { f32x4 v0 = acc[ai][bj][m][0] + bv[bj][0], v1 = acc[ai][bj][m][1] + bv[bj][1];
                if (gate) { _Pragma("unroll") for (int j = 0; j < 4; ++j) { v0[j] = sigmoidf_(v0[j]); v1[j] = sigmoidf_(v1[j]); } }
                *(u32x4*)(rowp + bj * HALF) = pack8(v0, v1); } }
    }
};
struct EpiDft { static constexpr bool PERM = true, AFTER_DRAIN = false, RPT = true;
    bf16_t* F;
    __device__ __forceinline__ void operator()(AccT acc, const Unit& u, int wr, int wc, int fr, int fq) const {
        const int part = u.pm / KHT, kt = u.pm - part * KHT;
        const int colg = (u.pn & 15) * BM + wc * 32 + 8 * fq;
        const unsigned sgn = part ? 0x80008000u : 0u;
        EPI_LOOP_AM { const int k = kt * BM + ai * HALF + wr * 64 + m * 16 + fr;
            {
                EPI_LOOP_BJ { const int cg_ = colg + bj * HALF, b = cg_ >> 9, ch = cg_ & 511;
                    u32x4 w = pack8(acc[ai][bj][m][0], acc[ai][bj][m][1]);
                    *(u32x4*)(F + (size_t)row_of(b, k) * DM + part * 512 + ch) = w;
                    if (k >= 1) { w.x ^= sgn; w.y ^= sgn; w.z ^= sgn; w.w ^= sgn;
                        *(u32x4*)(F + (size_t)row_of(b, LSEQ - k) * DM + part * 512 + ch) = w; } } } }
    }
};
struct EpiYa { static constexpr bool PERM = true, AFTER_DRAIN = false, RPT = true;
    bf16_t* Mg; const bf16_t* P;
    __device__ __forceinline__ void operator()(AccT acc, const Unit& u, int wr, int wc, int fr, int fq) const {
        const int row0 = u.pm * BM + wr * 64 + fr, colt = u.pn * BM + wc * 32 + 8 * fq;
        EPI_LOOP_AM { const size_t row = (size_t)(row0 + ai * HALF + m * 16);
            EPI_LOOP_BJ { const u32x4 gw = *(const u32x4*)(P + row * INC + 2048 + colt + bj * HALF); f32x4 g0, g1; unpack8(gw, g0, g1);
                *(u32x4*)(Mg + row * DM + colt + bj * HALF) = pack8(acc[ai][bj][m][0] * g0, acc[ai][bj][m][1] * g1); }
            asm volatile("" ::: "memory"); }
    }
};
struct EpiYb { static constexpr bool PERM = true, AFTER_DRAIN = false, RPT = false;
    bf16_t* Mg; const bf16_t* P;
    __device__ __forceinline__ void operator()(AccT acc, const Unit& u, int wr, int wc, int fr, int fq) const {
        const int row0 = u.pm * BM + wr * 64 + fr, colt = u.pn * BM + wc * 32 + 8 * fq;
        EPI_LOOP_AM { const size_t row = (size_t)(row0 + ai * HALF + m * 16);
            EPI_LOOP_BJ { const u32x4 gw = *(const u32x4*)(P + row * INC + 3072 + colt + bj * HALF); f32x4 g0, g1; unpack8(gw, g0, g1);
                const u32x4 tw = *(const u32x4*)(Mg + row * DM + colt + bj * HALF); f32x4 t0, t1; unpack8(tw, t0, t1);
                *(u32x4*)(Mg + row * DM + colt + bj * HALF) = pack8(t0 + acc[ai][bj][m][0] * g0, t1 + acc[ai][bj][m][1] * g1); }
            asm volatile("" ::: "memory"); }
    }
};
struct EpiStore { static constexpr bool PERM = true, AFTER_DRAIN = false, RPT = true;
    bf16_t* O; int ldc, pm0, pm_extra, extra_local;
    __device__ __forceinline__ void operator()(AccT acc, const Unit& u, int wr, int wc, int fr, int fq) const {
        const int lt = (u.pm == pm_extra) ? extra_local : u.pm - pm0;
        const int row0 = lt * BM + wr * 64 + fr, colt = u.pn * BM + wc * 32 + 8 * fq;
        EPI_LOOP_AM { bf16_t* rowp = O + (size_t)(row0 + ai * HALF + m * 16) * ldc + colt;
            EPI_LOOP_BJ { *(u32x4*)(rowp + bj * HALF) = pack8(acc[ai][bj][m][0], acc[ai][bj][m][1]); } }
    }
};
struct EpiF32 { static constexpr bool PERM = false, AFTER_DRAIN = false, RPT = true;
    float* C; int ldc, tile_off;
    __device__ __forceinline__ void operator()(AccT acc, const Unit& u, int wr, int wc, int fr, int fq) const {
        const int row0 = (u.pm + tile_off) * BM + wr * 64 + fr, col0 = u.pn * BM + wc * 32 + 4 * fq;
        EPI_LOOP_AM { float* rowp = C + (size_t)(row0 + ai * HALF + m * 16) * ldc + col0;
            EPI_LOOP_BJ { _Pragma("unroll") for (int n = 0; n < 2; ++n) *(f32x4*)(rowp + bj * HALF + n * 16) = acc[ai][bj][m][n]; } }
    }
};

template <class Epi, class Sched, bool ALIGN_EPI = true, bool SP2 = true>
__device__ __forceinline__ void gemm_phase(PG8_LAS unsigned char* lds, const Gemm g, const Sched& S, const Epi& E) {
    const int tid = threadIdx.x, wid = __builtin_amdgcn_readfirstlane(tid >> 6), lane = tid & 63, wr = wid >> 2, wc = wid & 3, fr = lane & 15, fq = lane >> 4;
    const int K = g.K, nt = K / BK;
    unsigned voffA[2], voffB[2];
#pragma unroll
    for (int i = 0; i < 2; ++i) { int R, C; stage_rc(tid * 16 + i * 8192, R, C); const int Rb = Epi::PERM ? ((R & ~31) + perm32(R & 31)) : R;
        voffA[i] = (unsigned)(R * K + C) * 2u; voffB[i] = (unsigned)(Rb * K + C) * 2u; }
    const size_t kstep = (size_t)(BK * 2);
    const size_t hstep = (size_t)HALF * K * 2;
    const size_t tstep = 2 * hstep;
    const unsigned ldsw = (unsigned)wid * 1024u;
    const int aoff = lds_byte(wr * 64 + fr, fq * 8), boff = lds_byte(wc * 32 + fr, fq * 8);
#define PG8_SA(b, h) (((b) * 2 + (h)) * HTB)
#define PG8_SB(b, h) ((4 + (b) * 2 + (h)) * HTB)
#define PG8_STAGE(bufoff, gbase, voff) do { _Pragma("unroll") for (int _i = 0; _i < 2; ++_i) \
        __builtin_amdgcn_global_load_lds((const unsigned*)((const char*)(gbase) + (voff)[_i]), (PG8_LAS unsigned*)(lds + (bufoff) + ldsw + _i * 8192), 16, 0, 0); } while (0)
#define PG8_LDA(dst, b, h) do { _Pragma("unroll") for (int m = 0; m < 4; ++m) _Pragma("unroll") for (int k = 0; k < 2; ++k) dst[m][k] = *(const PG8_LAS bf16x8*)(lds + PG8_SA(b, h) + aoff + m * 2048 + k * 1024); } while (0)
#define PG8_LDB(dst, b, h) do { _Pragma("unroll") for (int n = 0; n < 2; ++n) _Pragma("unroll") for (int k = 0; k < 2; ++k) dst[n][k] = *(const PG8_LAS bf16x8*)(lds + PG8_SB(b, h) + boff + n * 2048 + k * 1024); } while (0)
#define PG8_MMA(ai, bj, At, Bt) do { __builtin_amdgcn_s_setprio(1); _Pragma("unroll") for (int m = 0; m < 4; ++m) _Pragma("unroll") for (int n = 0; n < 2; ++n) _Pragma("unroll") for (int k = 0; k < 2; ++k) \
        acc[ai][bj][m][n] = __builtin_amdgcn_mfma_f32_16x16x32_bf16(Bt[n][k], At[m][k], acc[ai][bj][m][n], 0, 0, 0); __builtin_amdgcn_s_setprio(0); } while (0)
#define PG8_WAIT_V(n) asm volatile("s_waitcnt vmcnt(" #n ")" ::: "memory")
#define PG8_WAIT_L(n) asm volatile("s_waitcnt lgkmcnt(" #n ")" ::: "memory")
#define PG8_BAR __builtin_amdgcn_s_barrier()
#define PG8_SCHED __builtin_amdgcn_sched_barrier(0)
    Unit cur, nxt; int ui = 0;
    if (!S.next(0, cur)) return;
    f32x4 acc[2][2][4][2];
#pragma unroll
    for (int a = 0; a < 2; ++a)
#pragma unroll
        for (int b = 0; b < 2; ++b)
#pragma unroll
            for (int m = 0; m < 4; ++m)
#pragma unroll
                for (int n = 0; n < 2; ++n) acc[a][b][m][n] = (f32x4){0.f, 0.f, 0.f, 0.f};
    bf16x8 At[4][2], B0[2][2], B1[2][2];
    const char* cA = (const char*)g.A + (size_t)cur.pm * tstep; const char* cB = (const char*)g.Bt + (size_t)cur.pn * tstep;
    S.a_ready(cur);
    if constexpr (SP2) {
        PG8_STAGE(PG8_SB(0, 0), cB, voffB); PG8_STAGE(PG8_SB(0, 1), cB + hstep, voffB); PG8_STAGE(PG8_SA(0, 0), cA, voffA); PG8_STAGE(PG8_SA(0, 1), cA + hstep, voffA);
        if (wr == 1) PG8_BAR;
        PG8_WAIT_V(2); PG8_BAR;
        PG8_STAGE(PG8_SB(1, 0), cB + kstep, voffB); PG8_STAGE(PG8_SA(1, 0), cA + kstep, voffA); PG8_STAGE(PG8_SB(1, 1), cB + hstep + kstep, voffB);
        PG8_WAIT_V(6); PG8_BAR;
    } else {
        PG8_STAGE(PG8_SB(0, 0), cB, voffB); PG8_STAGE(PG8_SA(0, 0), cA, voffA); PG8_STAGE(PG8_SB(0, 1), cB + hstep, voffB); PG8_STAGE(PG8_SA(0, 1), cA + hstep, voffA);
        if (wr == 1) PG8_BAR;
        PG8_WAIT_V(4); PG8_BAR;
        PG8_STAGE(PG8_SB(1, 0), cB + kstep, voffB); PG8_STAGE(PG8_SA(1, 0), cA + kstep, voffA); PG8_STAGE(PG8_SB(1, 1), cB + hstep + kstep, voffB);
        PG8_WAIT_V(6); PG8_BAR;
    }
    for (;;) {
        const bool has_next = S.next(ui + 1, nxt);
        const char* nA = has_next ? (const char*)g.A + (size_t)nxt.pm * tstep : cA; const char* nB = has_next ? (const char*)g.Bt + (size_t)nxt.pn * tstep : cB;
        for (int t = 0; t < nt; t += 2) {
            const bool last = (t == nt - 2);
            const char* a1 = cA + (size_t)(t + 1) * kstep;
            const char* a2 = last ? nA : cA + (size_t)(t + 2) * kstep; const char* b2 = last ? nB : cB + (size_t)(t + 2) * kstep;
            const char* a3 = a2 + kstep; const char* b3 = b2 + kstep;
            if (last && has_next) S.a_ready(nxt);
            if constexpr (SP2) {
            PG8_LDB(B0, 0, 0); PG8_LDB(B1, 0, 1); PG8_SCHED; PG8_LDA(At, 0, 0); PG8_STAGE(PG8_SA(1, 1), a1 + hstep, voffA);
            PG8_WAIT_V(8); PG8_WAIT_L(0); PG8_BAR; PG8_MMA(0, 0, At, B0); PG8_MMA(0, 1, At, B1); PG8_BAR; PG8_SCHED;
            PG8_LDA(At, 0, 1); PG8_STAGE(PG8_SB(0, 0), b2, voffB); PG8_STAGE(PG8_SB(0, 1), b2 + hstep, voffB); PG8_STAGE(PG8_SA(0, 0), a2, voffA);
            PG8_WAIT_V(8); PG8_WAIT_L(0); PG8_BAR; PG8_MMA(1, 0, At, B0); PG8_MMA(1, 1, At, B1); PG8_BAR; PG8_SCHED;
            PG8_LDB(B0, 1, 0); PG8_LDB(B1, 1, 1); PG8_SCHED; PG8_LDA(At, 1, 0); PG8_STAGE(PG8_SA(0, 1), a2 + hstep, voffA);
            PG8_WAIT_V(8); PG8_WAIT_L(0); PG8_BAR; PG8_MMA(0, 0, At, B0); PG8_MMA(0, 1, At, B1); PG8_BAR; PG8_SCHED;
            PG8_LDA(At, 1, 1); PG8_STAGE(PG8_SB(1, 0), b3, voffB); PG8_STAGE(PG8_SB(1, 1), b3 + hstep, voffB); PG8_STAGE(PG8_SA(1, 0), a3, voffA);
            PG8_WAIT_V(8); PG8_WAIT_L(0); PG8_BAR; PG8_MMA(1, 0, At, B0); PG8_MMA(1, 1, At, B1); PG8_BAR; PG8_SCHED;
            } else {
            PG8_LDB(B0, 0, 0); PG8_SCHED; PG8_LDA(At, 0, 0); PG8_STAGE(PG8_SA(1, 1), a1 + hstep, voffA);
            PG8_WAIT_L(8); PG8_BAR; PG8_WAIT_L(0); PG8_MMA(0, 0, At, B0); PG8_BAR; PG8_SCHED;
            PG8_LDB(B1, 0, 1); PG8_STAGE(PG8_SB(0, 0), b2, voffB);
            PG8_BAR; PG8_WAIT_L(0); PG8_MMA(0, 1, At, B1); PG8_BAR;
            PG8_LDA(At, 0, 1); PG8_STAGE(PG8_SA(0, 0), a2, voffA);
            PG8_BAR; PG8_WAIT_L(0); PG8_MMA(1, 0, At, B0); PG8_BAR; PG8_SCHED;
            PG8_STAGE(PG8_SB(0, 1), b2 + hstep, voffB);
            PG8_WAIT_V(6); PG8_BAR; PG8_MMA(1, 1, At, B1); PG8_BAR;
            PG8_LDB(B0, 1, 0); PG8_SCHED; PG8_LDA(At, 1, 0); PG8_STAGE(PG8_SA(0, 1), a2 + hstep, voffA);
            PG8_WAIT_L(8); PG8_BAR; PG8_WAIT_L(0); PG8_MMA(0, 0, At, B0); PG8_BAR; PG8_SCHED;
            PG8_LDB(B1, 1, 1); PG8_STAGE(PG8_SB(1, 0), b3, voffB);
            PG8_BAR; PG8_WAIT_L(0); PG8_MMA(0, 1, At, B1); PG8_BAR;
            PG8_LDA(At, 1, 1); PG8_STAGE(PG8_SA(1, 0), a3, voffA);
            PG8_BAR; PG8_WAIT_L(0); PG8_MMA(1, 0, At, B0); PG8_BAR; PG8_SCHED;
            PG8_STAGE(PG8_SB(1, 1), b3 + hstep, voffB);
            PG8_WAIT_V(6); PG8_BAR; PG8_MMA(1, 1, At, B1); PG8_BAR;
            }
        }
        if constexpr (ALIGN_EPI) { if (wr == 0) PG8_BAR; }
        if constexpr (!Epi::AFTER_DRAIN) { E(acc, cur, wr, wc, fr, fq);
#ifdef PROBE_EPI2
            if constexpr (Epi::RPT) { asm volatile("" ::: "memory"); E(acc, cur, wr, wc, fr, fq); }
#endif
            S.done(cur); }
        if (!has_next) break;
#pragma unroll
        for (int a = 0; a < 2; ++a)
#pragma unroll
            for (int b = 0; b < 2; ++b)
#pragma unroll
                for (int m = 0; m < 4; ++m)
#pragma unroll
                    for (int n = 0; n < 2; ++n) acc[a][b][m][n] = (f32x4){0.f, 0.f, 0.f, 0.f};
        cur = nxt; cA = nA; cB = nB; ++ui;
        if constexpr (ALIGN_EPI) { if (wr == 1) PG8_BAR; }
    }
    PG8_WAIT_V(0);
    if constexpr (!ALIGN_EPI) { if (wr == 0) PG8_BAR; }
    PG8_BAR;
    if constexpr (Epi::AFTER_DRAIN) { E.fused(acc, cur, wr, wc, fr, fq, lds, wid, lane); S.done(cur); }
#undef PG8_SA
#undef PG8_SB
#undef PG8_STAGE
#undef PG8_LDA
#undef PG8_LDB
#undef PG8_MMA
#undef PG8_WAIT_V
#undef PG8_WAIT_L
#undef PG8_BAR
#undef PG8_SCHED
}
}

constexpr int NWAVES = 8;
constexpr int LDS_BYTES = 147456;
constexpr size_t MiB = 1u << 20;
constexpr size_t WS_WIN = 1 * MiB, WS_WEFF = 9 * MiB, WS_WCO = 11 * MiB, WS_WOUT = 12 * MiB, WS_WUP = 14 * MiB, WS_WDN = 25 * MiB;
constexpr size_t WS_H = 32 * MiB;
constexpr size_t WS_PROJ = 161 * MiB;
constexpr size_t WS_H2 = 161 * MiB;
constexpr size_t WS_U = 290 * MiB;
constexpr size_t WS_ACT = 645 * MiB;
constexpr size_t WS_ZB = 675 * MiB;
constexpr size_t WS_F = 740 * MiB;
constexpr size_t WS_MG = 869 * MiB;
constexpr size_t WS_NEED = 1000 * MiB;
constexpr size_t DO_DM = 0, DO_UT = 72 * MiB;
static_assert((size_t)2 * KH * KD * 2 <= DO_UT && DO_UT + (size_t)2 * 4096 * KD * 2 <= 256 * MiB, "d_out scratch map");
static_assert(WS_H + (size_t)R_TOT * DM * 2 <= WS_PROJ && WS_PROJ + (size_t)R_TOT * INC * 2 <= WS_ZB && WS_ZB + (size_t)R_TOT * 512 * 2 <= WS_F && WS_F + (size_t)R_TOT * DM * 2 <= WS_MG && WS_MG + (size_t)R_TOT * DM * 2 <= WS_NEED, "ws map 1");
static_assert(WS_H2 + (size_t)R_TOT * DM * 2 <= WS_U && WS_U + (size_t)33024 * 5632 * 2 <= WS_ACT && WS_ACT + (size_t)32768 * DFF * 2 <= WS_NEED, "ws map 2");

#define LAS __attribute__((address_space(3)))
typedef unsigned short bf16;
typedef unsigned v4u __attribute__((ext_vector_type(4)));
typedef unsigned v2u __attribute__((ext_vector_type(2)));
typedef float f32x4 __attribute__((ext_vector_type(4)));
#define LDS_WAIT() asm volatile("s_waitcnt lgkmcnt(0)" ::: "memory")
using pg8::cvt_pk_bf16; using pg8::bflo; using pg8::bfhi;

__device__ __forceinline__ float wave_sum(float v) {
#pragma unroll
    for (int o = 1; o < 64; o <<= 1) v += __shfl_xor(v, o);
    return v;
}
__device__ __forceinline__ void unpack8f(const v4u w, float (&f)[8]) { f[0] = bflo(w.x); f[1] = bfhi(w.x); f[2] = bflo(w.y); f[3] = bfhi(w.y); f[4] = bflo(w.z); f[5] = bfhi(w.z); f[6] = bflo(w.w); f[7] = bfhi(w.w); }
__device__ __forceinline__ v4u pack8f(const float (&f)[8]) { v4u w; w.x = cvt_pk_bf16(f[0], f[1]); w.y = cvt_pk_bf16(f[2], f[3]); w.z = cvt_pk_bf16(f[4], f[5]); w.w = cvt_pk_bf16(f[6], f[7]); return w; }
__device__ __forceinline__ void load8f(const float* p, float (&f)[8]) { const f32x4 a = *(const f32x4*)p, b = *(const f32x4*)(p + 4); f[0] = a.x; f[1] = a.y; f[2] = a.z; f[3] = a.w; f[4] = b.x; f[5] = b.y; f[6] = b.z; f[7] = b.w; }

struct Args { const float* in[17]; float* out; unsigned char* ws; int ph_lo, ph_hi; };
enum { I_X = 0, I_META, I_GMIXPRE, I_WIN, I_BGATES, I_WFOURIER, I_CWMIX, I_CBMIX, I_WCONVOUT, I_WOUT, I_GMIXPOST, I_GFFNPRE, I_WUP, I_CWFFN, I_CBFFN, I_WDOWN, I_GFFNPOST };

__device__ __forceinline__ void p0_transpose_item(const float* __restrict__ W, int K, int N, bf16* __restrict__ WT, int k0, int n0, int drow0, LAS float* scr, int lane) {
#pragma unroll 8
    for (int i = 0; i < 32; ++i) { const int kk = 2 * i + (lane >> 5); scr[kk * 33 + (lane & 31)] = W[(size_t)(k0 + kk) * N + n0 + (lane & 31)]; }
    LDS_WAIT();
    const int c = lane & 7;
#pragma unroll
    for (int j = 0; j < 4; ++j) { const int n = (lane >> 3) + 8 * j; const LAS float* s = scr + (8 * c) * 33 + n;
        v4u o; o.x = cvt_pk_bf16(s[0 * 33], s[1 * 33]); o.y = cvt_pk_bf16(s[2 * 33], s[3 * 33]); o.z = cvt_pk_bf16(s[4 * 33], s[5 * 33]); o.w = cvt_pk_bf16(s[6 * 33], s[7 * 33]);
        *(v4u*)(WT + (size_t)(drow0 + n) * K + k0 + 8 * c) = o; }
    LDS_WAIT();
}
__device__ __forceinline__ int wup_drow(int n0) { return n0 < DFF ? 256 * (n0 >> 7) + (n0 & 127) : 256 * ((n0 - DFF) >> 7) + 128 + ((n0 - DFF) & 127); }

__device__ __forceinline__ void phase0(const Args& a, LAS unsigned char* lds, int gw, int NGW, int wave, int lane) {
    unsigned char* ws = a.ws;
    LAS float* scr = (LAS float*)(lds + wave * 16384);
    constexpr int T_IN = 16 * 128, T_CO = 8 * 32, T_OUT = 16 * 32, T_UP = 16 * 176, T_DN = 44 * 32, T_ALL = T_IN + T_CO + T_OUT + T_UP + T_DN;
    for (int it = gw; it < T_ALL; it += NGW) {
        int r = it;
        if (r < T_IN) { const int kb = r / 128, nb = r % 128; p0_transpose_item(a.in[I_WIN], DM, INC, (bf16*)(ws + WS_WIN), kb * 64, nb * 32, nb * 32, scr, lane); continue; } r -= T_IN;
        if (r < T_CO) { const int kb = r / 32, nb = r % 32; p0_transpose_item(a.in[I_WCONVOUT], 512, DM, (bf16*)(ws + WS_WCO), kb * 64, nb * 32, nb * 32, scr, lane); continue; } r -= T_CO;
        if (r < T_OUT) { const int kb = r / 32, nb = r % 32; p0_transpose_item(a.in[I_WOUT], DM, DM, (bf16*)(ws + WS_WOUT), kb * 64, nb * 32, nb * 32, scr, lane); continue; } r -= T_OUT;
        if (r < T_UP) { const int kb = r / 176, nb = r % 176; p0_transpose_item(a.in[I_WUP], DM, 2 * DFF, (bf16*)(ws + WS_WUP), kb * 64, nb * 32, wup_drow(nb * 32), scr, lane); continue; } r -= T_UP;
        { const int kb = r / 32, nb = r % 32; p0_transpose_item(a.in[I_WDOWN], DFF, DM, (bf16*)(ws + WS_WDN), kb * 64, nb * 32, nb * 32, scr, lane); }
    }
    { const float* wf = a.in[I_WFOURIER]; bf16* we = (bf16*)(ws + WS_WEFF);
      for (int it = gw; it < 8192; it += NGW) { const int jb = it & 15, c = (it >> 4) & 127, g = it >> 11, j = jb * 64 + lane;
          float ac = 0.f, as = 0.f;
#pragma unroll 4
          for (int cp = 0; cp < 128; ++cp) { const float w = wf[(size_t)(g * 128 + cp) * DM + j]; const float ph = (float)((c * cp) & 127) * (1.0f / 128.0f);
              ac += __builtin_amdgcn_cosf(ph) * w; as += __builtin_amdgcn_sinf(ph) * w; }
          const float s = 0.08838834764831845f;
          we[(size_t)j * DM + g * 128 + c] = (bf16)(cvt_pk_bf16(ac * s, 0.f) & 0xffffu); we[(size_t)j * DM + 512 + g * 128 + c] = (bf16)(cvt_pk_bf16(as * s, 0.f) & 0xffffu); } }
    { bf16* dmat = (bf16*)((unsigned char*)a.out + DO_DM); constexpr int CPR = KD / 8;
      for (int it = gw; it < 2 * KH * CPR / 64; it += NGW) { const int chunk = it * 64 + lane, row = chunk / CPR, ci = chunk - row * CPR, n0 = ci * 8, part = row >= KH, k = row - part * KH;
          int mm = (int)(((unsigned)k * (unsigned)n0) % (unsigned)LSEQ); float f[8];
#pragma unroll
          for (int i = 0; i < 8; ++i) { const float ph = (float)mm * (1.0f / (float)LSEQ); const float v = part ? -__builtin_amdgcn_sinf(ph) : __builtin_amdgcn_cosf(ph);
              f[i] = (n0 + i <= NHALF) ? v * 0.011037770f : 0.f; mm += k; if (mm >= LSEQ) mm -= LSEQ; }
          *(v4u*)(dmat + (size_t)row * KD + n0) = pack8f(f); } }
    { const float* g = a.in[I_GMIXPRE]; bf16* h = (bf16*)(ws + WS_H);
      f32x4 gv[4];
#pragma unroll
      for (int j = 0; j < 4; ++j) gv[j] = ((const f32x4*)g)[lane + 64 * j];
      for (int r0 = gw; r0 < R_TOT; r0 += 2 * NGW) {
          f32x4 v[2][4]; float s2[2];
#pragma unroll
          for (int q = 0; q < 2; ++q) { const int r = r0 + q * NGW; s2[q] = 0.f;
              if (r < R_META + NB * NMETA) { const float* src = r < R_META ? a.in[I_X] + (size_t)r * DM : a.in[I_META] + (size_t)((r - R_META) & 15) * DM;
#pragma unroll
                  for (int j = 0; j < 4; ++j) v[q][j] = ((const f32x4*)src)[lane + 64 * j]; }
              else {
#pragma unroll
                  for (int j = 0; j < 4; ++j) v[q][j] = (f32x4){0.f, 0.f, 0.f, 0.f}; } }
#pragma unroll
          for (int q = 0; q < 2; ++q) {
#pragma unroll
              for (int j = 0; j < 4; ++j) s2[q] += (v[q][j].x * v[q][j].x + v[q][j].y * v[q][j].y) + (v[q][j].z * v[q][j].z + v[q][j].w * v[q][j].w); }
#pragma unroll
          for (int q = 0; q < 2; ++q) { const int r = r0 + q * NGW; if (r >= R_TOT) continue;
              const float rstd = rsqrtf(wave_sum(s2[q]) * (1.0f / DM) + RMS_EPS);
              unsigned long long* o8 = (unsigned long long*)(h + (size_t)r * DM) + lane;
#pragma unroll
              for (int j = 0; j < 4; ++j) { const f32x4 o = v[q][j] * rstd * gv[j]; o8[64 * j] = (unsigned long long)cvt_pk_bf16(o.x, o.y) | ((unsigned long long)cvt_pk_bf16(o.z, o.w) << 32); } }
      } }
}

__device__ __forceinline__ void phase2(const Args& a, LAS unsigned char* lds, int gw, int NGW, int wave, int lane) {
    unsigned char* ws = a.ws; const bf16* proj = (const bf16*)(ws + WS_PROJ);
    { bf16* eT = (bf16*)((unsigned char*)a.out + DO_UT); bf16* oT = eT + (size_t)4096 * KD;
      LAS bf16* scrE = (LAS bf16*)(lds + wave * 16896); LAS bf16* scrO = scrE + 64 * 66;
      constexpr int NBLK = KD / 64;
      for (int it = gw; it < NB * 8 * NBLK; it += NGW) { const int nblk = it % NBLK, cb = (it / NBLK) & 7, b = it / (8 * NBLK);
#pragma unroll
          for (int i = 0; i < 8; ++i) { const int nl = i * 8 + (lane >> 3), nh = nblk * 64 + nl, chunk = lane & 7;
              float e[8], o[8];
#pragma unroll
              for (int j = 0; j < 8; ++j) { e[j] = 0.f; o[j] = 0.f; }
              if (nh <= NHALF) { unpack8f(*(const v4u*)(proj + (size_t)row_of(b, nh) * INC + cb * 64 + chunk * 8), e);
                  if (nh >= 1 && nh < NHALF) { float u2[8]; unpack8f(*(const v4u*)(proj + (size_t)row_of(b, LSEQ - nh) * INC + cb * 64 + chunk * 8), u2);
#pragma unroll
                      for (int j = 0; j < 8; ++j) { o[j] = e[j] - u2[j]; e[j] = e[j] + u2[j]; } } }
              LAS bf16* dE = scrE + (chunk * 8) * 66 + nl; LAS bf16* dO = scrO + (chunk * 8) * 66 + nl;
#pragma unroll
              for (int j = 0; j < 8; ++j) { const unsigned w = cvt_pk_bf16(e[j], o[j]); dE[j * 66] = (bf16)(w & 0xffffu); dO[j * 66] = (bf16)(w >> 16); } }
          LDS_WAIT();
#pragma unroll
          for (int i = 0; i < 8; ++i) { const int ch = i * 8 + (lane >> 3), nc = lane & 7; const size_t off = (size_t)(b * 512 + cb * 64 + ch) * KD + nblk * 64 + nc * 8;
              const LAS unsigned* se = (const LAS unsigned*)(scrE + ch * 66 + nc * 8); const LAS unsigned* so = (const LAS unsigned*)(scrO + ch * 66 + nc * 8);
              v4u w; w.x = se[0]; w.y = se[1]; w.z = se[2]; w.w = se[3]; *(v4u*)(eT + off) = w;
              w.x = so[0]; w.y = so[1]; w.z = so[2]; w.w = so[3]; *(v4u*)(oT + off) = w; }
          LDS_WAIT(); } }
    { bf16* zb = (bf16*)(ws + WS_ZB); const float* cw = a.in[I_CWMIX]; const float* cbias = a.in[I_CBMIX];
      float w0[8], w1[8], w2[8], bb[8]; const int ch0 = lane * 8;
      load8f(cw + ch0, w0); load8f(cw + 512 + ch0, w1); load8f(cw + 1024 + ch0, w2); load8f(cbias + ch0, bb);
      for (int it = gw; it < NB * LSEQ; it += NGW) { const int b = it / LSEQ, p = it - b * LSEQ; const size_t r = (size_t)row_of(b, p);
          float cc[8], vv[8], bg[8], acc[8];
          unpack8f(*(const v4u*)(proj + r * INC + 512 + ch0), cc); unpack8f(*(const v4u*)(proj + r * INC + 1536 + ch0), vv); unpack8f(*(const v4u*)(proj + r * INC + 1024 + ch0), bg);
#pragma unroll
          for (int e = 0; e < 8; ++e) acc[e] = bb[e] + w1[e] * (cc[e] * vv[e]);
          if (p > 0) { const size_t rp = (size_t)row_of(b, p - 1); unpack8f(*(const v4u*)(proj + rp * INC + 512 + ch0), cc); unpack8f(*(const v4u*)(proj + rp * INC + 1536 + ch0), vv);
#pragma unroll
              for (int e = 0; e < 8; ++e) acc[e] += w0[e] * (cc[e] * vv[e]); }
          if (p < LSEQ - 1) { const size_t rn = (size_t)row_of(b, p + 1); unpack8f(*(const v4u*)(proj + rn * INC + 512 + ch0), cc); unpack8f(*(const v4u*)(proj + rn * INC + 1536 + ch0), vv);
#pragma unroll
              for (int e = 0; e < 8; ++e) acc[e] += w2[e] * (cc[e] * vv[e]); }
#pragma unroll
          for (int e = 0; e < 8; ++e) acc[e] *= bg[e];
          *(v4u*)(zb + r * 512 + ch0) = pack8f(acc); } }
}

template <int EPL> __device__ __forceinline__ void sk_load(unsigned (&a)[8][EPL / 2], const bf16* A, int lda, int row0, int rstride, int lane) {
#pragma unroll
    for (int r = 0; r < 8; ++r) { const v4u* p = (const v4u*)(A + (size_t)(row0 + r * rstride) * lda + lane * EPL);
#pragma unroll
        for (int i = 0; i < EPL / 8; ++i) { const v4u w = p[i]; a[r][4 * i] = w.x; a[r][4 * i + 1] = w.y; a[r][4 * i + 2] = w.z; a[r][4 * i + 3] = w.w; } }
}
template <int EPL> __device__ __forceinline__ float sk_dot(const unsigned (&a)[8][EPL / 2], const bf16* btrow, int lane) {
    unsigned b[EPL / 2];
#pragma unroll
    for (int i = 0; i < EPL / 8; ++i) { const v4u w = ((const v4u*)(btrow + lane * EPL))[i]; b[4 * i] = w.x; b[4 * i + 1] = w.y; b[4 * i + 2] = w.z; b[4 * i + 3] = w.w; }
    float acc[8];
#pragma unroll
    for (int r = 0; r < 8; ++r) acc[r] = 0.f;
#pragma unroll
    for (int i = 0; i < EPL / 2; ++i) { const float bl = bflo(b[i]), bh = bfhi(b[i]);
#pragma unroll
        for (int r = 0; r < 8; ++r) acc[r] += bflo(a[r][i]) * bl + bfhi(a[r][i]) * bh; }
    float res = 0.f;
#pragma unroll
    for (int r = 0; r < 8; ++r) { const float t = wave_sum(acc[r]); res = (lane == r) ? t : res; }
    return res;
}
__device__ __forceinline__ bf16 f2bf1(float v) { return (bf16)(cvt_pk_bf16(v, 0.f) & 0xffffu); }
__device__ __forceinline__ float bf2f1(bf16 h) { return __uint_as_float((unsigned)h << 16); }
constexpr int EDGE_ROW0 = R_META + NMETA - 1;

__device__ __forceinline__ void p1_meta(const Args& a, int gw, int NGW, int lane) {
    unsigned char* ws = a.ws; const bf16* h = (const bf16*)(ws + WS_H); const bf16* wt = (const bf16*)(ws + WS_WIN); bf16* proj = (bf16*)(ws + WS_PROJ); const float* bg = a.in[I_BGATES];
#pragma unroll 1
    for (int rg = 0; rg < 2; ++rg) { unsigned av[8][8]; sk_load<16>(av, h, DM, R_META + rg * 8, 1, lane);
#pragma unroll 1
        for (int j = gw; j < INC; j += NGW) { float v = sk_dot<16>(av, wt + (size_t)j * DM, lane);
            if (lane < 8) { if (j >= 2048) v = pg8::sigmoidf_(v + bg[j - 2048]); const bf16 o = f2bf1(v); const int pp = rg * 8 + lane;
#pragma unroll
                for (int b = 0; b < NB; ++b) proj[(size_t)(R_META + b * NMETA + pp) * INC + j] = o; } } }
}
__device__ __forceinline__ void p4_edge(const Args& a, int gw, int lane) {
    if (gw >= DM) return;
    unsigned char* ws = a.ws; const bf16* proj = (const bf16*)(ws + WS_PROJ); bf16* mg = (bf16*)(ws + WS_MG);
    unsigned aF[8][8], aZ[8][4]; sk_load<16>(aF, (const bf16*)(ws + WS_F), DM, EDGE_ROW0, NMETA, lane); sk_load<8>(aZ, (const bf16*)(ws + WS_ZB), 512, EDGE_ROW0, NMETA, lane);
    const int j = gw;
    const float ya = sk_dot<16>(aF, (const bf16*)(ws + WS_WEFF) + (size_t)j * DM, lane), yb = sk_dot<8>(aZ, (const bf16*)(ws + WS_WCO) + (size_t)j * 512, lane);
    if (lane < 8) { const size_t r = (size_t)(EDGE_ROW0 + lane * NMETA); mg[r * DM + j] = f2bf1(bf2f1(proj[r * INC + 2048 + j]) * ya + bf2f1(proj[r * INC + 3072 + j]) * yb); }
}
__device__ __forceinline__ void edge_gemm(const bf16* A, const bf16* Bt, int N, bf16* O, int ldo, int orow0, int ostride, int gw, int NGW, int lane) {
    if (gw >= N) return;
    unsigned av[8][8]; sk_load<16>(av, A, DM, EDGE_ROW0, NMETA, lane);
#pragma unroll 1
    for (int j = gw; j < N; j += NGW) { const float v = sk_dot<16>(av, Bt + (size_t)j * DM, lane);
        if (lane < 8) O[(size_t)(orow0 + lane * ostride) * ldo + j] = f2bf1(v); }
}

__device__ __forceinline__ void dft_tail(const Args& a, int gw, int NGW, int lane) {
    const bf16* dm = (const bf16*)((unsigned char*)a.out + DO_DM); const bf16* eT = (const bf16*)((unsigned char*)a.out + DO_UT); const bf16* oT = eT + (size_t)4096 * KD;
    bf16* F = (bf16*)(a.ws + WS_F);
    for (int row = gw; row < 4096; row += NGW) {
        float se[9], so[9];
#pragma unroll
        for (int kx = 0; kx < 9; ++kx) { se[kx] = 0.f; so[kx] = 0.f; }
        for (int it = 0; it < 9; ++it) { const int off = it * 512 + lane * 8;
            if (off < KD) { float ev[8], ov[8]; unpack8f(*(const v4u*)(eT + (size_t)row * KD + off), ev); unpack8f(*(const v4u*)(oT + (size_t)row * KD + off), ov);
#pragma unroll
                for (int kx = 0; kx < 9; ++kx) { float c[8], sn[8]; unpack8f(*(const v4u*)(dm + (size_t)(4096 + kx) * KD + off), c); unpack8f(*(const v4u*)(dm + (size_t)(KH + 4096 + kx) * KD + off), sn);
#pragma unroll
                    for (int e = 0; e < 8; ++e) { se[kx] += ev[e] * c[e]; so[kx] += ov[e] * sn[e]; } } } }
        float ve = 0.f, vo = 0.f;
#pragma unroll
        for (int kx = 0; kx < 9; ++kx) { const float te = wave_sum(se[kx]), to = wave_sum(so[kx]); if (lane == kx) { ve = te; vo = to; } }
        if (lane < 9) { const int b = row >> 9, ch = row & 511, k = 4096 + lane;
            const unsigned w = cvt_pk_bf16(ve, vo);
            F[(size_t)row_of(b, k) * DM + ch] = (bf16)(w & 0xffffu); F[(size_t)row_of(b, k) * DM + 512 + ch] = (bf16)(w >> 16);
            if (k != NHALF) { F[(size_t)row_of(b, LSEQ - k) * DM + ch] = (bf16)(w & 0xffffu); F[(size_t)row_of(b, LSEQ - k) * DM + 512 + ch] = (bf16)((w >> 16) ^ 0x8000u); } }
    }
}

__device__ __forceinline__ void phase6(const Args& a, int gw, int NGW, int lane) {
    unsigned char* ws = a.ws; const bf16* mix = (const bf16*)(ws + WS_H); bf16* h2 = (bf16*)(ws + WS_H2);
    float g1[2][8], g2[2][8];
#pragma unroll
    for (int j = 0; j < 2; ++j) { load8f(a.in[I_GMIXPOST] + 8 * lane + 512 * j, g1[j]); load8f(a.in[I_GFFNPRE] + 8 * lane + 512 * j, g2[j]); }
    constexpr int NR = R_META + NB;
    for (int r0 = gw; r0 < NR; r0 += 2 * NGW) {
        float mv[2][2][8], xv[2][2][8];
#pragma unroll
        for (int q = 0; q < 2; ++q) { const int ri = (r0 + q * NGW < NR) ? r0 + q * NGW : r0; const int r = ri < R_META ? ri : EDGE_ROW0 + (ri - R_META) * NMETA;
            const float* src = r < R_META ? a.in[I_X] + (size_t)r * DM : a.in[I_META] + (size_t)(NMETA - 1) * DM;
#pragma unroll
            for (int j = 0; j < 2; ++j) { unpack8f(*(const v4u*)(mix + (size_t)r * DM + 8 * lane + 512 * j), mv[q][j]); load8f(src + 8 * lane + 512 * j, xv[q][j]); } }
#pragma unroll
        for (int q = 0; q < 2; ++q) { const int ri = r0 + q * NGW; if (ri >= NR) continue; const int r = ri < R_META ? ri : EDGE_ROW0 + (ri - R_META) * NMETA;
            float s = 0.f;
#pragma unroll
            for (int j = 0; j < 2; ++j)
#pragma unroll
                for (int e = 0; e < 8; ++e) s += mv[q][j][e] * mv[q][j][e];
            const float r1 = rsqrtf(wave_sum(s) * (1.0f / DM) + RMS_EPS); float s2 = 0.f;
#pragma unroll
            for (int j = 0; j < 2; ++j)
#pragma unroll
                for (int e = 0; e < 8; ++e) { const float hr = xv[q][j][e] + mv[q][j][e] * r1 * g1[j][e]; xv[q][j][e] = hr; s2 += hr * hr; }
            const float r2 = rsqrtf(wave_sum(s2) * (1.0f / DM) + RMS_EPS);
#pragma unroll
            for (int j = 0; j < 2; ++j) { float o[8];
#pragma unroll
                for (int e = 0; e < 8; ++e) o[e] = xv[q][j][e] * r2 * g2[j][e];
                *(v4u*)(h2 + (size_t)r * DM + 8 * lane + 512 * j) = pack8f(o); } }
    }
}

__device__ __forceinline__ float gelu_tanh(float x) { const float z2 = 1.5957691216057308f * (x + 0.044715f * x * x * x); return x * __builtin_amdgcn_rcpf(1.0f + __expf(-z2)); }
__device__ __forceinline__ void phase8(const Args& a, int c, int gw, int NGW, int lane) {
    unsigned char* ws = a.ws; const bf16* U = (const bf16*)(ws + WS_U); bf16* act = (bf16*)(ws + WS_ACT);
    const float* cw = a.in[I_CWFFN]; const float* cbias = a.in[I_CBFFN];
    constexpr int SEGF = 32, NSEG = 32768 / SEGF;
    for (int it = gw; it < 6 * NSEG; it += NGW) { const int s = it / NSEG, seg = it - s * NSEG; const int cgi = s * 64 + lane; if (cgi >= DFF / 8) continue;
        const int j0 = cgi * 8, ua = 256 * (j0 >> 7) + (j0 & 127), uv = ua + 128;
        float wa[3][8], wv[3][8], ba[8], bv[8];
#pragma unroll
        for (int k = 0; k < 3; ++k) { load8f(cw + (size_t)k * 2 * DFF + j0, wa[k]); load8f(cw + (size_t)k * 2 * DFF + DFF + j0, wv[k]); }
        load8f(cbias + j0, ba); load8f(cbias + DFF + j0, bv);
        const int lr0 = seg * SEGF;
        for (int q = 0; q < SEGF; q += 4) {
            float xa[6][8], xv[6][8];
#pragma unroll
            for (int t = 0; t < 6; ++t) { const int lr = lr0 + q + t - 1; int src = lr; bool ok = true;
                if (t == 0 && ((lr + 1) & 8191) == 0) src = 32768 + (c * 4 + ((lr + 1) >> 13)) * NMETA + (NMETA - 1);
                if (t == 5 && (lr & 8191) == 0) ok = false;
                if (ok) { unpack8f(*(const v4u*)(U + (size_t)src * (2 * DFF) + ua), xa[t]); unpack8f(*(const v4u*)(U + (size_t)src * (2 * DFF) + uv), xv[t]); }
                else {
#pragma unroll
                    for (int e = 0; e < 8; ++e) { xa[t][e] = 0.f; xv[t][e] = 0.f; } } }
#pragma unroll
            for (int t = 0; t < 4; ++t) { float o[8];
#pragma unroll
                for (int e = 0; e < 8; ++e) { const float ca = ba[e] + wa[0][e] * xa[t][e] + wa[1][e] * xa[t + 1][e] + wa[2][e] * xa[t + 2][e];
                    const float cv = bv[e] + wv[0][e] * xv[t][e] + wv[1][e] * xv[t + 1][e] + wv[2][e] * xv[t + 2][e]; o[e] = gelu_tanh(ca) * cv; }
                *(v4u*)(act + (size_t)(lr0 + q + t) * DFF + j0) = pack8f(o); }
        } }
}

__device__ __forceinline__ void phase10(const Args& a, int gw, int NGW, int lane) {
    unsigned char* ws = a.ws; const bf16* mix = (const bf16*)(ws + WS_H); const bf16* ffn = (const bf16*)(ws + WS_MG);
    float g1[2][8], g3[2][8];
#pragma unroll
    for (int j = 0; j < 2; ++j) { load8f(a.in[I_GMIXPOST] + 8 * lane + 512 * j, g1[j]); load8f(a.in[I_GFFNPOST] + 8 * lane + 512 * j, g3[j]); }
    for (int r0 = gw; r0 < R_META; r0 += 2 * NGW) {
        float mv[2][2][8], xv[2][2][8], fv[2][2][8];
#pragma unroll
        for (int q = 0; q < 2; ++q) { const int r = (r0 + q * NGW < R_META) ? r0 + q * NGW : r0;
#pragma unroll
            for (int j = 0; j < 2; ++j) { const size_t off = (size_t)r * DM + 8 * lane + 512 * j;
                unpack8f(*(const v4u*)(mix + off), mv[q][j]); unpack8f(*(const v4u*)(ffn + off), fv[q][j]); load8f(a.in[I_X] + off, xv[q][j]); } }
#pragma unroll
        for (int q = 0; q < 2; ++q) { const int r = r0 + q * NGW; if (r >= R_META) continue;
            float s = 0.f, s3 = 0.f;
#pragma unroll
            for (int j = 0; j < 2; ++j)
#pragma unroll
                for (int e = 0; e < 8; ++e) { s += mv[q][j][e] * mv[q][j][e]; s3 += fv[q][j][e] * fv[q][j][e]; }
            const float r1 = rsqrtf(wave_sum(s) * (1.0f / DM) + RMS_EPS), r3 = rsqrtf(wave_sum(s3) * (1.0f / DM) + RMS_EPS);
#pragma unroll
            for (int j = 0; j < 2; ++j) { float o[8];
#pragma unroll
                for (int e = 0; e < 8; ++e) o[e] = xv[q][j][e] + mv[q][j][e] * r1 * g1[j][e] + fv[q][j][e] * r3 * g3[j][e];
                float* op = a.out + (size_t)r * DM + 8 * lane + 512 * j;
                *(f32x4*)op = (f32x4){o[0], o[1], o[2], o[3]}; *(f32x4*)(op + 4) = (f32x4){o[4], o[5], o[6], o[7]}; } }
    }
}

#define XB_TMO      128
#define XB_XCNT(j)  (256  + 64 * (j))
#define XB_XSUB(j)  (1280 + 64 * (j))
#define XB_XGEN(j)  (2304 + 64 * (j))
#define XB_TOP      3328
#define XB_TOPGEN   3392
#define XCD_BAR_WORDS 3456
#define XB_SPIN_CAP (1u << 18)

__device__ __forceinline__ unsigned xb_ld(unsigned* p)              { return __hip_atomic_load(p, __ATOMIC_RELAXED, __HIP_MEMORY_SCOPE_AGENT); }
__device__ __forceinline__ unsigned xb_add(unsigned* p, unsigned v) { return __hip_atomic_fetch_add(p, v, __ATOMIC_RELAXED, __HIP_MEMORY_SCOPE_AGENT); }
__device__ __forceinline__ unsigned xb_xcc_id() { return (unsigned)__builtin_amdgcn_s_getreg((3 << 11) | 20) & 0xFu; }
#define XB_SPIN(cond, bar) do { unsigned _sp = 0; while (cond) { __builtin_amdgcn_s_sleep(1); \
    if ((++_sp & 255u) == 0u) { if (xb_ld(&(bar)[XB_TMO])) break; if (_sp > XB_SPIN_CAP) { atomicAdd(&(bar)[XB_TMO], 1u); break; } } } } while (0)

struct XcdBarrier {
    unsigned* bar; unsigned x;
    volatile LAS unsigned* st;
};

__device__ __forceinline__ XcdBarrier xcd_barrier_post(unsigned* bar, volatile LAS unsigned* st) {
    XcdBarrier b; b.bar = bar; b.x = xb_xcc_id(); b.st = st;
    if (threadIdx.x == 0) (void)xb_add(&bar[XB_XCNT(b.x)], 1u);
    return b;
}
__device__ __forceinline__ void xcd_barrier_complete(unsigned* bar, unsigned x, unsigned& nloc, unsigned& nx) {
    const unsigned G = gridDim.x * gridDim.y * gridDim.z;
    unsigned sum, cnt, mine, sp = 0u;
    for (;;) {
        sum = 0u; cnt = 0u; mine = 0u;
#pragma unroll
        for (unsigned j = 0; j < 16; ++j) { const unsigned c = xb_ld(&bar[XB_XCNT(j)]); sum += c; cnt += (c > 0u) ? 1u : 0u; mine = (j == x) ? c : mine; }
        if (sum == G) break;
        __builtin_amdgcn_s_sleep(1);
        if ((++sp & 255u) == 0u) { if (xb_ld(&bar[XB_TMO])) break; if (sp > XB_SPIN_CAP) { atomicAdd(&bar[XB_TMO], 1u); break; } }
    }
    nloc = mine > 0u ? mine : 1u; nx = cnt > 0u ? cnt : 1u;
}

__device__ __forceinline__ void xcd_barrier(const XcdBarrier& b) {
    asm volatile("s_waitcnt vmcnt(0)" ::: "memory");
    __syncthreads();
    if (threadIdx.x == 0) {
        unsigned* bar = b.bar;
        __builtin_amdgcn_s_waitcnt(0);
        unsigned nloc = b.st[0], nx = b.st[1];
        if (nloc == 0u) { xcd_barrier_complete(bar, b.x, nloc, nx); b.st[0] = nloc; b.st[1] = nx; }
        const unsigned old = xb_add(&bar[XB_XSUB(b.x)], 1u);
        const unsigned gen = old / nloc;
        if (old + 1u == (gen + 1u) * nloc) {
            __builtin_amdgcn_fence(__ATOMIC_RELEASE, "agent");
            asm volatile("s_waitcnt vmcnt(0)" ::: "memory");
            const unsigned og = xb_add(&bar[XB_TOP], 1u);
            const unsigned tg = og / nx;
            if (og + 1u == (tg + 1u) * nx) xb_add(&bar[XB_TOPGEN], 1u);
            else XB_SPIN(xb_ld(&bar[XB_TOPGEN]) == tg, bar);
            __builtin_amdgcn_fence(__ATOMIC_ACQUIRE, "agent");
            xb_add(&bar[XB_XGEN(b.x)], 1u);
            asm volatile("s_waitcnt vmcnt(0)" ::: "memory");
        } else {
            XB_SPIN(xb_ld(&bar[XB_XGEN(b.x)]) == gen, bar);
            __builtin_amdgcn_fence(__ATOMIC_ACQUIRE, "agent");
            asm volatile("s_waitcnt vmcnt(0)" ::: "memory");
        }
    }
    __syncthreads();
}


#ifndef STAGGER_TICKS
#define STAGGER_TICKS 1000
#endif
__device__ __forceinline__ void stagger(int bx, unsigned ticks) {
    const unsigned frac = __brev((unsigned)bx) >> 24;
    const unsigned long long t0 = __builtin_amdgcn_s_memrealtime(), dt = (unsigned long long)ticks * frac / 256;
    while (__builtin_amdgcn_s_memrealtime() - t0 < dt) __builtin_amdgcn_s_sleep(8);
}

constexpr int N_PHASES = 15;
__global__ void __launch_bounds__(NWAVES * 64, 2) fwd_megakernel(Args args) {
    extern __shared__ __attribute__((aligned(16))) unsigned char lds_raw[];
    LAS unsigned char* lds = (LAS unsigned char*)lds_raw;
    cg::grid_group grid = cg::this_grid();
    const int tid = threadIdx.x, lane = tid & 63, wave = __builtin_amdgcn_readfirstlane(tid >> 6);
    const int G = gridDim.x, bx = blockIdx.x;
    const int vcu = (G % 8 == 0) ? (bx % 8) * (G / 8) + bx / 8 : bx;
    const int gw = vcu * NWAVES + wave, NGW = G * NWAVES;
    unsigned char* ws = args.ws;
    const int lo = args.ph_lo, hi = args.ph_hi;
    unsigned* barw = (unsigned*)ws;
    volatile LAS unsigned* MISC = (volatile LAS unsigned*)(lds + LDS_BYTES - 256);
    if (bx == 0) for (int i = tid; i < XCD_BAR_WORDS; i += NWAVES * 64) barw[i] = 0u;
    if (tid < 2) MISC[tid] = 0u;
    __syncthreads();
    XcdBarrier xbar; xbar.bar = barw; xbar.x = 0; xbar.st = MISC;
#ifndef PHASE_MASK
#define PHASE_MASK 0x7fff
#endif
#define IN(k) (((PHASE_MASK >> (k)) & 1) && lo <= (k) && (k) < hi)
#define SEAM(k) do { if ((k) + 1 < hi) { if ((k) == 0) { grid.sync(); xbar = xcd_barrier_post(barw, MISC); } else xcd_barrier(xbar); } } while (0)
    using namespace pg8;
    if (IN(0)) { phase0(args, lds, gw, NGW, wave, lane);
#ifdef PROBE_ELEM2
        __syncthreads(); phase0(args, lds, gw, NGW, wave, lane);
#endif
        SEAM(0); }
    if (IN(1)) {
        Gemm g{(const bf16_t*)(ws + WS_H), (const bf16_t*)(ws + WS_WIN), DM}; Order S; S.init(256, 0, -1, INC / 256, G, bx);
        p1_meta(args, gw, NGW, lane);
        EpiProj E{(bf16_t*)(ws + WS_PROJ), args.in[I_BGATES]};
        gemm_phase<EpiProj, Order>(lds, g, S, E); SEAM(1); }
    if (IN(2)) { phase2(args, lds, gw, NGW, wave, lane);
#ifdef PROBE_ELEM2
        __syncthreads(); phase2(args, lds, gw, NGW, wave, lane);
#endif
        SEAM(2); }
    if (IN(3)) {
        dft_tail(args, gw, NGW, lane);
        Gemm g{(const bf16_t*)((unsigned char*)args.out + DO_DM), (const bf16_t*)((unsigned char*)args.out + DO_UT), KD}; OrderDft S; S.init(G, bx);
        EpiDft E{(bf16_t*)(ws + WS_F)};
        gemm_phase<EpiDft, OrderDft>(lds, g, S, E); SEAM(3); }
    if (IN(4)) {
        Gemm g{(const bf16_t*)(ws + WS_F), (const bf16_t*)(ws + WS_WEFF), DM}; Order S; S.init(256, 0, -1, DM / 256, G, bx);
        p4_edge(args, gw, lane);
        EpiYa E{(bf16_t*)(ws + WS_MG), (const bf16_t*)(ws + WS_PROJ)};
        gemm_phase<EpiYa, Order>(lds, g, S, E); SEAM(4); }
    if (IN(5)) {
        Gemm g{(const bf16_t*)(ws + WS_ZB), (const bf16_t*)(ws + WS_WCO), 512}; Order S; S.init(256, 0, -1, DM / 256, G, bx);
        EpiYb E{(bf16_t*)(ws + WS_MG), (const bf16_t*)(ws + WS_PROJ)};
        gemm_phase<EpiYb, Order>(lds, g, S, E); SEAM(5); }
    if (IN(6)) {
        Gemm g{(const bf16_t*)(ws + WS_MG), (const bf16_t*)(ws + WS_WOUT), DM}; Order S; S.init(256, 0, -1, DM / 256, G, bx);
        edge_gemm((const bf16*)(ws + WS_MG), (const bf16*)(ws + WS_WOUT), DM, (bf16*)(ws + WS_H), DM, EDGE_ROW0, NMETA, gw, NGW, lane);
        EpiStore E{(bf16_t*)(ws + WS_H), DM, 0, -1, 0};
        gemm_phase<EpiStore, Order>(lds, g, S, E); SEAM(6); }
    if (IN(7)) { phase6(args, gw, NGW, lane);
#ifdef PROBE_ELEM2
        phase6(args, gw, NGW, lane);
#endif
        SEAM(7); }
#pragma unroll
    for (int c = 0; c < 2; ++c) {
        const int p = 8 + 3 * c;
        if (IN(p)) {
            Gemm g{(const bf16_t*)(ws + WS_H2), (const bf16_t*)(ws + WS_WUP), DM}; Order S; S.init(128, 128 * c, -1, 2 * DFF / 256, G, bx);
            if (c == 0) edge_gemm((const bf16*)(ws + WS_H2), (const bf16*)(ws + WS_WUP), 2 * DFF, (bf16*)(ws + WS_U), 2 * DFF, 32768 + NMETA - 1, NMETA, gw, NGW, lane);
            EpiStore E{(bf16_t*)(ws + WS_U), 2 * DFF, 128 * c, -1, 0};
            gemm_phase<EpiStore, Order>(lds, g, S, E); SEAM(p); }
        if (IN(p + 1)) { phase8(args, c, gw, NGW, lane);
#ifdef PROBE_ELEM2
            phase8(args, c, gw, NGW, lane);
#endif
            SEAM(p + 1); }
        if (IN(p + 2)) {
            Gemm g{(const bf16_t*)(ws + WS_ACT), (const bf16_t*)(ws + WS_WDN), DFF}; Order S; S.init(128, 0, -1, DM / 256, G, bx);
            EpiStore E{(bf16_t*)(ws + WS_MG), DM, -128 * c, -1, 0};
            gemm_phase<EpiStore, Order>(lds, g, S, E); SEAM(p + 2); }
    }
    #ifdef PROBE_SYNC10
    for (int q = 0; q < 10; ++q) grid.sync();
#endif
    if (IN(14)) { phase10(args, gw, NGW, lane);
#ifdef PROBE_ELEM2
        phase10(args, gw, NGW, lane);
#endif
    }
#undef IN
#undef SEAM
}

extern "C" void kernel_launch(void* const* d_in, const int* in_sizes, int n_in, void* d_out, int out_size, void* d_ws, size_t ws_size, hipStream_t stream) {
    static int grid = 0;
    if (grid == 0) {
        if (n_in != 17 || ws_size < WS_NEED || out_size != NB * SEQ * DM) { fprintf(stderr, "kernel_launch: unexpected problem (n_in %d, ws %zu, out %d)\n", n_in, ws_size, out_size); grid = -1; return; }
        int dev = 0, cus = 0, per_cu = 0;
        if (hipGetDevice(&dev) != hipSuccess || hipDeviceGetAttribute(&cus, hipDeviceAttributeMultiprocessorCount, dev) != hipSuccess) { grid = -1; return; }
        if (hipFuncSetAttribute((const void*)fwd_megakernel, hipFuncAttributeMaxDynamicSharedMemorySize, LDS_BYTES) != hipSuccess) { fprintf(stderr, "kernel_launch: hipFuncSetAttribute failed\n"); grid = -1; return; }
        if (hipOccupancyMaxActiveBlocksPerMultiprocessor(&per_cu, (const void*)fwd_megakernel, NWAVES * 64, LDS_BYTES) != hipSuccess || per_cu < 1) { fprintf(stderr, "kernel_launch: occupancy query says %d\n", per_cu); per_cu = 1; }
        (void)hipGetLastError();
        grid = cus * 1;
    }
    if (grid < 0) return;
    Args a{};
    for (int i = 0; i < 17; ++i) a.in[i] = (const float*)d_in[i];
    a.out = (float*)d_out; a.ws = (unsigned char*)d_ws; a.ph_lo = 0; a.ph_hi = N_PHASES;
    void* kargs[] = {&a};
    hipError_t e = hipLaunchCooperativeKernel((const void*)fwd_megakernel, dim3(grid), dim3(NWAVES * 64), kargs, LDS_BYTES, stream);
    if (e != hipSuccess) fprintf(stderr, "kernel_launch: cooperative launch failed: %s (grid %d)\n", hipGetErrorString(e), grid);
}
```

```cpp
#include <hip/hip_runtime.h>
#include <hip/hip_cooperative_groups.h>
#include <cstdio>
#include <cstdint>
namespace cg = cooperative_groups;

constexpr int NB = 8, SEQ = 8192, NMETA = 16, LSEQ = 8208, DM = 1024, DFF = 2816, INC = 4096;
constexpr int R_META = 65536, R_TOT = 65792;
constexpr int KD = 4224, NHALF = LSEQ / 2;
constexpr int KH = 4352, KHT = 17;
constexpr float RMS_EPS = 1e-6f;
__device__ __forceinline__ int row_of(int b, int pos) { return pos >= NMETA ? b * SEQ + pos - NMETA : R_META + b * NMETA + pos; }

namespace pg8 {
#define PG8_LAS __attribute__((address_space(3)))
typedef unsigned short bf16_t;
typedef short bf16x8 __attribute__((ext_vector_type(8)));
typedef float f32x4 __attribute__((ext_vector_type(4)));
typedef unsigned u32x4 __attribute__((ext_vector_type(4)));
constexpr int BM = 256, BK = 64, HALF = 128, HTB = HALF * BK * 2, STAGE_BYTES = 8 * HTB, NXCD = 8, WGM = 8;

__host__ __device__ __forceinline__ int lds_byte(int r, int c) { const int st = (r >> 4) * 2 + (c >> 5), rr = r & 15, cc = c & 31, ob = rr * 64 + cc * 2; return st * 1024 + (ob ^ (((ob >> 9) & 1) << 5)); }
__host__ __device__ __forceinline__ void stage_rc(int b, int& R, int& C) { const int st = b / 1024, sb = b % 1024, swz = sb ^ (((sb >> 9) & 1) << 5); R = (st >> 1) * 16 + swz / 64; C = (st & 1) * 32 + (swz % 64) / 2; }
__host__ __device__ __forceinline__ int perm32(int rho) { const int n = rho >> 4, i = rho & 15; return 8 * (i >> 2) + 4 * n + (i & 3); }

struct Unit { int pm, pn, arow; };
struct Gemm { const bf16_t* A; const bf16_t* Bt; int K; };

struct Order {
    int nM, nN, nwg, G, c, pm0, nMain, pm_extra;
    __device__ void init(int nMain_, int pm0_, int pm_extra_, int nN_, int G_, int c_) { nMain = nMain_; pm0 = pm0_; pm_extra = pm_extra_; nM = nMain_ + (pm_extra_ >= 0 ? 1 : 0); nN = nN_; nwg = nM * nN; G = G_; c = c_; }
    __device__ bool next(int i, Unit& u) const {
        const long L = (long)i * G + c; if (L >= nwg) return false;
        int wgid = (int)L; { const int q = nwg / NXCD, r = nwg % NXCD, xcd = wgid % NXCD, off = wgid / NXCD; wgid = (xcd < r ? xcd * (q + 1) : r * (q + 1) + (xcd - r) * q) + off; }
        const int nig = WGM * nN, gid = wgid / nig, fm = gid * WGM, gsz = (nM - fm) < WGM ? (nM - fm) : WGM;
        const int t = fm + ((wgid % nig) % gsz); u.pm = (t < nMain) ? pm0 + t : pm_extra; u.pn = (wgid % nig) / gsz; u.arow = u.pm * BM; return true;
    }
    __device__ __forceinline__ void a_ready(const Unit&) const {}
    __device__ __forceinline__ void done(const Unit&) const {}
};
struct OrderDft {
    int G, c;
    __device__ void init(int G_, int c_) { G = G_; c = c_; }
    __device__ bool next(int i, Unit& u) const {
        constexpr int nM = 32, nN = 16, nwg = nM * nN;
        const long L = (long)i * G + c; if (L >= nwg) return false;
        int wgid = (int)L; { const int q = nwg / NXCD, xcd = wgid % NXCD, off = wgid / NXCD; wgid = xcd * q + off; }
        const int nig = WGM * nN, gid = wgid / nig, fm = gid * WGM;
        const int t = fm + ((wgid % nig) % WGM), pn = (wgid % nig) / WGM, part = t >> 4;
        u.pm = part * KHT + (t & 15); u.pn = part * 16 + pn; u.arow = u.pm * BM; return true;
    }
    __device__ __forceinline__ void a_ready(const Unit&) const {}
    __device__ __forceinline__ void done(const Unit&) const {}
};
constexpr int H2F_PITCH = 8448, FFN_TPB = 33, FFN_STEP = 254;
struct OrderFfn : Order {
    __device__ bool next(int i, Unit& u) const { if (!Order::next(i, u)) return false; const int b = u.pm / FFN_TPB, t = u.pm - b * FFN_TPB; u.arow = b * H2F_PITCH + FFN_STEP * t; return true; }
};
__device__ __forceinline__ unsigned cvt_pk_bf16(float lo, float hi) { unsigned r; asm volatile("v_cvt_pk_bf16_f32 %0, %1, %2" : "=v"(r) : "v"(lo), "v"(hi)); return r; }
__device__ __forceinline__ u32x4 pack8(const f32x4 v0, const f32x4 v1) { u32x4 w; w.x = cvt_pk_bf16(v0[0], v0[1]); w.y = cvt_pk_bf16(v0[2], v0[3]); w.z = cvt_pk_bf16(v1[0], v1[1]); w.w = cvt_pk_bf16(v1[2], v1[3]); return w; }
__device__ __forceinline__ float bflo(unsigned w) { return __uint_as_float(w << 16); }
__device__ __forceinline__ float bfhi(unsigned w) { return __uint_as_float(w & 0xffff0000u); }
__device__ __forceinline__ void unpack8(const u32x4 w, f32x4& v0, f32x4& v1) { v0 = (f32x4){bflo(w.x), bfhi(w.x), bflo(w.y), bfhi(w.y)}; v1 = (f32x4){bflo(w.z), bfhi(w.z), bflo(w.w), bfhi(w.w)}; }
__device__ __forceinline__ float sigmoidf_(float x) { return __builtin_amdgcn_rcpf(1.0f + __expf(-x)); }
#define EPI_LOOP_AM _Pragma("unroll") for (int ai = 0; ai < 2; ++ai) _Pragma("unroll") for (int m = 0; m < 4; ++m)
#define EPI_LOOP_BJ _Pragma("unroll") for (int bj = 0; bj < 2; ++bj)
typedef const f32x4 (&AccT)[2][2][4][2];

struct EpiProj { static constexpr bool PERM = true, AFTER_DRAIN = false, RPT = true;
    bf16_t* P; const float* bg;
    __device__ __forceinline__ void operator()(AccT acc, const Unit& u, int wr, int wc, int fr, int fq) const {
        const int row0 = u.pm * BM + wr * 64 + fr, colt = u.pn * BM + wc * 32 + 8 * fq;
        const bool gate = u.pn >= 8;
        f32x4 bv[2][2];
        EPI_LOOP_BJ { _Pragma("unroll") for (int n = 0; n < 2; ++n) bv[bj][n] = gate ? *(const f32x4*)(bg + (colt - 2048) + bj * HALF + 4 * n) : (f32x4){0.f, 0.f, 0.f, 0.f}; }
        EPI_LOOP_AM { bf16_t* rowp = P + (size_t)(row0 + ai * HALF + m * 16) * INC + colt;
            EPI_LOOP_BJ { f32x4 v0 = acc[ai][bj][m][0] + bv[bj][0], v1 = acc[ai][bj][m][1] + bv[bj][1];
                if (gate) { _Pragma("unroll") for (int j = 0; j < 4; ++j) { v0[j] = sigmoidf_(v0[j]); v1[j] = sigmoidf_(v1[j]); } }
                *(u32x4*)(rowp + bj * HALF) = pack8(v0, v1); } }
    }
};
struct EpiDft { static constexpr bool PERM = true, AFTER_DRAIN = false, RPT = true;
    bf16_t* F;
    __device__ __forceinline__ void operator()(AccT acc, const Unit& u, int wr, int wc, int fr, int fq) const {
        const int part = u.pm / KHT, kt = u.pm - part * KHT;
        const int colg = (u.pn & 15) * BM + wc * 32 + 8 * fq;
        const unsigned sgn = part ? 0x80008000u : 0u;
        EPI_LOOP_AM { const int k = kt * BM + ai * HALF + wr * 64 + m * 16 + fr;
            {
                EPI_LOOP_BJ { const int cg_ = colg + bj * HALF, b = cg_ >> 9, ch = cg_ & 511;
                    u32x4 w = pack8(acc[ai][bj][m][0], acc[ai][bj][m][1]);
                    *(u32x4*)(F + (size_t)row_of(b, k) * DM + part * 512 + ch) = w;
                    if (k >= 1) { w.x ^= sgn; w.y ^= sgn; w.z ^= sgn; w.w ^= sgn;
                        *(u32x4*)(F + (size_t)row_of(b, LSEQ - k) * DM + part * 512 + ch) = w; } } } }
    }
};
struct EpiYa { static constexpr bool PERM = true, AFTER_DRAIN = false, RPT = true;
    bf16_t* Mg; const bf16_t* P;
    __device__ __forceinline__ void operator()(AccT acc, const Unit& u, int wr, int wc, int fr, int fq) const {
        const int row0 = u.pm * BM + wr * 64 + fr, colt = u.pn * BM + wc * 32 + 8 * fq;
        EPI_LOOP_AM { const size_t row = (size_t)(row0 + ai * HALF + m * 16);
            EPI_LOOP_BJ { const u32x4 gw = *(const u32x4*)(P + row * INC + 2048 + colt + bj * HALF); f32x4 g0, g1; unpack8(gw, g0, g1);
                *(u32x4*)(Mg + row * DM + colt + bj * HALF) = pack8(acc[ai][bj][m][0] * g0, acc[ai][bj][m][1] * g1); }
            asm volatile("" ::: "memory"); }
    }
};
struct EpiYb { static constexpr bool PERM = true, AFTER_DRAIN = false, RPT = false;
    bf16_t* Mg; const bf16_t* P;
    __device__ __forceinline__ void operator()(AccT acc, const Unit& u, int wr, int wc, int fr, int fq) const {
        const int row0 = u.pm * BM + wr * 64 + fr, colt = u.pn * BM + wc * 32 + 8 * fq;
        EPI_LOOP_AM { const size_t row = (size_t)(row0 + ai * HALF + m * 16);
            EPI_LOOP_BJ { const u32x4 gw = *(const u32x4*)(P + row * INC + 3072 + colt + bj * HALF); f32x4 g0, g1; unpack8(gw, g0, g1);
                const u32x4 tw = *(const u32x4*)(Mg + row * DM + colt + bj * HALF); f32x4 t0, t1; unpack8(tw, t0, t1);
                *(u32x4*)(Mg + row * DM + colt + bj * HALF) = pack8(t0 + acc[ai][bj][m][0] * g0, t1 + acc[ai][bj][m][1] * g1); }
            asm volatile("" ::: "memory"); }
    }
};
struct EpiStore { static constexpr bool PERM = true, AFTER_DRAIN = false, RPT = true;
    bf16_t* O; int ldc, pm0, pm_extra, extra_local;
    __device__ __forceinline__ void operator()(AccT acc, const Unit& u, int wr, int wc, int fr, int fq) const {
        const int lt = (u.pm == pm_extra) ? extra_local : u.pm - pm0;
        const int row0 = lt * BM + wr * 64 + fr, colt = u.pn * BM + wc * 32 + 8 * fq;
        EPI_LOOP_AM { bf16_t* rowp = O + (size_t)(row0 + ai * HALF + m * 16) * ldc + colt;
            EPI_LOOP_BJ { *(u32x4*)(rowp + bj * HALF) = pack8(acc[ai][bj][m][0], acc[ai][bj][m][1]); } }
    }
};
struct EpiF32 { static constexpr bool PERM = false, AFTER_DRAIN = false, RPT = true;
    float* C; int ldc, tile_off;
    __device__ __forceinline__ void operator()(AccT acc, const Unit& u, int wr, int wc, int fr, int fq) const {
        const int row0 = (u.pm + tile_off) * BM + wr * 64 + fr, col0 = u.pn * BM + wc * 32 + 4 * fq;
        EPI_LOOP_AM { float* rowp = C + (size_t)(row0 + ai * HALF + m * 16) * ldc + col0;
            EPI_LOOP_BJ { _Pragma("unroll") for (int n = 0; n < 2; ++n) *(f32x4*)(rowp + bj * HALF + n * 16) = acc[ai][bj][m][n]; } }
    }
};

struct EpiFfn { static constexpr bool PERM = true, AFTER_DRAIN = false, RPT = true;
    bf16_t* act; const float* cw; const float* cb; PG8_LAS unsigned char* slab;
    typedef unsigned u32x2 __attribute__((ext_vector_type(2)));
    __device__ __forceinline__ static f32x4 up4(const u32x2 w) { return (f32x4){bflo(w.x), bfhi(w.x), bflo(w.y), bfhi(w.y)}; }
    __device__ __forceinline__ void operator()(AccT acc, const Unit& u, int wr, int wc, int fr, int fq) const {
        const int tid = threadIdx.x, cg8 = tid & 7, rrow = tid >> 3, chunk = cg8 >> 1, hoff = (cg8 & 1) * 8;
        const int b = u.pm / FFN_TPB, t = u.pm - b * FFN_TPB;
#pragma unroll 1
        for (int s = 0; s < 4; ++s) {
            if (wc == s) {
                EPI_LOOP_AM { const int row = ai * HALF + wr * 64 + m * 16 + fr; PG8_LAS unsigned char* rp = slab + row * 128;
                    *(PG8_LAS u32x4*)(rp + ((fq ^ (row & 7)) << 4)) = pack8(acc[ai][0][m][0], acc[ai][0][m][1]);
                    *(PG8_LAS u32x4*)(rp + (((4 + fq) ^ (row & 7)) << 4)) = pack8(acc[ai][1][m][0], acc[ai][1][m][1]); } }
            asm volatile("s_waitcnt lgkmcnt(0)" ::: "memory"); __builtin_amdgcn_s_barrier(); asm volatile("" ::: "memory");
            const int j0 = u.pn * HALF + s * 32 + cg8 * 4;
            const f32x4 ka0 = *(const f32x4*)(cw + j0), ka1 = *(const f32x4*)(cw + 2 * DFF + j0), ka2 = *(const f32x4*)(cw + 4 * DFF + j0), kab = *(const f32x4*)(cb + j0);
            const f32x4 kv0 = *(const f32x4*)(cw + DFF + j0), kv1 = *(const f32x4*)(cw + 3 * DFF + j0), kv2 = *(const f32x4*)(cw + 5 * DFF + j0), kvb = *(const f32x4*)(cb + DFF + j0);
#pragma unroll 1
            for (int i2 = 0; i2 < 4; ++i2) { const int row = rrow + 64 * i2, iloc = FFN_STEP * t + row;
                if (row >= 1 && row <= 254 && iloc <= SEQ) {
                    const PG8_LAS unsigned char* p0 = slab + (row - 1) * 128 + hoff; const PG8_LAS unsigned char* p1 = p0 + 128; const PG8_LAS unsigned char* p2 = p1 + 128;
                    const int s0 = (row - 1) & 7, s1 = row & 7, s2 = (row + 1) & 7;
                    const f32x4 a0 = up4(*(const PG8_LAS u32x2*)(p0 + ((chunk ^ s0) << 4))), a1 = up4(*(const PG8_LAS u32x2*)(p1 + ((chunk ^ s1) << 4))), a2 = up4(*(const PG8_LAS u32x2*)(p2 + ((chunk ^ s2) << 4)));
                    const f32x4 v0 = up4(*(const PG8_LAS u32x2*)(p0 + (((4 + chunk) ^ s0) << 4))), v1 = up4(*(const PG8_LAS u32x2*)(p1 + (((4 + chunk) ^ s1) << 4))), v2 = up4(*(const PG8_LAS u32x2*)(p2 + (((4 + chunk) ^ s2) << 4)));
                    const f32x4 ca = kab + ka0 * a0 + ka1 * a1 + ka2 * a2, cv = kvb + kv0 * v0 + kv1 * v1 + kv2 * v2;
                    f32x4 o;
#pragma unroll
                    for (int e = 0; e < 4; ++e) { const float x = ca[e]; const float z2 = 1.5957691216057308f * (x + 0.044715f * x * x * x); o[e] = x * __builtin_amdgcn_rcpf(1.0f + __expf(-z2)) * cv[e]; }
                    u32x2 w; w.x = cvt_pk_bf16(o[0], o[1]); w.y = cvt_pk_bf16(o[2], o[3]);
                    *(u32x2*)(act + (size_t)(b * SEQ + iloc - 1) * DFF + j0) = w;
                } }
            asm volatile("s_waitcnt lgkmcnt(0)" ::: "memory"); __builtin_amdgcn_s_barrier(); asm volatile("" ::: "memory");
        }
    }
};

template <class Epi, class Sched, bool ALIGN_EPI = true, bool SP2 = true>
__device__ __forceinline__ void gemm_phase(PG8_LAS unsigned char* lds, const Gemm g, const Sched& S, const Epi& E) {
    const int tid = threadIdx.x, wid = __builtin_amdgcn_readfirstlane(tid >> 6), lane = tid & 63, wr = wid >> 2, wc = wid & 3, fr = lane & 15, fq = lane >> 4;
    const int K = g.K, nt = K / BK;
    unsigned voffA[2], voffB[2];
#pragma unroll
    for (int i = 0; i < 2; ++i) { int R, C; stage_rc(tid * 16 + i * 8192, R, C); const int Rb = Epi::PERM ? ((R & ~31) + perm32(R & 31)) : R;
        voffA[i] = (unsigned)(R * K + C) * 2u; voffB[i] = (unsigned)(Rb * K + C) * 2u; }
    const size_t kstep = (size_t)(BK * 2);
    const size_t hstep = (size_t)HALF * K * 2;
    const size_t tstep = 2 * hstep;
    const unsigned ldsw = (unsigned)wid * 1024u;
    const int aoff = lds_byte(wr * 64 + fr, fq * 8), boff = lds_byte(wc * 32 + fr, fq * 8);
#define PG8_SA(b, h) (((b) * 2 + (h)) * HTB)
#define PG8_SB(b, h) ((4 + (b) * 2 + (h)) * HTB)
#define PG8_STAGE(bufoff, gbase, voff) do { _Pragma("unroll") for (int _i = 0; _i < 2; ++_i) \
        __builtin_amdgcn_global_load_lds((const unsigned*)((const char*)(gbase) + (voff)[_i]), (PG8_LAS unsigned*)(lds + (bufoff) + ldsw + _i * 8192), 16, 0, 0); } while (0)
#define PG8_LDA(dst, b, h) do { _Pragma("unroll") for (int m = 0; m < 4; ++m) _Pragma("unroll") for (int k = 0; k < 2; ++k) dst[m][k] = *(const PG8_LAS bf16x8*)(lds + PG8_SA(b, h) + aoff + m * 2048 + k * 1024); } while (0)
#define PG8_LDB(dst, b, h) do { _Pragma("unroll") for (int n = 0; n < 2; ++n) _Pragma("unroll") for (int k = 0; k < 2; ++k) dst[n][k] = *(const PG8_LAS bf16x8*)(lds + PG8_SB(b, h) + boff + n * 2048 + k * 1024); } while (0)
#define PG8_MMA(ai, bj, At, Bt) do { __builtin_amdgcn_s_setprio(1); _Pragma("unroll") for (int m = 0; m < 4; ++m) _Pragma("unroll") for (int n = 0; n < 2; ++n) _Pragma("unroll") for (int k = 0; k < 2; ++k) \
        acc[ai][bj][m][n] = __builtin_amdgcn_mfma_f32_16x16x32_bf16(Bt[n][k], At[m][k], acc[ai][bj][m][n], 0, 0, 0); __builtin_amdgcn_s_setprio(0); } while (0)
#define PG8_WAIT_V(n) asm volatile("s_waitcnt vmcnt(" #n ")" ::: "memory")
#define PG8_WAIT_L(n) asm volatile("s_waitcnt lgkmcnt(" #n ")" ::: "memory")
#define PG8_BAR __builtin_amdgcn_s_barrier()
#define PG8_SCHED __builtin_amdgcn_sched_barrier(0)
    Unit cur, nxt; int ui = 0;
    if (!S.next(0, cur)) return;
    f32x4 acc[2][2][4][2];
#pragma unroll
    for (int a = 0; a < 2; ++a)
#pragma unroll
        for (int b = 0; b < 2; ++b)
#pragma unroll
            for (int m = 0; m < 4; ++m)
#pragma unroll
                for (int n = 0; n < 2; ++n) acc[a][b][m][n] = (f32x4){0.f, 0.f, 0.f, 0.f};
    bf16x8 At[4][2], B0[2][2], B1[2][2];
    const size_t rowb = (size_t)K * 2; const char* cA = (const char*)g.A + (size_t)cur.arow * rowb; const char* cB = (const char*)g.Bt + (size_t)cur.pn * tstep;
    S.a_ready(cur);
    if constexpr (SP2) {
        PG8_STAGE(PG8_SB(0, 0), cB, voffB); PG8_STAGE(PG8_SB(0, 1), cB + hstep, voffB); PG8_STAGE(PG8_SA(0, 0), cA, voffA); PG8_STAGE(PG8_SA(0, 1), cA + hstep, voffA);
        if (wr == 1) PG8_BAR;
        PG8_WAIT_V(2); PG8_BAR;
        PG8_STAGE(PG8_SB(1, 0), cB + kstep, voffB); PG8_STAGE(PG8_SA(1, 0), cA + kstep, voffA); PG8_STAGE(PG8_SB(1, 1), cB + hstep + kstep, voffB);
        PG8_WAIT_V(6); PG8_BAR;
    } else {
        PG8_STAGE(PG8_SB(0, 0), cB, voffB); PG8_STAGE(PG8_SA(0, 0), cA, voffA); PG8_STAGE(PG8_SB(0, 1), cB + hstep, voffB); PG8_STAGE(PG8_SA(0, 1), cA + hstep, voffA);
        if (wr == 1) PG8_BAR;
        PG8_WAIT_V(4); PG8_BAR;
        PG8_STAGE(PG8_SB(1, 0), cB + kstep, voffB); PG8_STAGE(PG8_SA(1, 0), cA + kstep, voffA); PG8_STAGE(PG8_SB(1, 1), cB + hstep + kstep, voffB);
        PG8_WAIT_V(6); PG8_BAR;
    }
    for (;;) {
        const bool has_next = S.next(ui + 1, nxt);
        const char* nA = has_next ? (const char*)g.A + (size_t)nxt.arow * rowb : cA; const char* nB = has_next ? (const char*)g.Bt + (size_t)nxt.pn * tstep : cB;
        for (int t = 0; t < nt; t += 2) {
            const bool last = (t == nt - 2);
            const char* a1 = cA + (size_t)(t + 1) * kstep;
            const char* a2 = last ? nA : cA + (size_t)(t + 2) * kstep; const char* b2 = last ? nB : cB + (size_t)(t + 2) * kstep;
            const char* a3 = a2 + kstep; const char* b3 = b2 + kstep;
            if (last && has_next) S.a_ready(nxt);
            if constexpr (SP2) {
            PG8_LDB(B0, 0, 0); PG8_LDB(B1, 0, 1); PG8_SCHED; PG8_LDA(At, 0, 0); PG8_STAGE(PG8_SA(1, 1), a1 + hstep, voffA);
            PG8_WAIT_V(8); PG8_WAIT_L(0); PG8_BAR; PG8_MMA(0, 0, At, B0); PG8_MMA(0, 1, At, B1); PG8_BAR; PG8_SCHED;
            PG8_LDA(At, 0, 1); PG8_STAGE(PG8_SB(0, 0), b2, voffB); PG8_STAGE(PG8_SB(0, 1), b2 + hstep, voffB); PG8_STAGE(PG8_SA(0, 0), a2, voffA);
            PG8_WAIT_V(8); PG8_WAIT_L(0); PG8_BAR; PG8_MMA(1, 0, At, B0); PG8_MMA(1, 1, At, B1); PG8_BAR; PG8_SCHED;
            PG8_LDB(B0, 1, 0); PG8_LDB(B1, 1, 1); PG8_SCHED; PG8_LDA(At, 1, 0); PG8_STAGE(PG8_SA(0, 1), a2 + hstep, voffA);
            PG8_WAIT_V(8); PG8_WAIT_L(0); PG8_BAR; PG8_MMA(0, 0, At, B0); PG8_MMA(0, 1, At, B1); PG8_BAR; PG8_SCHED;
            PG8_LDA(At, 1, 1); PG8_STAGE(PG8_SB(1, 0), b3, voffB); PG8_STAGE(PG8_SB(1, 1), b3 + hstep, voffB); PG8_STAGE(PG8_SA(1, 0), a3, voffA);
            PG8_WAIT_V(8); PG8_WAIT_L(0); PG8_BAR; PG8_MMA(1, 0, At, B0); PG8_MMA(1, 1, At, B1); PG8_BAR; PG8_SCHED;
            } else {
            PG8_LDB(B0, 0, 0); PG8_SCHED; PG8_LDA(At, 0, 0); PG8_STAGE(PG8_SA(1, 1), a1 + hstep, voffA);
            PG8_WAIT_L(8); PG8_BAR; PG8_WAIT_L(0); PG8_MMA(0, 0, At, B0); PG8_BAR; PG8_SCHED;
            PG8_LDB(B1, 0, 1); PG8_STAGE(PG8_SB(0, 0), b2, voffB);
            PG8_BAR; PG8_WAIT_L(0); PG8_MMA(0, 1, At, B1); PG8_BAR;
            PG8_LDA(At, 0, 1); PG8_STAGE(PG8_SA(0, 0), a2, voffA);
            PG8_BAR; PG8_WAIT_L(0); PG8_MMA(1, 0, At, B0); PG8_BAR; PG8_SCHED;
            PG8_STAGE(PG8_SB(0, 1), b2 + hstep, voffB);
            PG8_WAIT_V(6); PG8_BAR; PG8_MMA(1, 1, At, B1); PG8_BAR;
            PG8_LDB(B0, 1, 0); PG8_SCHED; PG8_LDA(At, 1, 0); PG8_STAGE(PG8_SA(0, 1), a2 + hstep, voffA);
            PG8_WAIT_L(8); PG8_BAR; PG8_WAIT_L(0); PG8_MMA(0, 0, At, B0); PG8_BAR; PG8_SCHED;
            PG8_LDB(B1, 1, 1); PG8_STAGE(PG8_SB(1, 0), b3, voffB);
            PG8_BAR; PG8_WAIT_L(0); PG8_MMA(0, 1, At, B1); PG8_BAR;
            PG8_LDA(At, 1, 1); PG8_STAGE(PG8_SA(1, 0), a3, voffA);
            PG8_BAR; PG8_WAIT_L(0); PG8_MMA(1, 0, At, B0); PG8_BAR; PG8_SCHED;
            PG8_STAGE(PG8_SB(1, 1), b3 + hstep, voffB);
            PG8_WAIT_V(6); PG8_BAR; PG8_MMA(1, 1, At, B1); PG8_BAR;
            }
        }
        if constexpr (ALIGN_EPI) { if (wr == 0) PG8_BAR; }
        if constexpr (!Epi::AFTER_DRAIN) { E(acc, cur, wr, wc, fr, fq);
            S.done(cur); }
        if (!has_next) break;
#pragma unroll
        for (int a = 0; a < 2; ++a)
#pragma unroll
            for (int b = 0; b < 2; ++b)
#pragma unroll
                for (int m = 0; m < 4; ++m)
#pragma unroll
                    for (int n = 0; n < 2; ++n) acc[a][b][m][n] = (f32x4){0.f, 0.f, 0.f, 0.f};
        cur = nxt; cA = nA; cB = nB; ++ui;
        if constexpr (ALIGN_EPI) { if (wr == 1) PG8_BAR; }
    }
    PG8_WAIT_V(0);
    if constexpr (!ALIGN_EPI) { if (wr == 0) PG8_BAR; }
    PG8_BAR;
    if constexpr (Epi::AFTER_DRAIN) { E.fused(acc, cur, wr, wc, fr, fq, lds, wid, lane); S.done(cur); }
#undef PG8_SA
#undef PG8_SB
#undef PG8_STAGE
#undef PG8_LDA
#undef PG8_LDB
#undef PG8_MMA
#undef PG8_WAIT_V
#undef PG8_WAIT_L
#undef PG8_BAR
#undef PG8_SCHED
}
}

constexpr int NWAVES = 8;
constexpr int LDS_BYTES = 163840;
constexpr size_t MiB = 1u << 20;
constexpr size_t WS_WIN = 1 * MiB, WS_WEFF = 9 * MiB, WS_WCO = 11 * MiB, WS_WOUT = 12 * MiB, WS_WUP = 14 * MiB, WS_WDN = 25 * MiB;
constexpr size_t WS_H = 32 * MiB;
constexpr size_t WS_PROJ = 161 * MiB;
constexpr size_t WS_H2 = 161 * MiB;
constexpr size_t WS_ACT = 300 * MiB;
constexpr size_t WS_ZB = 675 * MiB;
constexpr size_t WS_F = 740 * MiB;
constexpr size_t WS_MG = 869 * MiB;
constexpr size_t WS_NEED = 1000 * MiB;
constexpr size_t DO_DM = 0, DO_UT = 72 * MiB;
static_assert((size_t)2 * KH * KD * 2 <= DO_UT && DO_UT + (size_t)2 * 4096 * KD * 2 <= 256 * MiB, "d_out scratch map");
static_assert(WS_H + (size_t)R_TOT * DM * 2 <= WS_PROJ && WS_PROJ + (size_t)R_TOT * INC * 2 <= WS_ZB && WS_ZB + (size_t)R_TOT * 512 * 2 <= WS_F && WS_F + (size_t)R_TOT * DM * 2 <= WS_MG && WS_MG + (size_t)R_TOT * DM * 2 <= WS_NEED, "ws map 1");
static_assert(WS_H2 + (size_t)NB * pg8::H2F_PITCH * DM * 2 <= WS_ACT && WS_ACT + (size_t)65536 * DFF * 2 <= WS_MG, "ws map 2");

#define LAS __attribute__((address_space(3)))
typedef unsigned short bf16;
typedef unsigned v4u __attribute__((ext_vector_type(4)));
typedef unsigned v2u __attribute__((ext_vector_type(2)));
typedef float f32x4 __attribute__((ext_vector_type(4)));
#define LDS_WAIT() asm volatile("s_waitcnt lgkmcnt(0)" ::: "memory")
using pg8::cvt_pk_bf16; using pg8::bflo; using pg8::bfhi;

__device__ __forceinline__ float wave_sum(float v) {
#pragma unroll
    for (int o = 1; o < 64; o <<= 1) v += __shfl_xor(v, o);
    return v;
}
__device__ __forceinline__ void unpack8f(const v4u w, float (&f)[8]) { f[0] = bflo(w.x); f[1] = bfhi(w.x); f[2] = bflo(w.y); f[3] = bfhi(w.y); f[4] = bflo(w.z); f[5] = bfhi(w.z); f[6] = bflo(w.w); f[7] = bfhi(w.w); }
__device__ __forceinline__ v4u pack8f(const float (&f)[8]) { v4u w; w.x = cvt_pk_bf16(f[0], f[1]); w.y = cvt_pk_bf16(f[2], f[3]); w.z = cvt_pk_bf16(f[4], f[5]); w.w = cvt_pk_bf16(f[6], f[7]); return w; }
__device__ __forceinline__ void load8f(const float* p, float (&f)[8]) { const f32x4 a = *(const f32x4*)p, b = *(const f32x4*)(p + 4); f[0] = a.x; f[1] = a.y; f[2] = a.z; f[3] = a.w; f[4] = b.x; f[5] = b.y; f[6] = b.z; f[7] = b.w; }

struct Args { const float* in[17]; float* out; unsigned char* ws; int ph_lo, ph_hi; };
enum { I_X = 0, I_META, I_GMIXPRE, I_WIN, I_BGATES, I_WFOURIER, I_CWMIX, I_CBMIX, I_WCONVOUT, I_WOUT, I_GMIXPOST, I_GFFNPRE, I_WUP, I_CWFFN, I_CBFFN, I_WDOWN, I_GFFNPOST };

__device__ __forceinline__ void p0_transpose_item(const float* __restrict__ W, int K, int N, bf16* __restrict__ WT, int k0, int n0, int drow0, LAS float* scr, int lane) {
#pragma unroll 8
    for (int i = 0; i < 32; ++i) { const int kk = 2 * i + (lane >> 5); scr[kk * 33 + (lane & 31)] = W[(size_t)(k0 + kk) * N + n0 + (lane & 31)]; }
    LDS_WAIT();
    const int c = lane & 7;
#pragma unroll
    for (int j = 0; j < 4; ++j) { const int n = (lane >> 3) + 8 * j; const LAS float* s = scr + (8 * c) * 33 + n;
        v4u o; o.x = cvt_pk_bf16(s[0 * 33], s[1 * 33]); o.y = cvt_pk_bf16(s[2 * 33], s[3 * 33]); o.z = cvt_pk_bf16(s[4 * 33], s[5 * 33]); o.w = cvt_pk_bf16(s[6 * 33], s[7 * 33]);
        *(v4u*)(WT + (size_t)(drow0 + n) * K + k0 + 8 * c) = o; }
    LDS_WAIT();
}
__device__ __forceinline__ int wup_drow(int n0) { return n0 < DFF ? 256 * (n0 >> 7) + (n0 & 127) : 256 * ((n0 - DFF) >> 7) + 128 + ((n0 - DFF) & 127); }

__device__ __forceinline__ void phase0(const Args& a, LAS unsigned char* lds, int gw, int NGW, int wave, int lane) {
    unsigned char* ws = a.ws;
    LAS float* scr = (LAS float*)(lds + wave * 16384);
    constexpr int T_IN = 16 * 128, T_CO = 8 * 32, T_OUT = 16 * 32, T_UP = 16 * 176, T_DN = 44 * 32, T_ALL = T_IN + T_CO + T_OUT + T_UP + T_DN;
    for (int it = gw; it < T_ALL; it += NGW) {
        int r = it;
        if (r < T_IN) { const int kb = r / 128, nb = r % 128; p0_transpose_item(a.in[I_WIN], DM, INC, (bf16*)(ws + WS_WIN), kb * 64, nb * 32, nb * 32, scr, lane); continue; } r -= T_IN;
        if (r < T_CO) { const int kb = r / 32, nb = r % 32; p0_transpose_item(a.in[I_WCONVOUT], 512, DM, (bf16*)(ws + WS_WCO), kb * 64, nb * 32, nb * 32, scr, lane); continue; } r -= T_CO;
        if (r < T_OUT) { const int kb = r / 32, nb = r % 32; p0_transpose_item(a.in[I_WOUT], DM, DM, (bf16*)(ws + WS_WOUT), kb * 64, nb * 32, nb * 32, scr, lane); continue; } r -= T_OUT;
        if (r < T_UP) { const int kb = r / 176, nb = r % 176; p0_transpose_item(a.in[I_WUP], DM, 2 * DFF, (bf16*)(ws + WS_WUP), kb * 64, nb * 32, wup_drow(nb * 32), scr, lane); continue; } r -= T_UP;
        { const int kb = r / 32, nb = r % 32; p0_transpose_item(a.in[I_WDOWN], DFF, DM, (bf16*)(ws + WS_WDN), kb * 64, nb * 32, nb * 32, scr, lane); }
    }
    { const float* wf = a.in[I_WFOURIER]; bf16* we = (bf16*)(ws + WS_WEFF);
      for (int it = gw; it < 8192; it += NGW) { const int jb = it & 15, c = (it >> 4) & 127, g = it >> 11, j = jb * 64 + lane;
          float ac = 0.f, as = 0.f;
#pragma unroll 4
          for (int cp = 0; cp < 128; ++cp) { const float w = wf[(size_t)(g * 128 + cp) * DM + j]; const float ph = (float)((c * cp) & 127) * (1.0f / 128.0f);
              ac += __builtin_amdgcn_cosf(ph) * w; as += __builtin_amdgcn_sinf(ph) * w; }
          const float s = 0.08838834764831845f;
          we[(size_t)j * DM + g * 128 + c] = (bf16)(cvt_pk_bf16(ac * s, 0.f) & 0xffffu); we[(size_t)j * DM + 512 + g * 128 + c] = (bf16)(cvt_pk_bf16(as * s, 0.f) & 0xffffu); } }
    { bf16* dmat = (bf16*)((unsigned char*)a.out + DO_DM); constexpr int CPR = KD / 8;
      for (int it = gw; it < 2 * KH * CPR / 64; it += NGW) { const int chunk = it * 64 + lane, row = chunk / CPR, ci = chunk - row * CPR, n0 = ci * 8, part = row >= KH, k = row - part * KH;
          int mm = (int)(((unsigned)k * (unsigned)n0) % (unsigned)LSEQ); float f[8];
#pragma unroll
          for (int i = 0; i < 8; ++i) { const float ph = (float)mm * (1.0f / (float)LSEQ); const float v = part ? -__builtin_amdgcn_sinf(ph) : __builtin_amdgcn_cosf(ph);
              f[i] = (n0 + i <= NHALF) ? v * 0.011037770f : 0.f; mm += k; if (mm >= LSEQ) mm -= LSEQ; }
          *(v4u*)(dmat + (size_t)row * KD + n0) = pack8f(f); } }
    { const float* g = a.in[I_GMIXPRE]; bf16* h = (bf16*)(ws + WS_H);
      f32x4 gv[4];
#pragma unroll
      for (int j = 0; j < 4; ++j) gv[j] = ((const f32x4*)g)[lane + 64 * j];
      for (int r0 = gw; r0 < R_TOT; r0 += 2 * NGW) {
          f32x4 v[2][4]; float s2[2];
#pragma unroll
          for (int q = 0; q < 2; ++q) { const int r = r0 + q * NGW; s2[q] = 0.f;
              if (r < R_META + NB * NMETA) { const float* src = r < R_META ? a.in[I_X] + (size_t)r * DM : a.in[I_META] + (size_t)((r - R_META) & 15) * DM;
#pragma unroll
                  for (int j = 0; j < 4; ++j) v[q][j] = ((const f32x4*)src)[lane + 64 * j]; }
              else {
#pragma unroll
                  for (int j = 0; j < 4; ++j) v[q][j] = (f32x4){0.f, 0.f, 0.f, 0.f}; } }
#pragma unroll
          for (int q = 0; q < 2; ++q) {
#pragma unroll
              for (int j = 0; j < 4; ++j) s2[q] += (v[q][j].x * v[q][j].x + v[q][j].y * v[q][j].y) + (v[q][j].z * v[q][j].z + v[q][j].w * v[q][j].w); }
#pragma unroll
          for (int q = 0; q < 2; ++q) { const int r = r0 + q * NGW; if (r >= R_TOT) continue;
              const float rstd = rsqrtf(wave_sum(s2[q]) * (1.0f / DM) + RMS_EPS);
              unsigned long long* o8 = (unsigned long long*)(h + (size_t)r * DM) + lane;
#pragma unroll
              for (int j = 0; j < 4; ++j) { const f32x4 o = v[q][j] * rstd * gv[j]; o8[64 * j] = (unsigned long long)cvt_pk_bf16(o.x, o.y) | ((unsigned long long)cvt_pk_bf16(o.z, o.w) << 32); } }
      } }
}

__device__ __forceinline__ void phase2(const Args& a, LAS unsigned char* lds, int gw, int NGW, int wave, int lane) {
    unsigned char* ws = a.ws; const bf16* proj = (const bf16*)(ws + WS_PROJ);
    { bf16* eT = (bf16*)((unsigned char*)a.out + DO_UT); bf16* oT = eT + (size_t)4096 * KD;
      LAS bf16* scrE = (LAS bf16*)(lds + wave * 16896); LAS bf16* scrO = scrE + 64 * 66;
      constexpr int NBLK = KD / 64;
      for (int it = gw; it < NB * 8 * NBLK; it += NGW) { const int nblk = it % NBLK, cb = (it / NBLK) & 7, b = it / (8 * NBLK);
#pragma unroll
          for (int i = 0; i < 8; ++i) { const int nl = i * 8 + (lane >> 3), nh = nblk * 64 + nl, chunk = lane & 7;
              float e[8], o[8];
#pragma unroll
              for (int j = 0; j < 8; ++j) { e[j] = 0.f; o[j] = 0.f; }
              if (nh <= NHALF) { unpack8f(*(const v4u*)(proj + (size_t)row_of(b, nh) * INC + cb * 64 + chunk * 8), e);
                  if (nh >= 1 && nh < NHALF) { float u2[8]; unpack8f(*(const v4u*)(proj + (size_t)row_of(b, LSEQ - nh) * INC + cb * 64 + chunk * 8), u2);
#pragma unroll
                      for (int j = 0; j < 8; ++j) { o[j] = e[j] - u2[j]; e[j] = e[j] + u2[j]; } } }
              LAS bf16* dE = scrE + (chunk * 8) * 66 + nl; LAS bf16* dO = scrO + (chunk * 8) * 66 + nl;
#pragma unroll
              for (int j = 0; j < 8; ++j) { const unsigned w = cvt_pk_bf16(e[j], o[j]); dE[j * 66] = (bf16)(w & 0xffffu); dO[j * 66] = (bf16)(w >> 16); } }
          LDS_WAIT();
#pragma unroll
          for (int i = 0; i < 8; ++i) { const int ch = i * 8 + (lane >> 3), nc = lane & 7; const size_t off = (size_t)(b * 512 + cb * 64 + ch) * KD + nblk * 64 + nc * 8;
              const LAS unsigned* se = (const LAS unsigned*)(scrE + ch * 66 + nc * 8); const LAS unsigned* so = (const LAS unsigned*)(scrO + ch * 66 + nc * 8);
              v4u w; w.x = se[0]; w.y = se[1]; w.z = se[2]; w.w = se[3]; *(v4u*)(eT + off) = w;
              w.x = so[0]; w.y = so[1]; w.z = so[2]; w.w = so[3]; *(v4u*)(oT + off) = w; }
          LDS_WAIT(); } }
    { bf16* zb = (bf16*)(ws + WS_ZB); const float* cw = a.in[I_CWMIX]; const float* cbias = a.in[I_CBMIX];
      float w0[8], w1[8], w2[8], bb[8]; const int ch0 = lane * 8;
      load8f(cw + ch0, w0); load8f(cw + 512 + ch0, w1); load8f(cw + 1024 + ch0, w2); load8f(cbias + ch0, bb);
      for (int it = gw; it < NB * LSEQ; it += NGW) { const int b = it / LSEQ, p = it - b * LSEQ; const size_t r = (size_t)row_of(b, p);
          float cc[8], vv[8], bg[8], acc[8];
          unpack8f(*(const v4u*)(proj + r * INC + 512 + ch0), cc); unpack8f(*(const v4u*)(proj + r * INC + 1536 + ch0), vv); unpack8f(*(const v4u*)(proj + r * INC + 1024 + ch0), bg);
#pragma unroll
          for (int e = 0; e < 8; ++e) acc[e] = bb[e] + w1[e] * (cc[e] * vv[e]);
          if (p > 0) { const size_t rp = (size_t)row_of(b, p - 1); unpack8f(*(const v4u*)(proj + rp * INC + 512 + ch0), cc); unpack8f(*(const v4u*)(proj + rp * INC + 1536 + ch0), vv);
#pragma unroll
              for (int e = 0; e < 8; ++e) acc[e] += w0[e] * (cc[e] * vv[e]); }
          if (p < LSEQ - 1) { const size_t rn = (size_t)row_of(b, p + 1); unpack8f(*(const v4u*)(proj + rn * INC + 512 + ch0), cc); unpack8f(*(const v4u*)(proj + rn * INC + 1536 + ch0), vv);
#pragma unroll
              for (int e = 0; e < 8; ++e) acc[e] += w2[e] * (cc[e] * vv[e]); }
#pragma unroll
          for (int e = 0; e < 8; ++e) acc[e] *= bg[e];
          *(v4u*)(zb + r * 512 + ch0) = pack8f(acc); } }
}

template <int EPL> __device__ __forceinline__ void sk_load(unsigned (&a)[8][EPL / 2], const bf16* A, int lda, int row0, int rstride, int lane) {
#pragma unroll
    for (int r = 0; r < 8; ++r) { const v4u* p = (const v4u*)(A + (size_t)(row0 + r * rstride) * lda + lane * EPL);
#pragma unroll
        for (int i = 0; i < EPL / 8; ++i) { const v4u w = p[i]; a[r][4 * i] = w.x; a[r][4 * i + 1] = w.y; a[r][4 * i + 2] = w.z; a[r][4 * i + 3] = w.w; } }
}
template <int EPL> __device__ __forceinline__ float sk_dot(const unsigned (&a)[8][EPL / 2], const bf16* btrow, int lane) {
    unsigned b[EPL / 2];
#pragma unroll
    for (int i = 0; i < EPL / 8; ++i) { const v4u w = ((const v4u*)(btrow + lane * EPL))[i]; b[4 * i] = w.x; b[4 * i + 1] = w.y; b[4 * i + 2] = w.z; b[4 * i + 3] = w.w; }
    float acc[8];
#pragma unroll
    for (int r = 0; r < 8; ++r) acc[r] = 0.f;
#pragma unroll
    for (int i = 0; i < EPL / 2; ++i) { const float bl = bflo(b[i]), bh = bfhi(b[i]);
#pragma unroll
        for (int r = 0; r < 8; ++r) acc[r] += bflo(a[r][i]) * bl + bfhi(a[r][i]) * bh; }
    float res = 0.f;
#pragma unroll
    for (int r = 0; r < 8; ++r) { const float t = wave_sum(acc[r]); res = (lane == r) ? t : res; }
    return res;
}
__device__ __forceinline__ bf16 f2bf1(float v) { return (bf16)(cvt_pk_bf16(v, 0.f) & 0xffffu); }
__device__ __forceinline__ float bf2f1(bf16 h) { return __uint_as_float((unsigned)h << 16); }
constexpr int EDGE_ROW0 = R_META + NMETA - 1;

__device__ __forceinline__ void p1_meta(const Args& a, int gw, int NGW, int lane) {
    unsigned char* ws = a.ws; const bf16* h = (const bf16*)(ws + WS_H); const bf16* wt = (const bf16*)(ws + WS_WIN); bf16* proj = (bf16*)(ws + WS_PROJ); const float* bg = a.in[I_BGATES];
#pragma unroll 1
    for (int rg = 0; rg < 2; ++rg) { unsigned av[8][8]; sk_load<16>(av, h, DM, R_META + rg * 8, 1, lane);
#pragma unroll 1
        for (int j = gw; j < INC; j += NGW) { float v = sk_dot<16>(av, wt + (size_t)j * DM, lane);
            if (lane < 8) { if (j >= 2048) v = pg8::sigmoidf_(v + bg[j - 2048]); const bf16 o = f2bf1(v); const int pp = rg * 8 + lane;
#pragma unroll
                for (int b = 0; b < NB; ++b) proj[(size_t)(R_META + b * NMETA + pp) * INC + j] = o; } } }
}
__device__ __forceinline__ void p4_edge(const Args& a, int gw, int lane) {
    if (gw >= DM) return;
    unsigned char* ws = a.ws; const bf16* proj = (const bf16*)(ws + WS_PROJ); bf16* mg = (bf16*)(ws + WS_MG);
    unsigned aF[8][8], aZ[8][4]; sk_load<16>(aF, (const bf16*)(ws + WS_F), DM, EDGE_ROW0, NMETA, lane); sk_load<8>(aZ, (const bf16*)(ws + WS_ZB), 512, EDGE_ROW0, NMETA, lane);
    const int j = gw;
    const float ya = sk_dot<16>(aF, (const bf16*)(ws + WS_WEFF) + (size_t)j * DM, lane), yb = sk_dot<8>(aZ, (const bf16*)(ws + WS_WCO) + (size_t)j * 512, lane);
    if (lane < 8) { const size_t r = (size_t)(EDGE_ROW0 + lane * NMETA); mg[r * DM + j] = f2bf1(bf2f1(proj[r * INC + 2048 + j]) * ya + bf2f1(proj[r * INC + 3072 + j]) * yb); }
}
__device__ __forceinline__ void edge_gemm(const bf16* A, const bf16* Bt, int N, bf16* O, int ldo, int orow0, int ostride, int gw, int NGW, int lane) {
    if (gw >= N) return;
    unsigned av[8][8]; sk_load<16>(av, A, DM, EDGE_ROW0, NMETA, lane);
#pragma unroll 1
    for (int j = gw; j < N; j += NGW) { const float v = sk_dot<16>(av, Bt + (size_t)j * DM, lane);
        if (lane < 8) O[(size_t)(orow0 + lane * ostride) * ldo + j] = f2bf1(v); }
}

__device__ __forceinline__ void dft_tail(const Args& a, int gw, int NGW, int lane) {
    const bf16* dm = (const bf16*)((unsigned char*)a.out + DO_DM); const bf16* eT = (const bf16*)((unsigned char*)a.out + DO_UT); const bf16* oT = eT + (size_t)4096 * KD;
    bf16* F = (bf16*)(a.ws + WS_F);
    for (int row = gw; row < 4096; row += NGW) {
        float se[9], so[9];
#pragma unroll
        for (int kx = 0; kx < 9; ++kx) { se[kx] = 0.f; so[kx] = 0.f; }
        for (int it = 0; it < 9; ++it) { const int off = it * 512 + lane * 8;
            if (off < KD) { float ev[8], ov[8]; unpack8f(*(const v4u*)(eT + (size_t)row * KD + off), ev); unpack8f(*(const v4u*)(oT + (size_t)row * KD + off), ov);
#pragma unroll
                for (int kx = 0; kx < 9; ++kx) { float c[8], sn[8]; unpack8f(*(const v4u*)(dm + (size_t)(4096 + kx) * KD + off), c); unpack8f(*(const v4u*)(dm + (size_t)(KH + 4096 + kx) * KD + off), sn);
#pragma unroll
                    for (int e = 0; e < 8; ++e) { se[kx] += ev[e] * c[e]; so[kx] += ov[e] * sn[e]; } } } }
        float ve = 0.f, vo = 0.f;
#pragma unroll
        for (int kx = 0; kx < 9; ++kx) { const float te = wave_sum(se[kx]), to = wave_sum(so[kx]); if (lane == kx) { ve = te; vo = to; } }
        if (lane < 9) { const int b = row >> 9, ch = row & 511, k = 4096 + lane;
            const unsigned w = cvt_pk_bf16(ve, vo);
            F[(size_t)row_of(b, k) * DM + ch] = (bf16)(w & 0xffffu); F[(size_t)row_of(b, k) * DM + 512 + ch] = (bf16)(w >> 16);
            if (k != NHALF) { F[(size_t)row_of(b, LSEQ - k) * DM + ch] = (bf16)(w & 0xffffu); F[(size_t)row_of(b, LSEQ - k) * DM + 512 + ch] = (bf16)((w >> 16) ^ 0x8000u); } }
    }
}

__device__ __forceinline__ void phase6(const Args& a, int gw, int NGW, int lane) {
    unsigned char* ws = a.ws; const bf16* mix = (const bf16*)(ws + WS_H); bf16* h2 = (bf16*)(ws + WS_H2);
    float g1[2][8], g2[2][8];
#pragma unroll
    for (int j = 0; j < 2; ++j) { load8f(a.in[I_GMIXPOST] + 8 * lane + 512 * j, g1[j]); load8f(a.in[I_GFFNPRE] + 8 * lane + 512 * j, g2[j]); }
    constexpr int NR = R_META + 2 * NB;
    for (int r0 = gw; r0 < NR; r0 += 2 * NGW) {
        float mv[2][2][8], xv[2][2][8];
#pragma unroll
        for (int q = 0; q < 2; ++q) { int ri = (r0 + q * NGW < NR) ? r0 + q * NGW : r0; if (ri >= R_META + NB) ri = R_META;
            const int r = ri < R_META ? ri : EDGE_ROW0 + (ri - R_META) * NMETA;
            const float* src = r < R_META ? a.in[I_X] + (size_t)r * DM : a.in[I_META] + (size_t)(NMETA - 1) * DM;
#pragma unroll
            for (int j = 0; j < 2; ++j) { unpack8f(*(const v4u*)(mix + (size_t)r * DM + 8 * lane + 512 * j), mv[q][j]); load8f(src + 8 * lane + 512 * j, xv[q][j]); } }
#pragma unroll
        for (int q = 0; q < 2; ++q) { const int ri = r0 + q * NGW; if (ri >= NR) continue;
            const size_t orow = ri < R_META ? (size_t)(ri >> 13) * pg8::H2F_PITCH + (ri & 8191) + 1 : (ri < R_META + NB ? (size_t)(ri - R_META) * pg8::H2F_PITCH : (size_t)(ri - R_META - NB) * pg8::H2F_PITCH + SEQ + 1);
            if (ri >= R_META + NB) {
#pragma unroll
                for (int j = 0; j < 2; ++j) *(v4u*)(h2 + orow * DM + 8 * lane + 512 * j) = (v4u){0u, 0u, 0u, 0u};
                continue; }
            float s = 0.f;
#pragma unroll
            for (int j = 0; j < 2; ++j)
#pragma unroll
                for (int e = 0; e < 8; ++e) s += mv[q][j][e] * mv[q][j][e];
            const float r1 = rsqrtf(wave_sum(s) * (1.0f / DM) + RMS_EPS); float s2 = 0.f;
#pragma unroll
            for (int j = 0; j < 2; ++j)
#pragma unroll
                for (int e = 0; e < 8; ++e) { const float hr = xv[q][j][e] + mv[q][j][e] * r1 * g1[j][e]; xv[q][j][e] = hr; s2 += hr * hr; }
            const float r2 = rsqrtf(wave_sum(s2) * (1.0f / DM) + RMS_EPS);
#pragma unroll
            for (int j = 0; j < 2; ++j) { float o[8];
#pragma unroll
                for (int e = 0; e < 8; ++e) o[e] = xv[q][j][e] * r2 * g2[j][e];
                *(v4u*)(h2 + orow * DM + 8 * lane + 512 * j) = pack8f(o); } }
    }
}

__device__ __forceinline__ void phase10(const Args& a, int gw, int NGW, int lane) {
    unsigned char* ws = a.ws; const bf16* mix = (const bf16*)(ws + WS_H); const bf16* ffn = (const bf16*)(ws + WS_MG);
    float g1[2][8], g3[2][8];
#pragma unroll
    for (int j = 0; j < 2; ++j) { load8f(a.in[I_GMIXPOST] + 8 * lane + 512 * j, g1[j]); load8f(a.in[I_GFFNPOST] + 8 * lane + 512 * j, g3[j]); }
    for (int r0 = gw; r0 < R_META; r0 += 2 * NGW) {
        float mv[2][2][8], xv[2][2][8], fv[2][2][8];
#pragma unroll
        for (int q = 0; q < 2; ++q) { const int r = (r0 + q * NGW < R_META) ? r0 + q * NGW : r0;
#pragma unroll
            for (int j = 0; j < 2; ++j) { const size_t off = (size_t)r * DM + 8 * lane + 512 * j;
                unpack8f(*(const v4u*)(mix + off), mv[q][j]); unpack8f(*(const v4u*)(ffn + off), fv[q][j]); load8f(a.in[I_X] + off, xv[q][j]); } }
#pragma unroll
        for (int q = 0; q < 2; ++q) { const int r = r0 + q * NGW; if (r >= R_META) continue;
            float s = 0.f, s3 = 0.f;
#pragma unroll
            for (int j = 0; j < 2; ++j)
#pragma unroll
                for (int e = 0; e < 8; ++e) { s += mv[q][j][e] * mv[q][j][e]; s3 += fv[q][j][e] * fv[q][j][e]; }
            const float r1 = rsqrtf(wave_sum(s) * (1.0f / DM) + RMS_EPS), r3 = rsqrtf(wave_sum(s3) * (1.0f / DM) + RMS_EPS);
#pragma unroll
            for (int j = 0; j < 2; ++j) { float o[8];
#pragma unroll
                for (int e = 0; e < 8; ++e) o[e] = xv[q][j][e] + mv[q][j][e] * r1 * g1[j][e] + fv[q][j][e] * r3 * g3[j][e];
                float* op = a.out + (size_t)r * DM + 8 * lane + 512 * j;
                *(f32x4*)op = (f32x4){o[0], o[1], o[2], o[3]}; *(f32x4*)(op + 4) = (f32x4){o[4], o[5], o[6], o[7]}; } }
    }
}

#define XB_TMO      128
#define XB_XCNT(j)  (256  + 64 * (j))
#define XB_XSUB(j)  (1280 + 64 * (j))
#define XB_XGEN(j)  (2304 + 64 * (j))
#define XB_TOP      3328
#define XB_TOPGEN   3392
#define XCD_BAR_WORDS 3456
#define XB_SPIN_CAP (1u << 18)

__device__ __forceinline__ unsigned xb_ld(unsigned* p)              { return __hip_atomic_load(p, __ATOMIC_RELAXED, __HIP_MEMORY_SCOPE_AGENT); }
__device__ __forceinline__ unsigned xb_add(unsigned* p, unsigned v) { return __hip_atomic_fetch_add(p, v, __ATOMIC_RELAXED, __HIP_MEMORY_SCOPE_AGENT); }
__device__ __forceinline__ unsigned xb_xcc_id() { return (unsigned)__builtin_amdgcn_s_getreg((3 << 11) | 20) & 0xFu; }
#define XB_SPIN(cond, bar) do { unsigned _sp = 0; while (cond) { __builtin_amdgcn_s_sleep(1); \
    if ((++_sp & 255u) == 0u) { if (xb_ld(&(bar)[XB_TMO])) break; if (_sp > XB_SPIN_CAP) { atomicAdd(&(bar)[XB_TMO], 1u); break; } } } } while (0)

struct XcdBarrier {
    unsigned* bar; unsigned x;
    unsigned nloc, nx;
};

__device__ __forceinline__ XcdBarrier xcd_barrier_post(unsigned* bar) {
    XcdBarrier b; b.bar = bar; b.x = xb_xcc_id(); b.nloc = 0u; b.nx = 0u;
    if (threadIdx.x == 0) (void)xb_add(&bar[XB_XCNT(b.x)], 1u);
    return b;
}
__device__ __forceinline__ void xcd_barrier_complete(unsigned* bar, unsigned x, unsigned& nloc, unsigned& nx) {
    const unsigned G = gridDim.x * gridDim.y * gridDim.z;
    unsigned sum, cnt, mine, sp = 0u;
    for (;;) {
        sum = 0u; cnt = 0u; mine = 0u;
#pragma unroll
        for (unsigned j = 0; j < 16; ++j) { const unsigned c = xb_ld(&bar[XB_XCNT(j)]); sum += c; cnt += (c > 0u) ? 1u : 0u; mine = (j == x) ? c : mine; }
        if (sum == G) break;
        __builtin_amdgcn_s_sleep(1);
        if ((++sp & 255u) == 0u) { if (xb_ld(&bar[XB_TMO])) break; if (sp > XB_SPIN_CAP) { atomicAdd(&bar[XB_TMO], 1u); break; } }
    }
    nloc = mine > 0u ? mine : 1u; nx = cnt > 0u ? cnt : 1u;
}

__device__ __forceinline__ void xcd_barrier(XcdBarrier& b) {
    asm volatile("s_waitcnt vmcnt(0)" ::: "memory");
    __syncthreads();
    if (threadIdx.x == 0) {
        unsigned* bar = b.bar;
        __builtin_amdgcn_s_waitcnt(0);
        unsigned nloc = b.nloc, nx = b.nx;
        if (nloc == 0u) { xcd_barrier_complete(bar, b.x, nloc, nx); b.nloc = nloc; b.nx = nx; }
        const unsigned old = xb_add(&bar[XB_XSUB(b.x)], 1u);
        const unsigned gen = old / nloc;
        if (old + 1u == (gen + 1u) * nloc) {
            __builtin_amdgcn_fence(__ATOMIC_RELEASE, "agent");
            asm volatile("s_waitcnt vmcnt(0)" ::: "memory");
            const unsigned og = xb_add(&bar[XB_TOP], 1u);
            const unsigned tg = og / nx;
            if (og + 1u == (tg + 1u) * nx) xb_add(&bar[XB_TOPGEN], 1u);
            else XB_SPIN(xb_ld(&bar[XB_TOPGEN]) == tg, bar);
            __builtin_amdgcn_fence(__ATOMIC_ACQUIRE, "agent");
            xb_add(&bar[XB_XGEN(b.x)], 1u);
            asm volatile("s_waitcnt vmcnt(0)" ::: "memory");
        } else {
            XB_SPIN(xb_ld(&bar[XB_XGEN(b.x)]) == gen, bar);
            __builtin_amdgcn_fence(__ATOMIC_ACQUIRE, "agent");
            asm volatile("s_waitcnt vmcnt(0)" ::: "memory");
        }
    }
    __syncthreads();
}


#ifndef STAGGER_TICKS
#define STAGGER_TICKS 1000
#endif
__device__ __forceinline__ void stagger(int bx, unsigned ticks) {
    const unsigned frac = __brev((unsigned)bx) >> 24;
    const unsigned long long t0 = __builtin_amdgcn_s_memrealtime(), dt = (unsigned long long)ticks * frac / 256;
    while (__builtin_amdgcn_s_memrealtime() - t0 < dt) __builtin_amdgcn_s_sleep(8);
}

constexpr int N_PHASES = 11;
__global__ void __launch_bounds__(NWAVES * 64, 2) fwd_megakernel(Args args) {
    extern __shared__ __attribute__((aligned(16))) unsigned char lds_raw[];
    LAS unsigned char* lds = (LAS unsigned char*)lds_raw;
    cg::grid_group grid = cg::this_grid();
    const int tid = threadIdx.x, lane = tid & 63, wave = __builtin_amdgcn_readfirstlane(tid >> 6);
    const int G = gridDim.x, bx = blockIdx.x;
    const int vcu = (G % 8 == 0) ? (bx % 8) * (G / 8) + bx / 8 : bx;
    const int gw = vcu * NWAVES + wave, NGW = G * NWAVES;
    unsigned char* ws = args.ws;
    const int lo = args.ph_lo, hi = args.ph_hi;
    unsigned* barw = (unsigned*)ws;
    if (bx == 0) for (int i = tid; i < XCD_BAR_WORDS; i += NWAVES * 64) barw[i] = 0u;
    __syncthreads();
    XcdBarrier xbar; xbar.bar = barw; xbar.x = 0; xbar.nloc = 0u; xbar.nx = 0u;
#ifndef PHASE_MASK
#define PHASE_MASK 0x7ff
#endif
#define IN(k) (((PHASE_MASK >> (k)) & 1) && lo <= (k) && (k) < hi)
#define SEAM(k) do { if ((k) + 1 < hi) { if ((k) == 0) { grid.sync(); xbar = xcd_barrier_post(barw); } else xcd_barrier(xbar); } } while (0)
    using namespace pg8;
    if (IN(0)) { phase0(args, lds, gw, NGW, wave, lane);
        SEAM(0); }
    if (IN(1)) {
        Gemm g{(const bf16_t*)(ws + WS_H), (const bf16_t*)(ws + WS_WIN), DM}; Order S; S.init(256, 0, -1, INC / 256, G, bx);
        p1_meta(args, gw, NGW, lane);
        EpiProj E{(bf16_t*)(ws + WS_PROJ), args.in[I_BGATES]};
        gemm_phase<EpiProj, Order>(lds, g, S, E); SEAM(1); }
    if (IN(2)) { phase2(args, lds, gw, NGW, wave, lane);
        SEAM(2); }
    if (IN(3)) {
        dft_tail(args, gw, NGW, lane);
        Gemm g{(const bf16_t*)((unsigned char*)args.out + DO_DM), (const bf16_t*)((unsigned char*)args.out + DO_UT), KD}; OrderDft S; S.init(G, bx);
        EpiDft E{(bf16_t*)(ws + WS_F)};
        gemm_phase<EpiDft, OrderDft>(lds, g, S, E); SEAM(3); }
    if (IN(4)) {
        Gemm g{(const bf16_t*)(ws + WS_F), (const bf16_t*)(ws + WS_WEFF), DM}; Order S; S.init(256, 0, -1, DM / 256, G, bx);
        p4_edge(args, gw, lane);
        EpiYa E{(bf16_t*)(ws + WS_MG), (const bf16_t*)(ws + WS_PROJ)};
        gemm_phase<EpiYa, Order>(lds, g, S, E); SEAM(4); }
    if (IN(5)) {
        Gemm g{(const bf16_t*)(ws + WS_ZB), (const bf16_t*)(ws + WS_WCO), 512}; Order S; S.init(256, 0, -1, DM / 256, G, bx);
        EpiYb E{(bf16_t*)(ws + WS_MG), (const bf16_t*)(ws + WS_PROJ)};
        gemm_phase<EpiYb, Order>(lds, g, S, E); SEAM(5); }
    if (IN(6)) {
        Gemm g{(const bf16_t*)(ws + WS_MG), (const bf16_t*)(ws + WS_WOUT), DM}; Order S; S.init(256, 0, -1, DM / 256, G, bx);
        edge_gemm((const bf16*)(ws + WS_MG), (const bf16*)(ws + WS_WOUT), DM, (bf16*)(ws + WS_H), DM, EDGE_ROW0, NMETA, gw, NGW, lane);
        EpiStore E{(bf16_t*)(ws + WS_H), DM, 0, -1, 0};
        gemm_phase<EpiStore, Order>(lds, g, S, E); SEAM(6); }
    if (IN(7)) { phase6(args, gw, NGW, lane);
        SEAM(7); }
    if (IN(8)) {
        Gemm g{(const bf16_t*)(ws + WS_H2), (const bf16_t*)(ws + WS_WUP), DM}; OrderFfn S; S.init(NB * FFN_TPB, 0, -1, 2 * DFF / 256, G, bx);
        EpiFfn E{(bf16_t*)(ws + WS_ACT), args.in[I_CWFFN], args.in[I_CBFFN], lds + STAGE_BYTES};
        gemm_phase<EpiFfn, OrderFfn>(lds, g, S, E); SEAM(8); }
    if (IN(9)) {
        Gemm g{(const bf16_t*)(ws + WS_ACT), (const bf16_t*)(ws + WS_WDN), DFF}; Order S; S.init(256, 0, -1, DM / 256, G, bx);
        EpiStore E{(bf16_t*)(ws + WS_MG), DM, 0, -1, 0};
        gemm_phase<EpiStore, Order>(lds, g, S, E); SEAM(9); }
    if (IN(10)) { phase10(args, gw, NGW, lane);
    }
#undef IN
#undef SEAM
}

extern "C" void kernel_launch(void* const* d_in, const int* in_sizes, int n_in, void* d_out, int out_size, void* d_ws, size_t ws_size, hipStream_t stream) {
    static int grid = 0;
    if (grid == 0) {
        if (n_in != 17 || ws_size < WS_NEED || out_size != NB * SEQ * DM) { fprintf(stderr, "kernel_launch: unexpected problem (n_in %d, ws %zu, out %d)\n", n_in, ws_size, out_size); grid = -1; return; }
        int dev = 0, cus = 0, per_cu = 0;
        if (hipGetDevice(&dev) != hipSuccess || hipDeviceGetAttribute(&cus, hipDeviceAttributeMultiprocessorCount, dev) != hipSuccess) { grid = -1; return; }
        if (hipFuncSetAttribute((const void*)fwd_megakernel, hipFuncAttributeMaxDynamicSharedMemorySize, LDS_BYTES) != hipSuccess) { fprintf(stderr, "kernel_launch: hipFuncSetAttribute failed\n"); grid = -1; return; }
        if (hipOccupancyMaxActiveBlocksPerMultiprocessor(&per_cu, (const void*)fwd_megakernel, NWAVES * 64, LDS_BYTES) != hipSuccess || per_cu < 1) { fprintf(stderr, "kernel_launch: occupancy query says %d\n", per_cu); per_cu = 1; }
        (void)hipGetLastError();
        grid = cus * 1;
    }
    if (grid < 0) return;
    Args a{};
    for (int i = 0; i < 17; ++i) a.in[i] = (const float*)d_in[i];
    a.out = (float*)d_out; a.ws = (unsigned char*)d_ws; a.ph_lo = 0; a.ph_hi = N_PHASES;
    void* kargs[] = {&a};
    hipError_t e = hipLaunchCooperativeKernel((const void*)fwd_megakernel, dim3(grid), dim3(NWAVES * 64), kargs, LDS_BYTES, stream);
    if (e != hipSuccess) fprintf(stderr, "kernel_launch: cooperative launch failed: %s (grid %d)\n", hipGetErrorString(e), grid);
}
```

```cpp
#include <hip/hip_runtime.h>
#include <hip/hip_cooperative_groups.h>
#include <cstdio>
#include <cstdint>
namespace cg = cooperative_groups;

constexpr int NB = 8, SEQ = 8192, NMETA = 16, LSEQ = 8208, DM = 1024, DFF = 2816, INC = 4096;
constexpr int R_META = 65536, R_TOT = 65792;
constexpr int KD = 4224, NHALF = LSEQ / 2;
constexpr int KH = 4352, KHT = 17;
constexpr float RMS_EPS = 1e-6f;
__device__ __forceinline__ int row_of(int b, int pos) { return pos >= NMETA ? b * SEQ + pos - NMETA : R_META + b * NMETA + pos; }

namespace pg8 {
#define PG8_LAS __attribute__((address_space(3)))
typedef unsigned short bf16_t;
typedef short bf16x8 __attribute__((ext_vector_type(8)));
typedef float f32x4 __attribute__((ext_vector_type(4)));
typedef unsigned u32x4 __attribute__((ext_vector_type(4)));
constexpr int BM = 256, BK = 64, HALF = 128, HTB = HALF * BK * 2, STAGE_BYTES = 8 * HTB, NXCD = 8, WGM = 8;

__host__ __device__ __forceinline__ int lds_byte(int r, int c) { const int st = (r >> 4) * 2 + (c >> 5), rr = r & 15, cc = c & 31, ob = rr * 64 + cc * 2; return st * 1024 + (ob ^ (((ob >> 9) & 1) << 5)); }
__host__ __device__ __forceinline__ void stage_rc(int b, int& R, int& C) { const int st = b / 1024, sb = b % 1024, swz = sb ^ (((sb >> 9) & 1) << 5); R = (st >> 1) * 16 + swz / 64; C = (st & 1) * 32 + (swz % 64) / 2; }
__host__ __device__ __forceinline__ int perm32(int rho) { const int n = rho >> 4, i = rho & 15; return 8 * (i >> 2) + 4 * n + (i & 3); }

struct Unit { int pm, pn, arow; };
struct Gemm { const bf16_t* A; const bf16_t* Bt; int K; };

struct Order {
    int nM, nN, nwg, G, c, pm0, nMain, pm_extra;
    __device__ void init(int nMain_, int pm0_, int pm_extra_, int nN_, int G_, int c_) { nMain = nMain_; pm0 = pm0_; pm_extra = pm_extra_; nM = nMain_ + (pm_extra_ >= 0 ? 1 : 0); nN = nN_; nwg = nM * nN; G = G_; c = c_; }
    __device__ bool next(int i, Unit& u) const {
        const long L = (long)i * G + c; if (L >= nwg) return false;
        int wgid = (int)L; { const int q = nwg / NXCD, r = nwg % NXCD, xcd = wgid % NXCD, off = wgid / NXCD; wgid = (xcd < r ? xcd * (q + 1) : r * (q + 1) + (xcd - r) * q) + off; }
        const int nig = WGM * nN, gid = wgid / nig, fm = gid * WGM, gsz = (nM - fm) < WGM ? (nM - fm) : WGM;
        const int t = fm + ((wgid % nig) % gsz); u.pm = (t < nMain) ? pm0 + t : pm_extra; u.pn = (wgid % nig) / gsz; u.arow = u.pm * BM; return true;
    }
    __device__ __forceinline__ void a_ready(const Unit&) const {}
    __device__ __forceinline__ void done(const Unit&) const {}
};
struct OrderDft {
    int G, c;
    __device__ void init(int G_, int c_) { G = G_; c = c_; }
    __device__ bool next(int i, Unit& u) const {
        constexpr int nM = 32, nN = 16, nwg = nM * nN;
        const long L = (long)i * G + c; if (L >= nwg) return false;
        int wgid = (int)L; { const int q = nwg / NXCD, xcd = wgid % NXCD, off = wgid / NXCD; wgid = xcd * q + off; }
        const int nig = WGM * nN, gid = wgid / nig, fm = gid * WGM;
        const int t = fm + ((wgid % nig) % WGM), pn = (wgid % nig) / WGM, part = t >> 4;
        u.pm = part * KHT + (t & 15); u.pn = part * 16 + pn; u.arow = u.pm * BM; return true;
    }
    __device__ __forceinline__ void a_ready(const Unit&) const {}
    __device__ __forceinline__ void done(const Unit&) const {}
};
constexpr int H2F_PITCH = 8448, FFN_TPB = 33, FFN_STEP = 254;
struct OrderFfn : Order {
    __device__ bool next(int i, Unit& u) const { if (!Order::next(i, u)) return false; const int b = u.pm / FFN_TPB, t = u.pm - b * FFN_TPB; u.arow = b * H2F_PITCH + FFN_STEP * t; return true; }
};
__device__ __forceinline__ unsigned cvt_pk_bf16(float lo, float hi) { unsigned r; asm volatile("v_cvt_pk_bf16_f32 %0, %1, %2" : "=v"(r) : "v"(lo), "v"(hi)); return r; }
__device__ __forceinline__ u32x4 pack8(const f32x4 v0, const f32x4 v1) { u32x4 w; w.x = cvt_pk_bf16(v0[0], v0[1]); w.y = cvt_pk_bf16(v0[2], v0[3]); w.z = cvt_pk_bf16(v1[0], v1[1]); w.w = cvt_pk_bf16(v1[2], v1[3]); return w; }
__device__ __forceinline__ float bflo(unsigned w) { return __uint_as_float(w << 16); }
__device__ __forceinline__ float bfhi(unsigned w) { return __uint_as_float(w & 0xffff0000u); }
__device__ __forceinline__ void unpack8(const u32x4 w, f32x4& v0, f32x4& v1) { v0 = (f32x4){bflo(w.x), bfhi(w.x), bflo(w.y), bfhi(w.y)}; v1 = (f32x4){bflo(w.z), bfhi(w.z), bflo(w.w), bfhi(w.w)}; }
__device__ __forceinline__ float sigmoidf_(float x) { return __builtin_amdgcn_rcpf(1.0f + __expf(-x)); }
#define EPI_LOOP_AM _Pragma("unroll") for (int ai = 0; ai < 2; ++ai) _Pragma("unroll") for (int m = 0; m < 4; ++m)
#define EPI_LOOP_BJ _Pragma("unroll") for (int bj = 0; bj < 2; ++bj)
typedef const f32x4 (&AccT)[2][2][4][2];

struct EpiProj { static constexpr bool PERM = true, AFTER_DRAIN = false, RPT = true;
    bf16_t* P; const float* bg;
    __device__ __forceinline__ void operator()(AccT acc, const Unit& u, int wr, int wc, int fr, int fq) const {
        const int row0 = u.pm * BM + wr * 64 + fr, colt = u.pn * BM + wc * 32 + 8 * fq;
        const bool gate = u.pn >= 8;
        f32x4 bv[2][2];
        EPI_LOOP_BJ { _Pragma("unroll") for (int n = 0; n < 2; ++n) bv[bj][n] = gate ? *(const f32x4*)(bg + (colt - 2048) + bj * HALF + 4 * n) : (f32x4){0.f, 0.f, 0.f, 0.f}; }
        EPI_LOOP_AM { bf16_t* rowp = P + (size_t)(row0 + ai * HALF + m * 16) * INC + colt;
            EPI_LOOP_BJ { f32x4 v0 = acc[ai][bj][m][0] + bv[bj][0], v1 = acc[ai][bj][m][1] + bv[bj][1];
                if (gate) { _Pragma("unroll") for (int j = 0; j < 4; ++j) { v0[j] = sigmoidf_(v0[j]); v1[j] = sigmoidf_(v1[j]); } }
                *(u32x4*)(rowp + bj * HALF) = pack8(v0, v1); } }
    }
};
struct EpiDft { static constexpr bool PERM = true, AFTER_DRAIN = false, RPT = true;
    bf16_t* F;
    __device__ __forceinline__ void operator()(AccT acc, const Unit& u, int wr, int wc, int fr, int fq) const {
        const int part = u.pm / KHT, kt = u.pm - part * KHT;
        const int colg = (u.pn & 15) * BM + wc * 32 + 8 * fq;
        const unsigned sgn = part ? 0x80008000u : 0u;
        EPI_LOOP_AM { const int k = kt * BM + ai * HALF + wr * 64 + m * 16 + fr;
            {
                EPI_LOOP_BJ { const int cg_ = colg + bj * HALF, b = cg_ >> 9, ch = cg_ & 511;
                    u32x4 w = pack8(acc[ai][bj][m][0], acc[ai][bj][m][1]);
                    *(u32x4*)(F + (size_t)row_of(b, k) * DM + part * 512 + ch) = w;
                    if (k >= 1) { w.x ^= sgn; w.y ^= sgn; w.z ^= sgn; w.w ^= sgn;
                        *(u32x4*)(F + (size_t)row_of(b, LSEQ - k) * DM + part * 512 + ch) = w; } } } }
    }
};
struct EpiYa { static constexpr bool PERM = true, AFTER_DRAIN = false, RPT = true;
    bf16_t* Mg; const bf16_t* P;
    __device__ __forceinline__ void operator()(AccT acc, const Unit& u, int wr, int wc, int fr, int fq) const {
        const int row0 = u.pm * BM + wr * 64 + fr, colt = u.pn * BM + wc * 32 + 8 * fq;
        EPI_LOOP_AM { const size_t row = (size_t)(row0 + ai * HALF + m * 16);
            EPI_LOOP_BJ { const u32x4 gw = *(const u32x4*)(P + row * INC + 2048 + colt + bj * HALF); f32x4 g0, g1; unpack8(gw, g0, g1);
                *(u32x4*)(Mg + row * DM + colt + bj * HALF) = pack8(acc[ai][bj][m][0] * g0, acc[ai][bj][m][1] * g1); }
            asm volatile("" ::: "memory"); }
    }
};
struct EpiYb { static constexpr bool PERM = true, AFTER_DRAIN = false, RPT = false;
    bf16_t* Mg; const bf16_t* P;
    __device__ __forceinline__ void operator()(AccT acc, const Unit& u, int wr, int wc, int fr, int fq) const {
        const int row0 = u.pm * BM + wr * 64 + fr, colt = u.pn * BM + wc * 32 + 8 * fq;
        EPI_LOOP_AM { const size_t row = (size_t)(row0 + ai * HALF + m * 16);
            EPI_LOOP_BJ { const u32x4 gw = *(const u32x4*)(P + row * INC + 3072 + colt + bj * HALF); f32x4 g0, g1; unpack8(gw, g0, g1);
                const u32x4 tw = *(const u32x4*)(Mg + row * DM + colt + bj * HALF); f32x4 t0, t1; unpack8(tw, t0, t1);
                *(u32x4*)(Mg + row * DM + colt + bj * HALF) = pack8(t0 + acc[ai][bj][m][0] * g0, t1 + acc[ai][bj][m][1] * g1); }
            asm volatile("" ::: "memory"); }
    }
};
struct EpiStore { static constexpr bool PERM = true, AFTER_DRAIN = false, RPT = true;
    bf16_t* O; int ldc, pm0, pm_extra, extra_local;
    __device__ __forceinline__ void operator()(AccT acc, const Unit& u, int wr, int wc, int fr, int fq) const {
        const int lt = (u.pm == pm_extra) ? extra_local : u.pm - pm0;
        const int row0 = lt * BM + wr * 64 + fr, colt = u.pn * BM + wc * 32 + 8 * fq;
        EPI_LOOP_AM { bf16_t* rowp = O + (size_t)(row0 + ai * HALF + m * 16) * ldc + colt;
            EPI_LOOP_BJ { *(u32x4*)(rowp + bj * HALF) = pack8(acc[ai][bj][m][0], acc[ai][bj][m][1]); } }
    }
};
struct EpiF32 { static constexpr bool PERM = false, AFTER_DRAIN = false, RPT = true;
    float* C; int ldc, tile_off;
    __device__ __forceinline__ void operator()(AccT acc, const Unit& u, int wr, int wc, int fr, int fq) const {
        const int row0 = (u.pm + tile_off) * BM + wr * 64 + fr, col0 = u.pn * BM + wc * 32 + 4 * fq;
        EPI_LOOP_AM { float* rowp = C + (size_t)(row0 + ai * HALF + m * 16) * ldc + col0;
            EPI_LOOP_BJ { _Pragma("unroll") for (int n = 0; n < 2; ++n) *(f32x4*)(rowp + bj * HALF + n * 16) = acc[ai][bj][m][n]; } }
    }
};

struct EpiFfn { static constexpr bool PERM = true, AFTER_DRAIN = false, RPT = true;
    bf16_t* act; const float* cw; const float* cb; PG8_LAS unsigned char* slab;
    typedef unsigned u32x2 __attribute__((ext_vector_type(2)));
    __device__ __forceinline__ static f32x4 up4(const u32x2 w) { return (f32x4){bflo(w.x), bfhi(w.x), bflo(w.y), bfhi(w.y)}; }
    __device__ __forceinline__ void operator()(AccT acc, const Unit& u, int wr, int wc, int fr, int fq) const {
        const int tid = threadIdx.x, cg8 = tid & 7, rrow = tid >> 3, chunk = cg8 >> 1, hoff = (cg8 & 1) * 8;
        const int b = u.pm / FFN_TPB, t = u.pm - b * FFN_TPB;
#pragma unroll 1
        for (int s = 0; s < 4; ++s) {
            if (wc == s) {
                EPI_LOOP_AM { const int row = ai * HALF + wr * 64 + m * 16 + fr; PG8_LAS unsigned char* rp = slab + row * 128;
                    *(PG8_LAS u32x4*)(rp + ((fq ^ (row & 7)) << 4)) = pack8(acc[ai][0][m][0], acc[ai][0][m][1]);
                    *(PG8_LAS u32x4*)(rp + (((4 + fq) ^ (row & 7)) << 4)) = pack8(acc[ai][1][m][0], acc[ai][1][m][1]); } }
            asm volatile("s_waitcnt lgkmcnt(0)" ::: "memory"); __builtin_amdgcn_s_barrier(); asm volatile("" ::: "memory");
            const int j0 = u.pn * HALF + s * 32 + cg8 * 4;
            const f32x4 ka0 = *(const f32x4*)(cw + j0), ka1 = *(const f32x4*)(cw + 2 * DFF + j0), ka2 = *(const f32x4*)(cw + 4 * DFF + j0), kab = *(const f32x4*)(cb + j0);
            const f32x4 kv0 = *(const f32x4*)(cw + DFF + j0), kv1 = *(const f32x4*)(cw + 3 * DFF + j0), kv2 = *(const f32x4*)(cw + 5 * DFF + j0), kvb = *(const f32x4*)(cb + DFF + j0);
#pragma unroll 1
            for (int i2 = 0; i2 < 4; ++i2) { const int row = rrow + 64 * i2, iloc = FFN_STEP * t + row;
                if (row >= 1 && row <= 254 && iloc <= SEQ) {
                    const PG8_LAS unsigned char* p0 = slab + (row - 1) * 128 + hoff; const PG8_LAS unsigned char* p1 = p0 + 128; const PG8_LAS unsigned char* p2 = p1 + 128;
                    const int s0 = (row - 1) & 7, s1 = row & 7, s2 = (row + 1) & 7;
                    const f32x4 a0 = up4(*(const PG8_LAS u32x2*)(p0 + ((chunk ^ s0) << 4))), a1 = up4(*(const PG8_LAS u32x2*)(p1 + ((chunk ^ s1) << 4))), a2 = up4(*(const PG8_LAS u32x2*)(p2 + ((chunk ^ s2) << 4)));
                    const f32x4 v0 = up4(*(const PG8_LAS u32x2*)(p0 + (((4 + chunk) ^ s0) << 4))), v1 = up4(*(const PG8_LAS u32x2*)(p1 + (((4 + chunk) ^ s1) << 4))), v2 = up4(*(const PG8_LAS u32x2*)(p2 + (((4 + chunk) ^ s2) << 4)));
                    const f32x4 ca = kab + ka0 * a0 + ka1 * a1 + ka2 * a2, cv = kvb + kv0 * v0 + kv1 * v1 + kv2 * v2;
                    f32x4 o;
#pragma unroll
                    for (int e = 0; e < 4; ++e) { const float x = ca[e]; const float z2 = 1.5957691216057308f * (x + 0.044715f * x * x * x); o[e] = x * __builtin_amdgcn_rcpf(1.0f + __expf(-z2)) * cv[e]; }
                    u32x2 w; w.x = cvt_pk_bf16(o[0], o[1]); w.y = cvt_pk_bf16(o[2], o[3]);
                    *(u32x2*)(act + (size_t)(b * SEQ + iloc - 1) * DFF + j0) = w;
                } }
            asm volatile("s_waitcnt lgkmcnt(0)" ::: "memory"); __builtin_amdgcn_s_barrier(); asm volatile("" ::: "memory");
        }
    }
};

template <class Epi, class Sched, bool ALIGN_EPI = true, bool SP2 = true>
__device__ __forceinline__ void gemm_phase(PG8_LAS unsigned char* lds, const Gemm g, const Sched& S, const Epi& E) {
    const int tid = threadIdx.x, wid = __builtin_amdgcn_readfirstlane(tid >> 6), lane = tid & 63, wr = wid >> 2, wc = wid & 3, fr = lane & 15, fq = lane >> 4;
    const int K = g.K, nt = K / BK;
    unsigned voffA[2], voffB[2];
#pragma unroll
    for (int i = 0; i < 2; ++i) { int R, C; stage_rc(tid * 16 + i * 8192, R, C); const int Rb = Epi::PERM ? ((R & ~31) + perm32(R & 31)) : R;
        voffA[i] = (unsigned)(R * K + C) * 2u; voffB[i] = (unsigned)(Rb * K + C) * 2u; }
    const size_t kstep = (size_t)(BK * 2);
    const size_t hstep = (size_t)HALF * K * 2;
    const size_t tstep = 2 * hstep;
    const unsigned ldsw = (unsigned)wid * 1024u;
    const int aoff = lds_byte(wr * 64 + fr, fq * 8), boff = lds_byte(wc * 32 + fr, fq * 8);
#define PG8_SA(b, h) (((b) * 2 + (h)) * HTB)
#define PG8_SB(b, h) ((4 + (b) * 2 + (h)) * HTB)
#define PG8_STAGE(bufoff, gbase, voff) do { _Pragma("unroll") for (int _i = 0; _i < 2; ++_i) \
        __builtin_amdgcn_global_load_lds((const unsigned*)((const char*)(gbase) + (voff)[_i]), (PG8_LAS unsigned*)(lds + (bufoff) + ldsw + _i * 8192), 16, 0, 0); } while (0)
#define PG8_LDA(dst, b, h) do { _Pragma("unroll") for (int m = 0; m < 4; ++m) _Pragma("unroll") for (int k = 0; k < 2; ++k) dst[m][k] = *(const PG8_LAS bf16x8*)(lds + PG8_SA(b, h) + aoff + m * 2048 + k * 1024); } while (0)
#define PG8_LDB(dst, b, h) do { _Pragma("unroll") for (int n = 0; n < 2; ++n) _Pragma("unroll") for (int k = 0; k < 2; ++k) dst[n][k] = *(const PG8_LAS bf16x8*)(lds + PG8_SB(b, h) + boff + n * 2048 + k * 1024); } while (0)
#define PG8_MMA(ai, bj, At, Bt) do { __builtin_amdgcn_s_setprio(1); _Pragma("unroll") for (int m = 0; m < 4; ++m) _Pragma("unroll") for (int n = 0; n < 2; ++n) _Pragma("unroll") for (int k = 0; k < 2; ++k) \
        acc[ai][bj][m][n] = __builtin_amdgcn_mfma_f32_16x16x32_bf16(Bt[n][k], At[m][k], acc[ai][bj][m][n], 0, 0, 0); __builtin_amdgcn_s_setprio(0); } while (0)
#define PG8_WAIT_V(n) asm volatile("s_waitcnt vmcnt(" #n ")" ::: "memory")
#define PG8_WAIT_L(n) asm volatile("s_waitcnt lgkmcnt(" #n ")" ::: "memory")
#define PG8_BAR __builtin_amdgcn_s_barrier()
#define PG8_SCHED __builtin_amdgcn_sched_barrier(0)
    Unit cur, nxt; int ui = 0;
    if (!S.next(0, cur)) return;
    f32x4 acc[2][2][4][2];
#pragma unroll
    for (int a = 0; a < 2; ++a)
#pragma unroll
        for (int b = 0; b < 2; ++b)
#pragma unroll
            for (int m = 0; m < 4; ++m)
#pragma unroll
                for (int n = 0; n < 2; ++n) acc[a][b][m][n] = (f32x4){0.f, 0.f, 0.f, 0.f};
    bf16x8 At[4][2], B0[2][2], B1[2][2];
    const size_t rowb = (size_t)K * 2; const char* cA = (const char*)g.A + (size_t)cur.arow * rowb; const char* cB = (const char*)g.Bt + (size_t)cur.pn * tstep;
    S.a_ready(cur);
    if constexpr (SP2) {
        PG8_STAGE(PG8_SB(0, 0), cB, voffB); PG8_STAGE(PG8_SB(0, 1), cB + hstep, voffB); PG8_STAGE(PG8_SA(0, 0), cA, voffA); PG8_STAGE(PG8_SA(0, 1), cA + hstep, voffA);
        if (wr == 1) PG8_BAR;
        PG8_WAIT_V(2); PG8_BAR;
        PG8_STAGE(PG8_SB(1, 0), cB + kstep, voffB); PG8_STAGE(PG8_SA(1, 0), cA + kstep, voffA); PG8_STAGE(PG8_SB(1, 1), cB + hstep + kstep, voffB);
        PG8_WAIT_V(6); PG8_BAR;
    } else {
        PG8_STAGE(PG8_SB(0, 0), cB, voffB); PG8_STAGE(PG8_SA(0, 0), cA, voffA); PG8_STAGE(PG8_SB(0, 1), cB + hstep, voffB); PG8_STAGE(PG8_SA(0, 1), cA + hstep, voffA);
        if (wr == 1) PG8_BAR;
        PG8_WAIT_V(4); PG8_BAR;
        PG8_STAGE(PG8_SB(1, 0), cB + kstep, voffB); PG8_STAGE(PG8_SA(1, 0), cA + kstep, voffA); PG8_STAGE(PG8_SB(1, 1), cB + hstep + kstep, voffB);
        PG8_WAIT_V(6); PG8_BAR;
    }
    for (;;) {
        const bool has_next = S.next(ui + 1, nxt);
        const char* nA = has_next ? (const char*)g.A + (size_t)nxt.arow * rowb : cA; const char* nB = has_next ? (const char*)g.Bt + (size_t)nxt.pn * tstep : cB;
        for (int t = 0; t < nt; t += 2) {
            const bool last = (t == nt - 2);
            const char* a1 = cA + (size_t)(t + 1) * kstep;
            const char* a2 = last ? nA : cA + (size_t)(t + 2) * kstep; const char* b2 = last ? nB : cB + (size_t)(t + 2) * kstep;
            const char* a3 = a2 + kstep; const char* b3 = b2 + kstep;
            if (last && has_next) S.a_ready(nxt);
            if constexpr (SP2) {
            PG8_LDB(B0, 0, 0); PG8_LDB(B1, 0, 1); PG8_SCHED; PG8_LDA(At, 0, 0); PG8_STAGE(PG8_SA(1, 1), a1 + hstep, voffA);
            PG8_WAIT_V(8); PG8_WAIT_L(0); PG8_BAR; PG8_MMA(0, 0, At, B0); PG8_MMA(0, 1, At, B1); PG8_BAR; PG8_SCHED;
            PG8_LDA(At, 0, 1); PG8_STAGE(PG8_SB(0, 0), b2, voffB); PG8_STAGE(PG8_SB(0, 1), b2 + hstep, voffB); PG8_STAGE(PG8_SA(0, 0), a2, voffA);
            PG8_WAIT_V(8); PG8_WAIT_L(0); PG8_BAR; PG8_MMA(1, 0, At, B0); PG8_MMA(1, 1, At, B1); PG8_BAR; PG8_SCHED;
            PG8_LDB(B0, 1, 0); PG8_LDB(B1, 1, 1); PG8_SCHED; PG8_LDA(At, 1, 0); PG8_STAGE(PG8_SA(0, 1), a2 + hstep, voffA);
            PG8_WAIT_V(8); PG8_WAIT_L(0); PG8_BAR; PG8_MMA(0, 0, At, B0); PG8_MMA(0, 1, At, B1); PG8_BAR; PG8_SCHED;
            PG8_LDA(At, 1, 1); PG8_STAGE(PG8_SB(1, 0), b3, voffB); PG8_STAGE(PG8_SB(1, 1), b3 + hstep, voffB); PG8_STAGE(PG8_SA(1, 0), a3, voffA);
            PG8_WAIT_V(8); PG8_WAIT_L(0); PG8_BAR; PG8_MMA(1, 0, At, B0); PG8_MMA(1, 1, At, B1); PG8_BAR; PG8_SCHED;
            } else {
            PG8_LDB(B0, 0, 0); PG8_SCHED; PG8_LDA(At, 0, 0); PG8_STAGE(PG8_SA(1, 1), a1 + hstep, voffA);
            PG8_WAIT_L(8); PG8_BAR; PG8_WAIT_L(0); PG8_MMA(0, 0, At, B0); PG8_BAR; PG8_SCHED;
            PG8_LDB(B1, 0, 1); PG8_STAGE(PG8_SB(0, 0), b2, voffB);
            PG8_BAR; PG8_WAIT_L(0); PG8_MMA(0, 1, At, B1); PG8_BAR;
            PG8_LDA(At, 0, 1); PG8_STAGE(PG8_SA(0, 0), a2, voffA);
            PG8_BAR; PG8_WAIT_L(0); PG8_MMA(1, 0, At, B0); PG8_BAR; PG8_SCHED;
            PG8_STAGE(PG8_SB(0, 1), b2 + hstep, voffB);
            PG8_WAIT_V(6); PG8_BAR; PG8_MMA(1, 1, At, B1); PG8_BAR;
            PG8_LDB(B0, 1, 0); PG8_SCHED; PG8_LDA(At, 1, 0); PG8_STAGE(PG8_SA(0, 1), a2 + hstep, voffA);
            PG8_WAIT_L(8); PG8_BAR; PG8_WAIT_L(0); PG8_MMA(0, 0, At, B0); PG8_BAR; PG8_SCHED;
            PG8_LDB(B1, 1, 1); PG8_STAGE(PG8_SB(1, 0), b3, voffB);
            PG8_BAR; PG8_WAIT_L(0); PG8_MMA(0, 1, At, B1); PG8_BAR;
            PG8_LDA(At, 1, 1); PG8_STAGE(PG8_SA(1, 0), a3, voffA);
            PG8_BAR; PG8_WAIT_L(0); PG8_MMA(1, 0, At, B0); PG8_BAR; PG8_SCHED;
            PG8_STAGE(PG8_SB(1, 1), b3 + hstep, voffB);
            PG8_WAIT_V(6); PG8_BAR; PG8_MMA(1, 1, At, B1); PG8_BAR;
            }
        }
        if constexpr (ALIGN_EPI) { if (wr == 0) PG8_BAR; }
        if constexpr (!Epi::AFTER_DRAIN) { E(acc, cur, wr, wc, fr, fq);
            S.done(cur); }
        if (!has_next) break;
#pragma unroll
        for (int a = 0; a < 2; ++a)
#pragma unroll
            for (int b = 0; b < 2; ++b)
#pragma unroll
                for (int m = 0; m < 4; ++m)
#pragma unroll
                    for (int n = 0; n < 2; ++n) acc[a][b][m][n] = (f32x4){0.f, 0.f, 0.f, 0.f};
        cur = nxt; cA = nA; cB = nB; ++ui;
        if constexpr (ALIGN_EPI) { if (wr == 1) PG8_BAR; }
    }
    PG8_WAIT_V(0);
    if constexpr (!ALIGN_EPI) { if (wr == 0) PG8_BAR; }
    PG8_BAR;
    if constexpr (Epi::AFTER_DRAIN) { E.fused(acc, cur, wr, wc, fr, fq, lds, wid, lane); S.done(cur); }
#undef PG8_SA
#undef PG8_SB
#undef PG8_STAGE
#undef PG8_LDA
#undef PG8_LDB
#undef PG8_MMA
#undef PG8_WAIT_V
#undef PG8_WAIT_L
#undef PG8_BAR
#undef PG8_SCHED
}
}

constexpr int NWAVES = 8;
constexpr int LDS_BYTES = 163840;
constexpr size_t MiB = 1u << 20;
constexpr size_t WS_WIN = 1 * MiB, WS_WEFF = 9 * MiB, WS_WCO = 11 * MiB, WS_WOUT = 12 * MiB, WS_WUP = 14 * MiB, WS_WDN = 25 * MiB;
constexpr size_t WS_H = 32 * MiB;
constexpr size_t WS_PROJ = 161 * MiB;
constexpr size_t WS_H2 = 161 * MiB;
constexpr size_t WS_ACT = 300 * MiB;
constexpr size_t WS_ZB = 675 * MiB;
constexpr size_t WS_F = 740 * MiB;
constexpr size_t WS_MG = 869 * MiB;
constexpr size_t WS_NEED = 1000 * MiB;
constexpr size_t DO_DM = 0, DO_UT = 72 * MiB;
static_assert((size_t)2 * KH * KD * 2 <= DO_UT && DO_UT + (size_t)2 * 4096 * KD * 2 <= 256 * MiB, "d_out scratch map");
static_assert(WS_H + (size_t)R_TOT * DM * 2 <= WS_PROJ && WS_PROJ + (size_t)R_TOT * INC * 2 <= WS_ZB && WS_ZB + (size_t)R_TOT * 512 * 2 <= WS_F && WS_F + (size_t)R_TOT * DM * 2 <= WS_MG && WS_MG + (size_t)R_TOT * DM * 2 <= WS_NEED, "ws map 1");
static_assert(WS_H2 + (size_t)NB * pg8::H2F_PITCH * DM * 2 <= WS_ACT && WS_ACT + (size_t)65536 * DFF * 2 <= WS_MG, "ws map 2");

#define LAS __attribute__((address_space(3)))
typedef unsigned short bf16;
typedef unsigned v4u __attribute__((ext_vector_type(4)));
typedef unsigned v2u __attribute__((ext_vector_type(2)));
typedef float f32x4 __attribute__((ext_vector_type(4)));
#define LDS_WAIT() asm volatile("s_waitcnt lgkmcnt(0)" ::: "memory")
using pg8::cvt_pk_bf16; using pg8::bflo; using pg8::bfhi;

__device__ __forceinline__ float wave_sum(float v) {
#pragma unroll
    for (int o = 1; o < 64; o <<= 1) v += __shfl_xor(v, o);
    return v;
}
__device__ __forceinline__ void unpack8f(const v4u w, float (&f)[8]) { f[0] = bflo(w.x); f[1] = bfhi(w.x); f[2] = bflo(w.y); f[3] = bfhi(w.y); f[4] = bflo(w.z); f[5] = bfhi(w.z); f[6] = bflo(w.w); f[7] = bfhi(w.w); }
__device__ __forceinline__ v4u pack8f(const float (&f)[8]) { v4u w; w.x = cvt_pk_bf16(f[0], f[1]); w.y = cvt_pk_bf16(f[2], f[3]); w.z = cvt_pk_bf16(f[4], f[5]); w.w = cvt_pk_bf16(f[6], f[7]); return w; }
__device__ __forceinline__ void load8f(const float* p, float (&f)[8]) { const f32x4 a = *(const f32x4*)p, b = *(const f32x4*)(p + 4); f[0] = a.x; f[1] = a.y; f[2] = a.z; f[3] = a.w; f[4] = b.x; f[5] = b.y; f[6] = b.z; f[7] = b.w; }

struct Args { const float* in[17]; float* out; unsigned char* ws; int ph_lo, ph_hi; };
enum { I_X = 0, I_META, I_GMIXPRE, I_WIN, I_BGATES, I_WFOURIER, I_CWMIX, I_CBMIX, I_WCONVOUT, I_WOUT, I_GMIXPOST, I_GFFNPRE, I_WUP, I_CWFFN, I_CBFFN, I_WDOWN, I_GFFNPOST };

__device__ __forceinline__ void p0_transpose_item(const float* __restrict__ W, int K, int N, bf16* __restrict__ WT, int k0, int n0, int drow0, LAS float* scr, int lane) {
    f32x4 tv[8];
#pragma unroll
    for (int i = 0; i < 8; ++i) tv[i] = *(const f32x4*)(W + (size_t)(k0 + i * 8 + (lane >> 3)) * N + n0 + 4 * (lane & 7));
#pragma unroll
    for (int i = 0; i < 8; ++i) { LAS float* d = scr + (i * 8 + (lane >> 3)) * 33 + 4 * (lane & 7); d[0] = tv[i].x; d[1] = tv[i].y; d[2] = tv[i].z; d[3] = tv[i].w; }
    LDS_WAIT();
    const int c = lane & 7;
#pragma unroll
    for (int j = 0; j < 4; ++j) { const int n = (lane >> 3) + 8 * j; const LAS float* s = scr + (8 * c) * 33 + n;
        v4u o; o.x = cvt_pk_bf16(s[0 * 33], s[1 * 33]); o.y = cvt_pk_bf16(s[2 * 33], s[3 * 33]); o.z = cvt_pk_bf16(s[4 * 33], s[5 * 33]); o.w = cvt_pk_bf16(s[6 * 33], s[7 * 33]);
        *(v4u*)(WT + (size_t)(drow0 + n) * K + k0 + 8 * c) = o; }
    LDS_WAIT();
}
__device__ __forceinline__ int wup_drow(int n0) { return n0 < DFF ? 256 * (n0 >> 7) + (n0 & 127) : 256 * ((n0 - DFF) >> 7) + 128 + ((n0 - DFF) & 127); }

__device__ __forceinline__ void phase0(const Args& a, LAS unsigned char* lds, int gw, int NGW, int wave, int lane) {
    unsigned char* ws = a.ws;
    LAS float* scr = (LAS float*)(lds + wave * 16384);
    constexpr int T_IN = 16 * 128, T_CO = 8 * 32, T_OUT = 16 * 32, T_UP = 16 * 176, T_DN = 44 * 32, T_ALL = T_IN + T_CO + T_OUT + T_UP + T_DN;
    for (int it = gw; it < T_ALL; it += NGW) {
        int r = it;
        if (r < T_IN) { const int kb = r / 128, nb = r % 128; p0_transpose_item(a.in[I_WIN], DM, INC, (bf16*)(ws + WS_WIN), kb * 64, nb * 32, nb * 32, scr, lane); continue; } r -= T_IN;
        if (r < T_CO) { const int kb = r / 32, nb = r % 32; p0_transpose_item(a.in[I_WCONVOUT], 512, DM, (bf16*)(ws + WS_WCO), kb * 64, nb * 32, nb * 32, scr, lane); continue; } r -= T_CO;
        if (r < T_OUT) { const int kb = r / 32, nb = r % 32; p0_transpose_item(a.in[I_WOUT], DM, DM, (bf16*)(ws + WS_WOUT), kb * 64, nb * 32, nb * 32, scr, lane); continue; } r -= T_OUT;
        if (r < T_UP) { const int kb = r / 176, nb = r % 176; p0_transpose_item(a.in[I_WUP], DM, 2 * DFF, (bf16*)(ws + WS_WUP), kb * 64, nb * 32, wup_drow(nb * 32), scr, lane); continue; } r -= T_UP;
        { const int kb = r / 32, nb = r % 32; p0_transpose_item(a.in[I_WDOWN], DFF, DM, (bf16*)(ws + WS_WDN), kb * 64, nb * 32, nb * 32, scr, lane); }
    }
    { const float* wf = a.in[I_WFOURIER]; bf16* we = (bf16*)(ws + WS_WEFF);
      for (int it = gw; it < 8192; it += NGW) { const int jb = it & 15, c = (it >> 4) & 127, g = it >> 11, j = jb * 64 + lane;
          float ac = 0.f, as = 0.f;
#pragma unroll 32
          for (int cp = 0; cp < 128; ++cp) { const float w = wf[(size_t)(g * 128 + cp) * DM + j]; const float ph = (float)((c * cp) & 127) * (1.0f / 128.0f);
              ac += __builtin_amdgcn_cosf(ph) * w; as += __builtin_amdgcn_sinf(ph) * w; }
          const float s = 0.08838834764831845f;
          we[(size_t)j * DM + g * 128 + c] = (bf16)(cvt_pk_bf16(ac * s, 0.f) & 0xffffu); we[(size_t)j * DM + 512 + g * 128 + c] = (bf16)(cvt_pk_bf16(as * s, 0.f) & 0xffffu); } }
    { bf16* dmat = (bf16*)((unsigned char*)a.out + DO_DM); constexpr int CPR = KD / 8;
      for (int it = gw; it < 2 * KH * CPR / 64; it += NGW) { const int chunk = it * 64 + lane, row = chunk / CPR, ci = chunk - row * CPR, n0 = ci * 8, part = row >= KH, k = row - part * KH;
          int mm = (int)(((unsigned)k * (unsigned)n0) % (unsigned)LSEQ); float f[8];
#pragma unroll
          for (int i = 0; i < 8; ++i) { const float ph = (float)mm * (1.0f / (float)LSEQ); const float v = part ? -__builtin_amdgcn_sinf(ph) : __builtin_amdgcn_cosf(ph);
              f[i] = (n0 + i <= NHALF) ? v * 0.011037770f : 0.f; mm += k; if (mm >= LSEQ) mm -= LSEQ; }
          *(v4u*)(dmat + (size_t)row * KD + n0) = pack8f(f); } }
    { const float* g = a.in[I_GMIXPRE]; bf16* h = (bf16*)(ws + WS_H);
      f32x4 gv[4];
#pragma unroll
      for (int j = 0; j < 4; ++j) gv[j] = ((const f32x4*)g)[lane + 64 * j];
      for (int r0 = gw; r0 < R_TOT; r0 += 2 * NGW) {
          f32x4 v[2][4]; float s2[2];
#pragma unroll
          for (int q = 0; q < 2; ++q) { const int r = r0 + q * NGW; s2[q] = 0.f;
              if (r < R_META + NB * NMETA) { const float* src = r < R_META ? a.in[I_X] + (size_t)r * DM : a.in[I_META] + (size_t)((r - R_META) & 15) * DM;
#pragma unroll
                  for (int j = 0; j < 4; ++j) v[q][j] = ((const f32x4*)src)[lane + 64 * j]; }
              else {
#pragma unroll
                  for (int j = 0; j < 4; ++j) v[q][j] = (f32x4){0.f, 0.f, 0.f, 0.f}; } }
#pragma unroll
          for (int q = 0; q < 2; ++q) {
#pragma unroll
              for (int j = 0; j < 4; ++j) s2[q] += (v[q][j].x * v[q][j].x + v[q][j].y * v[q][j].y) + (v[q][j].z * v[q][j].z + v[q][j].w * v[q][j].w); }
#pragma unroll
          for (int q = 0; q < 2; ++q) { const int r = r0 + q * NGW; if (r >= R_TOT) continue;
              const float rstd = rsqrtf(wave_sum(s2[q]) * (1.0f / DM) + RMS_EPS);
              unsigned long long* o8 = (unsigned long long*)(h + (size_t)r * DM) + lane;
#pragma unroll
              for (int j = 0; j < 4; ++j) { const f32x4 o = v[q][j] * rstd * gv[j]; o8[64 * j] = (unsigned long long)cvt_pk_bf16(o.x, o.y) | ((unsigned long long)cvt_pk_bf16(o.z, o.w) << 32); } }
      } }
}

__device__ __forceinline__ void phase2(const Args& a, LAS unsigned char* lds, int gw, int NGW, int wave, int lane) {
    unsigned char* ws = a.ws; const bf16* proj = (const bf16*)(ws + WS_PROJ);
    { bf16* eT = (bf16*)((unsigned char*)a.out + DO_UT); bf16* oT = eT + (size_t)4096 * KD;
      LAS bf16* scrE = (LAS bf16*)(lds + wave * 16896); LAS bf16* scrO = scrE + 64 * 66;
      constexpr int NBLK = KD / 64;
      for (int it = gw; it < NB * 8 * NBLK; it += NGW) { const int nblk = it % NBLK, cb = (it / NBLK) & 7, b = it / (8 * NBLK);
#pragma unroll
          for (int i = 0; i < 8; ++i) { const int nl = i * 8 + (lane >> 3), nh = nblk * 64 + nl, chunk = lane & 7;
              float e[8], o[8];
#pragma unroll
              for (int j = 0; j < 8; ++j) { e[j] = 0.f; o[j] = 0.f; }
              if (nh <= NHALF) { unpack8f(*(const v4u*)(proj + (size_t)row_of(b, nh) * INC + cb * 64 + chunk * 8), e);
                  if (nh >= 1 && nh < NHALF) { float u2[8]; unpack8f(*(const v4u*)(proj + (size_t)row_of(b, LSEQ - nh) * INC + cb * 64 + chunk * 8), u2);
#pragma unroll
                      for (int j = 0; j < 8; ++j) { o[j] = e[j] - u2[j]; e[j] = e[j] + u2[j]; } } }
              LAS bf16* dE = scrE + (chunk * 8) * 66 + nl; LAS bf16* dO = scrO + (chunk * 8) * 66 + nl;
#pragma unroll
              for (int j = 0; j < 8; ++j) { const unsigned w = cvt_pk_bf16(e[j], o[j]); dE[j * 66] = (bf16)(w & 0xffffu); dO[j * 66] = (bf16)(w >> 16); } }
          LDS_WAIT();
#pragma unroll
          for (int i = 0; i < 8; ++i) { const int ch = i * 8 + (lane >> 3), nc = lane & 7; const size_t off = (size_t)(b * 512 + cb * 64 + ch) * KD + nblk * 64 + nc * 8;
              const LAS unsigned* se = (const LAS unsigned*)(scrE + ch * 66 + nc * 8); const LAS unsigned* so = (const LAS unsigned*)(scrO + ch * 66 + nc * 8);
              v4u w; w.x = se[0]; w.y = se[1]; w.z = se[2]; w.w = se[3]; *(v4u*)(eT + off) = w;
              w.x = so[0]; w.y = so[1]; w.z = so[2]; w.w = so[3]; *(v4u*)(oT + off) = w; }
          LDS_WAIT(); } }
    { bf16* zb = (bf16*)(ws + WS_ZB); const float* cw = a.in[I_CWMIX]; const float* cbias = a.in[I_CBMIX];
      float w0[8], w1[8], w2[8], bb[8]; const int ch0 = lane * 8;
      load8f(cw + ch0, w0); load8f(cw + 512 + ch0, w1); load8f(cw + 1024 + ch0, w2); load8f(cbias + ch0, bb);
      for (int it = gw; it < NB * LSEQ; it += NGW) { const int b = it / LSEQ, p = it - b * LSEQ; const size_t r = (size_t)row_of(b, p);
          float cc[8], vv[8], bg[8], acc[8];
          unpack8f(*(const v4u*)(proj + r * INC + 512 + ch0), cc); unpack8f(*(const v4u*)(proj + r * INC + 1536 + ch0), vv); unpack8f(*(const v4u*)(proj + r * INC + 1024 + ch0), bg);
#pragma unroll
          for (int e = 0; e < 8; ++e) acc[e] = bb[e] + w1[e] * (cc[e] * vv[e]);
          if (p > 0) { const size_t rp = (size_t)row_of(b, p - 1); unpack8f(*(const v4u*)(proj + rp * INC + 512 + ch0), cc); unpack8f(*(const v4u*)(proj + rp * INC + 1536 + ch0), vv);
#pragma unroll
              for (int e = 0; e < 8; ++e) acc[e] += w0[e] * (cc[e] * vv[e]); }
          if (p < LSEQ - 1) { const size_t rn = (size_t)row_of(b, p + 1); unpack8f(*(const v4u*)(proj + rn * INC + 512 + ch0), cc); unpack8f(*(const v4u*)(proj + rn * INC + 1536 + ch0), vv);
#pragma unroll
              for (int e = 0; e < 8; ++e) acc[e] += w2[e] * (cc[e] * vv[e]); }
#pragma unroll
          for (int e = 0; e < 8; ++e) acc[e] *= bg[e];
          *(v4u*)(zb + r * 512 + ch0) = pack8f(acc); } }
}

template <int EPL> __device__ __forceinline__ void sk_load(unsigned (&a)[8][EPL / 2], const bf16* A, int lda, int row0, int rstride, int lane) {
#pragma unroll
    for (int r = 0; r < 8; ++r) { const v4u* p = (const v4u*)(A + (size_t)(row0 + r * rstride) * lda + lane * EPL);
#pragma unroll
        for (int i = 0; i < EPL / 8; ++i) { const v4u w = p[i]; a[r][4 * i] = w.x; a[r][4 * i + 1] = w.y; a[r][4 * i + 2] = w.z; a[r][4 * i + 3] = w.w; } }
}
template <int EPL> __device__ __forceinline__ float sk_dot(const unsigned (&a)[8][EPL / 2], const bf16* btrow, int lane) {
    unsigned b[EPL / 2];
#pragma unroll
    for (int i = 0; i < EPL / 8; ++i) { const v4u w = ((const v4u*)(btrow + lane * EPL))[i]; b[4 * i] = w.x; b[4 * i + 1] = w.y; b[4 * i + 2] = w.z; b[4 * i + 3] = w.w; }
    float acc[8];
#pragma unroll
    for (int r = 0; r < 8; ++r) acc[r] = 0.f;
#pragma unroll
    for (int i = 0; i < EPL / 2; ++i) { const float bl = bflo(b[i]), bh = bfhi(b[i]);
#pragma unroll
        for (int r = 0; r < 8; ++r) acc[r] += bflo(a[r][i]) * bl + bfhi(a[r][i]) * bh; }
    float res = 0.f;
#pragma unroll
    for (int r = 0; r < 8; ++r) { const float t = wave_sum(acc[r]); res = (lane == r) ? t : res; }
    return res;
}
__device__ __forceinline__ bf16 f2bf1(float v) { return (bf16)(cvt_pk_bf16(v, 0.f) & 0xffffu); }
__device__ __forceinline__ float bf2f1(bf16 h) { return __uint_as_float((unsigned)h << 16); }
constexpr int EDGE_ROW0 = R_META + NMETA - 1;

__device__ __forceinline__ void p1_meta(const Args& a, int gw, int NGW, int lane) {
    unsigned char* ws = a.ws; const bf16* h = (const bf16*)(ws + WS_H); const bf16* wt = (const bf16*)(ws + WS_WIN); bf16* proj = (bf16*)(ws + WS_PROJ); const float* bg = a.in[I_BGATES];
#pragma unroll 1
    for (int rg = 0; rg < 2; ++rg) { unsigned av[8][8]; sk_load<16>(av, h, DM, R_META + rg * 8, 1, lane);
#pragma unroll 1
        for (int j = gw; j < INC; j += NGW) { float v = sk_dot<16>(av, wt + (size_t)j * DM, lane);
            if (lane < 8) { if (j >= 2048) v = pg8::sigmoidf_(v + bg[j - 2048]); const bf16 o = f2bf1(v); const int pp = rg * 8 + lane;
#pragma unroll
                for (int b = 0; b < NB; ++b) proj[(size_t)(R_META + b * NMETA + pp) * INC + j] = o; } } }
}
__device__ __forceinline__ void p4_edge(const Args& a, int gw, int lane) {
    if (gw >= DM) return;
    unsigned char* ws = a.ws; const bf16* proj = (const bf16*)(ws + WS_PROJ); bf16* mg = (bf16*)(ws + WS_MG);
    unsigned aF[8][8], aZ[8][4]; sk_load<16>(aF, (const bf16*)(ws + WS_F), DM, EDGE_ROW0, NMETA, lane); sk_load<8>(aZ, (const bf16*)(ws + WS_ZB), 512, EDGE_ROW0, NMETA, lane);
    const int j = gw;
    const float ya = sk_dot<16>(aF, (const bf16*)(ws + WS_WEFF) + (size_t)j * DM, lane), yb = sk_dot<8>(aZ, (const bf16*)(ws + WS_WCO) + (size_t)j * 512, lane);
    if (lane < 8) { const size_t r = (size_t)(EDGE_ROW0 + lane * NMETA); mg[r * DM + j] = f2bf1(bf2f1(proj[r * INC + 2048 + j]) * ya + bf2f1(proj[r * INC + 3072 + j]) * yb); }
}
__device__ __forceinline__ void edge_gemm(const bf16* A, const bf16* Bt, int N, bf16* O, int ldo, int orow0, int ostride, int gw, int NGW, int lane) {
    if (gw >= N) return;
    unsigned av[8][8]; sk_load<16>(av, A, DM, EDGE_ROW0, NMETA, lane);
#pragma unroll 1
    for (int j = gw; j < N; j += NGW) { const float v = sk_dot<16>(av, Bt + (size_t)j * DM, lane);
        if (lane < 8) O[(size_t)(orow0 + lane * ostride) * ldo + j] = f2bf1(v); }
}

__device__ __forceinline__ void dft_tail(const Args& a, int gw, int NGW, int lane) {
    const bf16* dm = (const bf16*)((unsigned char*)a.out + DO_DM); const bf16* eT = (const bf16*)((unsigned char*)a.out + DO_UT); const bf16* oT = eT + (size_t)4096 * KD;
    bf16* F = (bf16*)(a.ws + WS_F);
    for (int row = gw; row < 4096; row += NGW) {
        float se[9], so[9];
#pragma unroll
        for (int kx = 0; kx < 9; ++kx) { se[kx] = 0.f; so[kx] = 0.f; }
        for (int it = 0; it < 9; ++it) { const int off = it * 512 + lane * 8;
            if (off < KD) { float ev[8], ov[8]; unpack8f(*(const v4u*)(eT + (size_t)row * KD + off), ev); unpack8f(*(const v4u*)(oT + (size_t)row * KD + off), ov);
#pragma unroll
                for (int kx = 0; kx < 9; ++kx) { float c[8], sn[8]; unpack8f(*(const v4u*)(dm + (size_t)(4096 + kx) * KD + off), c); unpack8f(*(const v4u*)(dm + (size_t)(KH + 4096 + kx) * KD + off), sn);
#pragma unroll
                    for (int e = 0; e < 8; ++e) { se[kx] += ev[e] * c[e]; so[kx] += ov[e] * sn[e]; } } } }
        float ve = 0.f, vo = 0.f;
#pragma unroll
        for (int kx = 0; kx < 9; ++kx) { const float te = wave_sum(se[kx]), to = wave_sum(so[kx]); if (lane == kx) { ve = te; vo = to; } }
        if (lane < 9) { const int b = row >> 9, ch = row & 511, k = 4096 + lane;
            const unsigned w = cvt_pk_bf16(ve, vo);
            F[(size_t)row_of(b, k) * DM + ch] = (bf16)(w & 0xffffu); F[(size_t)row_of(b, k) * DM + 512 + ch] = (bf16)(w >> 16);
            if (k != NHALF) { F[(size_t)row_of(b, LSEQ - k) * DM + ch] = (bf16)(w & 0xffffu); F[(size_t)row_of(b, LSEQ - k) * DM + 512 + ch] = (bf16)((w >> 16) ^ 0x8000u); } }
    }
}

__device__ __forceinline__ void phase6(const Args& a, int gw, int NGW, int lane) {
    unsigned char* ws = a.ws; const bf16* mix = (const bf16*)(ws + WS_H); bf16* h2 = (bf16*)(ws + WS_H2);
    float g1[2][8], g2[2][8];
#pragma unroll
    for (int j = 0; j < 2; ++j) { load8f(a.in[I_GMIXPOST] + 8 * lane + 512 * j, g1[j]); load8f(a.in[I_GFFNPRE] + 8 * lane + 512 * j, g2[j]); }
    constexpr int NR = R_META + 2 * NB;
    for (int r0 = gw; r0 < NR; r0 += 2 * NGW) {
        float mv[2][2][8], xv[2][2][8];
#pragma unroll
        for (int q = 0; q < 2; ++q) { int ri = (r0 + q * NGW < NR) ? r0 + q * NGW : r0; if (ri >= R_META + NB) ri = R_META;
            const int r = ri < R_META ? ri : EDGE_ROW0 + (ri - R_META) * NMETA;
            const float* src = r < R_META ? a.in[I_X] + (size_t)r * DM : a.in[I_META] + (size_t)(NMETA - 1) * DM;
#pragma unroll
            for (int j = 0; j < 2; ++j) { unpack8f(*(const v4u*)(mix + (size_t)r * DM + 8 * lane + 512 * j), mv[q][j]); load8f(src + 8 * lane + 512 * j, xv[q][j]); } }
#pragma unroll
        for (int q = 0; q < 2; ++q) { const int ri = r0 + q * NGW; if (ri >= NR) continue;
            const size_t orow = ri < R_META ? (size_t)(ri >> 13) * pg8::H2F_PITCH + (ri & 8191) + 1 : (ri < R_META + NB ? (size_t)(ri - R_META) * pg8::H2F_PITCH : (size_t)(ri - R_META - NB) * pg8::H2F_PITCH + SEQ + 1);
            if (ri >= R_META + NB) {
#pragma unroll
                for (int j = 0; j < 2; ++j) *(v4u*)(h2 + orow * DM + 8 * lane + 512 * j) = (v4u){0u, 0u, 0u, 0u};
                continue; }
            float s = 0.f;
#pragma unroll
            for (int j = 0; j < 2; ++j)
#pragma unroll
                for (int e = 0; e < 8; ++e) s += mv[q][j][e] * mv[q][j][e];
            const float r1 = rsqrtf(wave_sum(s) * (1.0f / DM) + RMS_EPS); float s2 = 0.f;
#pragma unroll
            for (int j = 0; j < 2; ++j)
#pragma unroll
                for (int e = 0; e < 8; ++e) { const float hr = xv[q][j][e] + mv[q][j][e] * r1 * g1[j][e]; xv[q][j][e] = hr; s2 += hr * hr; }
            const float r2 = rsqrtf(wave_sum(s2) * (1.0f / DM) + RMS_EPS);
#pragma unroll
            for (int j = 0; j < 2; ++j) { float o[8];
#pragma unroll
                for (int e = 0; e < 8; ++e) o[e] = xv[q][j][e] * r2 * g2[j][e];
                *(v4u*)(h2 + orow * DM + 8 * lane + 512 * j) = pack8f(o); } }
    }
}

__device__ __forceinline__ void phase10(const Args& a, int gw, int NGW, int lane) {
    unsigned char* ws = a.ws; const bf16* mix = (const bf16*)(ws + WS_H); const bf16* ffn = (const bf16*)(ws + WS_MG);
    float g1[2][8], g3[2][8];
#pragma unroll
    for (int j = 0; j < 2; ++j) { load8f(a.in[I_GMIXPOST] + 8 * lane + 512 * j, g1[j]); load8f(a.in[I_GFFNPOST] + 8 * lane + 512 * j, g3[j]); }
    for (int r0 = gw; r0 < R_META; r0 += 2 * NGW) {
        float mv[2][2][8], xv[2][2][8], fv[2][2][8];
#pragma unroll
        for (int q = 0; q < 2; ++q) { const int r = (r0 + q * NGW < R_META) ? r0 + q * NGW : r0;
#pragma unroll
            for (int j = 0; j < 2; ++j) { const size_t off = (size_t)r * DM + 8 * lane + 512 * j;
                unpack8f(*(const v4u*)(mix + off), mv[q][j]); unpack8f(*(const v4u*)(ffn + off), fv[q][j]); load8f(a.in[I_X] + off, xv[q][j]); } }
#pragma unroll
        for (int q = 0; q < 2; ++q) { const int r = r0 + q * NGW; if (r >= R_META) continue;
            float s = 0.f, s3 = 0.f;
#pragma unroll
            for (int j = 0; j < 2; ++j)
#pragma unroll
                for (int e = 0; e < 8; ++e) { s += mv[q][j][e] * mv[q][j][e]; s3 += fv[q][j][e] * fv[q][j][e]; }
            const float r1 = rsqrtf(wave_sum(s) * (1.0f / DM) + RMS_EPS), r3 = rsqrtf(wave_sum(s3) * (1.0f / DM) + RMS_EPS);
#pragma unroll
            for (int j = 0; j < 2; ++j) { float o[8];
#pragma unroll
                for (int e = 0; e < 8; ++e) o[e] = xv[q][j][e] + mv[q][j][e] * r1 * g1[j][e] + fv[q][j][e] * r3 * g3[j][e];
                float* op = a.out + (size_t)r * DM + 8 * lane + 512 * j;
                *(f32x4*)op = (f32x4){o[0], o[1], o[2], o[3]}; *(f32x4*)(op + 4) = (f32x4){o[4], o[5], o[6], o[7]}; } }
    }
}

#define XB_TMO      128
#define XB_XCNT(j)  (256  + 64 * (j))
#define XB_XSUB(j)  (1280 + 64 * (j))
#define XB_XGEN(j)  (2304 + 64 * (j))
#define XB_TOP      3328
#define XB_TOPGEN   3392
#define XCD_BAR_WORDS 3456
#define XB_SPIN_CAP (1u << 18)

__device__ __forceinline__ unsigned xb_ld(unsigned* p)              { return __hip_atomic_load(p, __ATOMIC_RELAXED, __HIP_MEMORY_SCOPE_AGENT); }
__device__ __forceinline__ unsigned xb_add(unsigned* p, unsigned v) { return __hip_atomic_fetch_add(p, v, __ATOMIC_RELAXED, __HIP_MEMORY_SCOPE_AGENT); }
__device__ __forceinline__ unsigned xb_xcc_id() { return (unsigned)__builtin_amdgcn_s_getreg((3 << 11) | 20) & 0xFu; }
#define XB_SPIN(cond, bar) do { unsigned _sp = 0; while (cond) { __builtin_amdgcn_s_sleep(1); \
    if ((++_sp & 255u) == 0u) { if (xb_ld(&(bar)[XB_TMO])) break; if (_sp > XB_SPIN_CAP) { atomicAdd(&(bar)[XB_TMO], 1u); break; } } } } while (0)

struct XcdBarrier {
    unsigned* bar; unsigned x;
    unsigned nloc, nx;
    unsigned rank;
};

__device__ __forceinline__ XcdBarrier xcd_barrier_post(unsigned* bar) {
    XcdBarrier b; b.bar = bar; b.x = xb_xcc_id(); b.nloc = 0u; b.nx = 0u;
    b.rank = 0u; if (threadIdx.x == 0) b.rank = xb_add(&bar[XB_XCNT(b.x)], 1u);
    return b;
}
__device__ __forceinline__ void xcd_barrier_complete(unsigned* bar, unsigned x, unsigned& nloc, unsigned& nx) {
    const unsigned G = gridDim.x * gridDim.y * gridDim.z;
    unsigned sum, cnt, mine, sp = 0u;
    for (;;) {
        sum = 0u; cnt = 0u; mine = 0u;
#pragma unroll
        for (unsigned j = 0; j < 16; ++j) { const unsigned c = xb_ld(&bar[XB_XCNT(j)]); sum += c; cnt += (c > 0u) ? 1u : 0u; mine = (j == x) ? c : mine; }
        if (sum == G) break;
        __builtin_amdgcn_s_sleep(1);
        if ((++sp & 255u) == 0u) { if (xb_ld(&bar[XB_TMO])) break; if (sp > XB_SPIN_CAP) { atomicAdd(&bar[XB_TMO], 1u); break; } }
    }
    nloc = mine > 0u ? mine : 1u; nx = cnt > 0u ? cnt : 1u;
}

__device__ __forceinline__ void xcd_barrier(XcdBarrier& b) {
    asm volatile("s_waitcnt vmcnt(0)" ::: "memory");
    __syncthreads();
    if (threadIdx.x == 0) {
        unsigned* bar = b.bar;
        __builtin_amdgcn_s_waitcnt(0);
        unsigned nloc = b.nloc, nx = b.nx;
        if (nloc == 0u) { xcd_barrier_complete(bar, b.x, nloc, nx); b.nloc = nloc; b.nx = nx; }
        const unsigned old = xb_add(&bar[XB_XSUB(b.x)], 1u);
        const unsigned gen = old / nloc;
        if (old + 1u == (gen + 1u) * nloc) {
            __builtin_amdgcn_fence(__ATOMIC_RELEASE, "agent");
            asm volatile("s_waitcnt vmcnt(0)" ::: "memory");
            const unsigned og = xb_add(&bar[XB_TOP], 1u);
            const unsigned tg = og / nx;
            if (og + 1u == (tg + 1u) * nx) xb_add(&bar[XB_TOPGEN], 1u);
            else XB_SPIN(xb_ld(&bar[XB_TOPGEN]) == tg, bar);
            __builtin_amdgcn_fence(__ATOMIC_ACQUIRE, "agent");
            xb_add(&bar[XB_XGEN(b.x)], 1u);
            asm volatile("s_waitcnt vmcnt(0)" ::: "memory");
        } else {
            XB_SPIN(xb_ld(&bar[XB_XGEN(b.x)]) == gen, bar);
            __builtin_amdgcn_fence(__ATOMIC_ACQUIRE, "agent");
            asm volatile("s_waitcnt vmcnt(0)" ::: "memory");
        }
    }
    __syncthreads();
}


#ifndef STAGGER_TICKS
#define STAGGER_TICKS 1000
#endif
__device__ __forceinline__ void stagger(int bx, unsigned ticks) {
    const unsigned frac = __brev((unsigned)bx) >> 24;
    const unsigned long long t0 = __builtin_amdgcn_s_memrealtime(), dt = (unsigned long long)ticks * frac / 256;
    while (__builtin_amdgcn_s_memrealtime() - t0 < dt) __builtin_amdgcn_s_sleep(8);
}

constexpr int N_PHASES = 11;
__global__ void __launch_bounds__(NWAVES * 64, 2) fwd_megakernel(Args args) {
    extern __shared__ __attribute__((aligned(16))) unsigned char lds_raw[];
    LAS unsigned char* lds = (LAS unsigned char*)lds_raw;
    cg::grid_group grid = cg::this_grid();
    const int tid = threadIdx.x, lane = tid & 63, wave = __builtin_amdgcn_readfirstlane(tid >> 6);
    const int G = gridDim.x, bx = blockIdx.x;
    const int vcu = (G % 8 == 0) ? (bx % 8) * (G / 8) + bx / 8 : bx;
    const int gw = vcu * NWAVES + wave, NGW = G * NWAVES;
    unsigned char* ws = args.ws;
    const int lo = args.ph_lo, hi = args.ph_hi;
    unsigned* barw = (unsigned*)ws;
    if (args.ph_hi < 0) grid.sync();
    XcdBarrier xbar = xcd_barrier_post(barw);
    int vbx = bx;
    if (G == 256) { if (tid == 0) *(volatile LAS unsigned*)lds = xbar.x + 8u * xbar.rank; __syncthreads(); const unsigned v_ = *(volatile LAS unsigned*)lds; __syncthreads(); if (v_ < 256u) vbx = (int)v_; }
#ifndef PHASE_MASK
#define PHASE_MASK 0x7ff
#endif
#define IN(k) (((PHASE_MASK >> (k)) & 1) && lo <= (k) && (k) < hi)
#define SEAM(k) do { if ((k) + 1 < hi) xcd_barrier(xbar); } while (0)
    using namespace pg8;
    if (IN(0)) { phase0(args, lds, gw, NGW, wave, lane);
        SEAM(0); }
    if (IN(1)) {
        Gemm g{(const bf16_t*)(ws + WS_H), (const bf16_t*)(ws + WS_WIN), DM}; Order S; S.init(256, 0, -1, INC / 256, G, vbx);
        p1_meta(args, gw, NGW, lane);
        EpiProj E{(bf16_t*)(ws + WS_PROJ), args.in[I_BGATES]};
        gemm_phase<EpiProj, Order>(lds, g, S, E); SEAM(1); }
    if (IN(2)) { phase2(args, lds, gw, NGW, wave, lane);
        SEAM(2); }
    if (IN(3)) {
        dft_tail(args, gw, NGW, lane);
        Gemm g{(const bf16_t*)((unsigned char*)args.out + DO_DM), (const bf16_t*)((unsigned char*)args.out + DO_UT), KD}; OrderDft S; S.init(G, vbx);
        EpiDft E{(bf16_t*)(ws + WS_F)};
        gemm_phase<EpiDft, OrderDft>(lds, g, S, E); SEAM(3); }
    if (IN(4)) {
        Gemm g{(const bf16_t*)(ws + WS_F), (const bf16_t*)(ws + WS_WEFF), DM}; Order S; S.init(256, 0, -1, DM / 256, G, vbx);
        p4_edge(args, gw, lane);
        EpiYa E{(bf16_t*)(ws + WS_MG), (const bf16_t*)(ws + WS_PROJ)};
        gemm_phase<EpiYa, Order>(lds, g, S, E); SEAM(4); }
    if (IN(5)) {
        Gemm g{(const bf16_t*)(ws + WS_ZB), (const bf16_t*)(ws + WS_WCO), 512}; Order S; S.init(256, 0, -1, DM / 256, G, vbx);
        EpiYb E{(bf16_t*)(ws + WS_MG), (const bf16_t*)(ws + WS_PROJ)};
        gemm_phase<EpiYb, Order>(lds, g, S, E); SEAM(5); }
    if (IN(6)) {
        Gemm g{(const bf16_t*)(ws + WS_MG), (const bf16_t*)(ws + WS_WOUT), DM}; Order S; S.init(256, 0, -1, DM / 256, G, vbx);
        edge_gemm((const bf16*)(ws + WS_MG), (const bf16*)(ws + WS_WOUT), DM, (bf16*)(ws + WS_H), DM, EDGE_ROW0, NMETA, gw, NGW, lane);
        EpiStore E{(bf16_t*)(ws + WS_H), DM, 0, -1, 0};
        gemm_phase<EpiStore, Order>(lds, g, S, E); SEAM(6); }
    if (IN(7)) { phase6(args, gw, NGW, lane);
        SEAM(7); }
    if (IN(8)) {
        Gemm g{(const bf16_t*)(ws + WS_H2), (const bf16_t*)(ws + WS_WUP), DM}; OrderFfn S; S.init(NB * FFN_TPB, 0, -1, 2 * DFF / 256, G, vbx);
        EpiFfn E{(bf16_t*)(ws + WS_ACT), args.in[I_CWFFN], args.in[I_CBFFN], lds + STAGE_BYTES};
        gemm_phase<EpiFfn, OrderFfn>(lds, g, S, E); SEAM(8); }
    if (IN(9)) {
        Gemm g{(const bf16_t*)(ws + WS_ACT), (const bf16_t*)(ws + WS_WDN), DFF}; Order S; S.init(256, 0, -1, DM / 256, G, vbx);
        EpiStore E{(bf16_t*)(ws + WS_MG), DM, 0, -1, 0};
        gemm_phase<EpiStore, Order>(lds, g, S, E); SEAM(9); }
    if (IN(10)) { phase10(args, gw, NGW, lane);
    }
#undef IN
#undef SEAM
}

extern "C" void kernel_launch(void* const* d_in, const int* in_sizes, int n_in, void* d_out, int out_size, void* d_ws, size_t ws_size, hipStream_t stream) {
    static int grid = 0;
    if (grid == 0) {
        if (n_in != 17 || ws_size < WS_NEED || out_size != NB * SEQ * DM) { fprintf(stderr, "kernel_launch: unexpected problem (n_in %d, ws %zu, out %d)\n", n_in, ws_size, out_size); grid = -1; return; }
        int dev = 0, cus = 0, per_cu = 0;
        if (hipGetDevice(&dev) != hipSuccess || hipDeviceGetAttribute(&cus, hipDeviceAttributeMultiprocessorCount, dev) != hipSuccess) { grid = -1; return; }
        if (hipFuncSetAttribute((const void*)fwd_megakernel, hipFuncAttributeMaxDynamicSharedMemorySize, LDS_BYTES) != hipSuccess) { fprintf(stderr, "kernel_launch: hipFuncSetAttribute failed\n"); grid = -1; return; }
        if (hipOccupancyMaxActiveBlocksPerMultiprocessor(&per_cu, (const void*)fwd_megakernel, NWAVES * 64, LDS_BYTES) != hipSuccess || per_cu < 1) { fprintf(stderr, "kernel_launch: occupancy query says %d\n", per_cu); per_cu = 1; }
        (void)hipGetLastError();
        grid = cus * 1;
    }
    if (grid < 0) return;
    if (hipMemsetAsync(d_ws, 0, 16384, stream) != hipSuccess) { fprintf(stderr, "kernel_launch: memset of the barrier words failed\n"); return; }
    Args a{};
    for (int i = 0; i < 17; ++i) a.in[i] = (const float*)d_in[i];
    a.out = (float*)d_out; a.ws = (unsigned char*)d_ws; a.ph_lo = 0; a.ph_hi = N_PHASES;
    void* kargs[] = {&a};
    hipError_t e = hipLaunchCooperativeKernel((const void*)fwd_megakernel, dim3(grid), dim3(NWAVES * 64), kargs, LDS_BYTES, stream);
    if (e != hipSuccess) fprintf(stderr, "kernel_launch: cooperative launch failed: %s (grid %d)\n", hipGetErrorString(e), grid);
}
```

```cpp
#include <hip/hip_runtime.h>
#include <hip/hip_cooperative_groups.h>
#include <cstdio>
#include <cstdint>
namespace cg = cooperative_groups;

constexpr int NB = 8, SEQ = 8192, NMETA = 16, LSEQ = 8208, DM = 1024, DFF = 2816, INC = 4096;
constexpr int R_META = 65536, R_TOT = 65792;
constexpr int KD = 4224, NHALF = LSEQ / 2;
constexpr int KH = 4352, KHT = 17;
constexpr float RMS_EPS = 1e-6f;
__device__ __forceinline__ int row_of(int b, int pos) { return pos >= NMETA ? b * SEQ + pos - NMETA : R_META + b * NMETA + pos; }

namespace pg8 {
#define PG8_LAS __attribute__((address_space(3)))
typedef unsigned short bf16_t;
typedef short bf16x8 __attribute__((ext_vector_type(8)));
typedef float f32x4 __attribute__((ext_vector_type(4)));
typedef unsigned u32x4 __attribute__((ext_vector_type(4)));
constexpr int BM = 256, BK = 64, HALF = 128, HTB = HALF * BK * 2, STAGE_BYTES = 8 * HTB, NXCD = 8, WGM = 8;

__host__ __device__ __forceinline__ int lds_byte(int r, int c) { const int st = (r >> 4) * 2 + (c >> 5), rr = r & 15, cc = c & 31, ob = rr * 64 + cc * 2; return st * 1024 + (ob ^ (((ob >> 9) & 1) << 5)); }
__host__ __device__ __forceinline__ void stage_rc(int b, int& R, int& C) { const int st = b / 1024, sb = b % 1024, swz = sb ^ (((sb >> 9) & 1) << 5); R = (st >> 1) * 16 + swz / 64; C = (st & 1) * 32 + (swz % 64) / 2; }
__host__ __device__ __forceinline__ int perm32(int rho) { const int n = rho >> 4, i = rho & 15; return 8 * (i >> 2) + 4 * n + (i & 3); }

struct Unit { int pm, pn, arow; };
struct Gemm { const bf16_t* A; const bf16_t* Bt; int K; };

struct Order {
    int nM, nN, nwg, G, c, pm0, nMain, pm_extra;
    __device__ void init(int nMain_, int pm0_, int pm_extra_, int nN_, int G_, int c_) { nMain = nMain_; pm0 = pm0_; pm_extra = pm_extra_; nM = nMain_ + (pm_extra_ >= 0 ? 1 : 0); nN = nN_; nwg = nM * nN; G = G_; c = c_; }
    __device__ bool next(int i, Unit& u) const {
        const long L = (long)i * G + c; if (L >= nwg) return false;
        int wgid = (int)L; { const int q = nwg / NXCD, r = nwg % NXCD, xcd = wgid % NXCD, off = wgid / NXCD; wgid = (xcd < r ? xcd * (q + 1) : r * (q + 1) + (xcd - r) * q) + off; }
        const int nig = WGM * nN, gid = wgid / nig, fm = gid * WGM, gsz = (nM - fm) < WGM ? (nM - fm) : WGM;
        const int t = fm + ((wgid % nig) % gsz); u.pm = (t < nMain) ? pm0 + t : pm_extra; u.pn = (wgid % nig) / gsz; u.arow = u.pm * BM; return true;
    }
    __device__ __forceinline__ void a_ready(const Unit&) const {}
    __device__ __forceinline__ void done(const Unit&) const {}
};
struct OrderDft {
    int G, c;
    __device__ void init(int G_, int c_) { G = G_; c = c_; }
    __device__ bool next(int i, Unit& u) const {
        constexpr int nM = 32, nN = 16, nwg = nM * nN;
        const long L = (long)i * G + c; if (L >= nwg) return false;
        int wgid = (int)L; { const int q = nwg / NXCD, xcd = wgid % NXCD, off = wgid / NXCD; wgid = xcd * q + off; }
        const int nig = WGM * nN, gid = wgid / nig, fm = gid * WGM;
        const int t = fm + ((wgid % nig) % WGM), pn = (wgid % nig) / WGM, part = t >> 4;
        u.pm = part * KHT + (t & 15); u.pn = part * 16 + pn; u.arow = u.pm * BM; return true;
    }
    __device__ __forceinline__ void a_ready(const Unit&) const {}
    __device__ __forceinline__ void done(const Unit&) const {}
};
constexpr int H2F_PITCH = 8448, FFN_TPB = 33, FFN_STEP = 254;
struct OrderFfn : Order {
    __device__ bool next(int i, Unit& u) const { if (!Order::next(i, u)) return false; const int b = u.pm / FFN_TPB, t = u.pm - b * FFN_TPB; u.arow = b * H2F_PITCH + FFN_STEP * t; return true; }
};
__device__ __forceinline__ unsigned cvt_pk_bf16(float lo, float hi) { unsigned r; asm volatile("v_cvt_pk_bf16_f32 %0, %1, %2" : "=v"(r) : "v"(lo), "v"(hi)); return r; }
__device__ __forceinline__ u32x4 pack8(const f32x4 v0, const f32x4 v1) { u32x4 w; w.x = cvt_pk_bf16(v0[0], v0[1]); w.y = cvt_pk_bf16(v0[2], v0[3]); w.z = cvt_pk_bf16(v1[0], v1[1]); w.w = cvt_pk_bf16(v1[2], v1[3]); return w; }
__device__ __forceinline__ float bflo(unsigned w) { return __uint_as_float(w << 16); }
__device__ __forceinline__ float bfhi(unsigned w) { return __uint_as_float(w & 0xffff0000u); }
__device__ __forceinline__ void unpack8(const u32x4 w, f32x4& v0, f32x4& v1) { v0 = (f32x4){bflo(w.x), bfhi(w.x), bflo(w.y), bfhi(w.y)}; v1 = (f32x4){bflo(w.z), bfhi(w.z), bflo(w.w), bfhi(w.w)}; }
__device__ __forceinline__ float sigmoidf_(float x) { return __builtin_amdgcn_rcpf(1.0f + __expf(-x)); }
#define EPI_LOOP_AM _Pragma("unroll") for (int ai = 0; ai < 2; ++ai) _Pragma("unroll") for (int m = 0; m < 4; ++m)
#define EPI_LOOP_BJ _Pragma("unroll") for (int bj = 0; bj < 2; ++bj)
typedef const f32x4 (&AccT)[2][2][4][2];

struct EpiProj { static constexpr bool PERM = true, AFTER_DRAIN = false, RPT = true;
    bf16_t* P; const float* bg;
    __device__ __forceinline__ void operator()(AccT acc, const Unit& u, int wr, int wc, int fr, int fq) const {
        const int row0 = u.pm * BM + wr * 64 + fr, colt = u.pn * BM + wc * 32 + 8 * fq;
        const bool gate = u.pn >= 8;
        f32x4 bv[2][2];
        EPI_LOOP_BJ { _Pragma("unroll") for (int n = 0; n < 2; ++n) bv[bj][n] = gate ? *(const f32x4*)(bg + (colt - 2048) + bj * HALF + 4 * n) : (f32x4){0.f, 0.f, 0.f, 0.f}; }
        EPI_LOOP_AM { bf16_t* rowp = P + (size_t)(row0 + ai * HALF + m * 16) * INC + colt;
            EPI_LOOP_BJ { f32x4 v0 = acc[ai][bj][m][0] + bv[bj][0], v1 = acc[ai][bj][m][1] + bv[bj][1];
                if (gate) { _Pragma("unroll") for (int j = 0; j < 4; ++j) { v0[j] = sigmoidf_(v0[j]); v1[j] = sigmoidf_(v1[j]); } }
                *(u32x4*)(rowp + bj * HALF) = pack8(v0, v1); } }
    }
};
struct EpiDft { static constexpr bool PERM = true, AFTER_DRAIN = false, RPT = true;
    bf16_t* F;
    __device__ __forceinline__ void operator()(AccT acc, const Unit& u, int wr, int wc, int fr, int fq) const {
        const int part = u.pm / KHT, kt = u.pm - part * KHT;
        const int colg = (u.pn & 15) * BM + wc * 32 + 8 * fq;
        const unsigned sgn = part ? 0x80008000u : 0u;
        EPI_LOOP_AM { const int k = kt * BM + ai * HALF + wr * 64 + m * 16 + fr;
            {
                EPI_LOOP_BJ { const int cg_ = colg + bj * HALF, b = cg_ >> 9, ch = cg_ & 511;
                    u32x4 w = pack8(acc[ai][bj][m][0], acc[ai][bj][m][1]);
                    *(u32x4*)(F + (size_t)row_of(b, k) * DM + part * 512 + ch) = w;
                    if (k >= 1) { w.x ^= sgn; w.y ^= sgn; w.z ^= sgn; w.w ^= sgn;
                        *(u32x4*)(F + (size_t)row_of(b, LSEQ - k) * DM + part * 512 + ch) = w; } } } }
    }
};
struct EpiYa { static constexpr bool PERM = true, AFTER_DRAIN = false, RPT = true;
    bf16_t* Mg; const bf16_t* P;
    __device__ __forceinline__ void operator()(AccT acc, const Unit& u, int wr, int wc, int fr, int fq) const {
        const int row0 = u.pm * BM + wr * 64 + fr, colt = u.pn * BM + wc * 32 + 8 * fq;
        EPI_LOOP_AM { const size_t row = (size_t)(row0 + ai * HALF + m * 16);
            EPI_LOOP_BJ { const u32x4 gw = *(const u32x4*)(P + row * INC + 2048 + colt + bj * HALF); f32x4 g0, g1; unpack8(gw, g0, g1);
                *(u32x4*)(Mg + row * DM + colt + bj * HALF) = pack8(acc[ai][bj][m][0] * g0, acc[ai][bj][m][1] * g1); }
            asm volatile("" ::: "memory"); }
    }
};
struct EpiYb { static constexpr bool PERM = true, AFTER_DRAIN = false, RPT = false;
    bf16_t* Mg; const bf16_t* P;
    __device__ __forceinline__ void operator()(AccT acc, const Unit& u, int wr, int wc, int fr, int fq) const {
        const int row0 = u.pm * BM + wr * 64 + fr, colt = u.pn * BM + wc * 32 + 8 * fq;
        EPI_LOOP_AM { const size_t row = (size_t)(row0 + ai * HALF + m * 16);
            EPI_LOOP_BJ { const u32x4 gw = *(const u32x4*)(P + row * INC + 3072 + colt + bj * HALF); f32x4 g0, g1; unpack8(gw, g0, g1);
                const u32x4 tw = *(const u32x4*)(Mg + row * DM + colt + bj * HALF); f32x4 t0, t1; unpack8(tw, t0, t1);
                *(u32x4*)(Mg + row * DM + colt + bj * HALF) = pack8(t0 + acc[ai][bj][m][0] * g0, t1 + acc[ai][bj][m][1] * g1); }
            asm volatile("" ::: "memory"); }
    }
};
struct EpiStore { static constexpr bool PERM = true, AFTER_DRAIN = false, RPT = true;
    bf16_t* O; int ldc, pm0, pm_extra, extra_local;
    __device__ __forceinline__ void operator()(AccT acc, const Unit& u, int wr, int wc, int fr, int fq) const {
        const int lt = (u.pm == pm_extra) ? extra_local : u.pm - pm0;
        const int row0 = lt * BM + wr * 64 + fr, colt = u.pn * BM + wc * 32 + 8 * fq;
        EPI_LOOP_AM { bf16_t* rowp = O + (size_t)(row0 + ai * HALF + m * 16) * ldc + colt;
            EPI_LOOP_BJ { *(u32x4*)(rowp + bj * HALF) = pack8(acc[ai][bj][m][0], acc[ai][bj][m][1]); } }
    }
};
struct EpiF32 { static constexpr bool PERM = false, AFTER_DRAIN = false, RPT = true;
    float* C; int ldc, tile_off;
    __device__ __forceinline__ void operator()(AccT acc, const Unit& u, int wr, int wc, int fr, int fq) const {
        const int row0 = (u.pm + tile_off) * BM + wr * 64 + fr, col0 = u.pn * BM + wc * 32 + 4 * fq;
        EPI_LOOP_AM { float* rowp = C + (size_t)(row0 + ai * HALF + m * 16) * ldc + col0;
            EPI_LOOP_BJ { _Pragma("unroll") for (int n = 0; n < 2; ++n) *(f32x4*)(rowp + bj * HALF + n * 16) = acc[ai][bj][m][n]; } }
    }
};

struct EpiFfn { static constexpr bool PERM = true, AFTER_DRAIN = false, RPT = true;
    bf16_t* act; const float* cw; const float* cb; PG8_LAS unsigned char* slab;
    typedef unsigned u32x2 __attribute__((ext_vector_type(2)));
    __device__ __forceinline__ static f32x4 up4(const u32x2 w) { return (f32x4){bflo(w.x), bfhi(w.x), bflo(w.y), bfhi(w.y)}; }
    __device__ __forceinline__ void operator()(AccT acc, const Unit& u, int wr, int wc, int fr, int fq) const {
        const int tid = threadIdx.x, cg8 = tid & 7, rrow = tid >> 3, chunk = cg8 >> 1, hoff = (cg8 & 1) * 8;
        const int b = u.pm / FFN_TPB, t = u.pm - b * FFN_TPB;
#pragma unroll 1
        for (int s = 0; s < 4; ++s) {
            if (wc == s) {
                EPI_LOOP_AM { const int row = ai * HALF + wr * 64 + m * 16 + fr; PG8_LAS unsigned char* rp = slab + row * 128;
                    *(PG8_LAS u32x4*)(rp + ((fq ^ (row & 7)) << 4)) = pack8(acc[ai][0][m][0], acc[ai][0][m][1]);
                    *(PG8_LAS u32x4*)(rp + (((4 + fq) ^ (row & 7)) << 4)) = pack8(acc[ai][1][m][0], acc[ai][1][m][1]); } }
            asm volatile("s_waitcnt lgkmcnt(0)" ::: "memory"); __builtin_amdgcn_s_barrier(); asm volatile("" ::: "memory");
            const int j0 = u.pn * HALF + s * 32 + cg8 * 4;
            const f32x4 ka0 = *(const f32x4*)(cw + j0), ka1 = *(const f32x4*)(cw + 2 * DFF + j0), ka2 = *(const f32x4*)(cw + 4 * DFF + j0), kab = *(const f32x4*)(cb + j0);
            const f32x4 kv0 = *(const f32x4*)(cw + DFF + j0), kv1 = *(const f32x4*)(cw + 3 * DFF + j0), kv2 = *(const f32x4*)(cw + 5 * DFF + j0), kvb = *(const f32x4*)(cb + DFF + j0);
#pragma unroll 1
            for (int i2 = 0; i2 < 4; ++i2) { const int row = rrow + 64 * i2, iloc = FFN_STEP * t + row;
                if (row >= 1 && row <= 254 && iloc <= SEQ) {
                    const PG8_LAS unsigned char* p0 = slab + (row - 1) * 128 + hoff; const PG8_LAS unsigned char* p1 = p0 + 128; const PG8_LAS unsigned char* p2 = p1 + 128;
                    const int s0 = (row - 1) & 7, s1 = row & 7, s2 = (row + 1) & 7;
                    const f32x4 a0 = up4(*(const PG8_LAS u32x2*)(p0 + ((chunk ^ s0) << 4))), a1 = up4(*(const PG8_LAS u32x2*)(p1 + ((chunk ^ s1) << 4))), a2 = up4(*(const PG8_LAS u32x2*)(p2 + ((chunk ^ s2) << 4)));
                    const f32x4 v0 = up4(*(const PG8_LAS u32x2*)(p0 + (((4 + chunk) ^ s0) << 4))), v1 = up4(*(const PG8_LAS u32x2*)(p1 + (((4 + chunk) ^ s1) << 4))), v2 = up4(*(const PG8_LAS u32x2*)(p2 + (((4 + chunk) ^ s2) << 4)));
                    const f32x4 ca = kab + ka0 * a0 + ka1 * a1 + ka2 * a2, cv = kvb + kv0 * v0 + kv1 * v1 + kv2 * v2;
                    f32x4 o;
#pragma unroll
                    for (int e = 0; e < 4; ++e) { const float x = ca[e]; const float z2 = 1.5957691216057308f * (x + 0.044715f * x * x * x); o[e] = x * __builtin_amdgcn_rcpf(1.0f + __expf(-z2)) * cv[e]; }
                    u32x2 w; w.x = cvt_pk_bf16(o[0], o[1]); w.y = cvt_pk_bf16(o[2], o[3]);
                    *(u32x2*)(act + (size_t)(b * SEQ + iloc - 1) * DFF + j0) = w;
                } }
            asm volatile("s_waitcnt lgkmcnt(0)" ::: "memory"); __builtin_amdgcn_s_barrier(); asm volatile("" ::: "memory");
        }
    }
};

template <class Epi, class Sched, bool ALIGN_EPI = true, bool SP2 = true>
__device__ __forceinline__ void gemm_phase(PG8_LAS unsigned char* lds, const Gemm g, const Sched& S, const Epi& E) {
    const int tid = threadIdx.x, wid = __builtin_amdgcn_readfirstlane(tid >> 6), lane = tid & 63, wr = wid >> 2, wc = wid & 3, fr = lane & 15, fq = lane >> 4;
    const int K = g.K, nt = K / BK;
    unsigned voffA[2], voffB[2];
#pragma unroll
    for (int i = 0; i < 2; ++i) { int R, C; stage_rc(tid * 16 + i * 8192, R, C); const int Rb = Epi::PERM ? ((R & ~31) + perm32(R & 31)) : R;
        voffA[i] = (unsigned)(R * K + C) * 2u; voffB[i] = (unsigned)(Rb * K + C) * 2u; }
    const size_t kstep = (size_t)(BK * 2);
    const size_t hstep = (size_t)HALF * K * 2;
    const size_t tstep = 2 * hstep;
    const unsigned ldsw = (unsigned)wid * 1024u;
    const int aoff = lds_byte(wr * 64 + fr, fq * 8), boff = lds_byte(wc * 32 + fr, fq * 8);
#define PG8_SA(b, h) (((b) * 2 + (h)) * HTB)
#define PG8_SB(b, h) ((4 + (b) * 2 + (h)) * HTB)
#define PG8_STAGE(bufoff, gbase, voff) do { _Pragma("unroll") for (int _i = 0; _i < 2; ++_i) \
        __builtin_amdgcn_global_load_lds((const unsigned*)((const char*)(gbase) + (voff)[_i]), (PG8_LAS unsigned*)(lds + (bufoff) + ldsw + _i * 8192), 16, 0, 0); } while (0)
#define PG8_LDA(dst, b, h) do { _Pragma("unroll") for (int m = 0; m < 4; ++m) _Pragma("unroll") for (int k = 0; k < 2; ++k) dst[m][k] = *(const PG8_LAS bf16x8*)(lds + PG8_SA(b, h) + aoff + m * 2048 + k * 1024); } while (0)
#define PG8_LDB(dst, b, h) do { _Pragma("unroll") for (int n = 0; n < 2; ++n) _Pragma("unroll") for (int k = 0; k < 2; ++k) dst[n][k] = *(const PG8_LAS bf16x8*)(lds + PG8_SB(b, h) + boff + n * 2048 + k * 1024); } while (0)
#define PG8_MMA(ai, bj, At, Bt) do { __builtin_amdgcn_s_setprio(1); _Pragma("unroll") for (int m = 0; m < 4; ++m) _Pragma("unroll") for (int n = 0; n < 2; ++n) _Pragma("unroll") for (int k = 0; k < 2; ++k) \
        acc[ai][bj][m][n] = __builtin_amdgcn_mfma_f32_16x16x32_bf16(Bt[n][k], At[m][k], acc[ai][bj][m][n], 0, 0, 0); __builtin_amdgcn_s_setprio(0); } while (0)
#define PG8_WAIT_V(n) asm volatile("s_waitcnt vmcnt(" #n ")" ::: "memory")
#define PG8_WAIT_L(n) asm volatile("s_waitcnt lgkmcnt(" #n ")" ::: "memory")
#define PG8_BAR __builtin_amdgcn_s_barrier()
#define PG8_SCHED __builtin_amdgcn_sched_barrier(0)
    Unit cur, nxt; int ui = 0;
    if (!S.next(0, cur)) return;
    f32x4 acc[2][2][4][2];
#pragma unroll
    for (int a = 0; a < 2; ++a)
#pragma unroll
        for (int b = 0; b < 2; ++b)
#pragma unroll
            for (int m = 0; m < 4; ++m)
#pragma unroll
                for (int n = 0; n < 2; ++n) acc[a][b][m][n] = (f32x4){0.f, 0.f, 0.f, 0.f};
    bf16x8 At[4][2], B0[2][2], B1[2][2];
    const size_t rowb = (size_t)K * 2; const char* cA = (const char*)g.A + (size_t)cur.arow * rowb; const char* cB = (const char*)g.Bt + (size_t)cur.pn * tstep;
    S.a_ready(cur);
    if constexpr (SP2) {
        PG8_STAGE(PG8_SB(0, 0), cB, voffB); PG8_STAGE(PG8_SB(0, 1), cB + hstep, voffB); PG8_STAGE(PG8_SA(0, 0), cA, voffA); PG8_STAGE(PG8_SA(0, 1), cA + hstep, voffA);
        if (wr == 1) PG8_BAR;
        PG8_WAIT_V(2); PG8_BAR;
        PG8_STAGE(PG8_SB(1, 0), cB + kstep, voffB); PG8_STAGE(PG8_SA(1, 0), cA + kstep, voffA); PG8_STAGE(PG8_SB(1, 1), cB + hstep + kstep, voffB);
        PG8_WAIT_V(6); PG8_BAR;
    } else {
        PG8_STAGE(PG8_SB(0, 0), cB, voffB); PG8_STAGE(PG8_SA(0, 0), cA, voffA); PG8_STAGE(PG8_SB(0, 1), cB + hstep, voffB); PG8_STAGE(PG8_SA(0, 1), cA + hstep, voffA);
        if (wr == 1) PG8_BAR;
        PG8_WAIT_V(4); PG8_BAR;
        PG8_STAGE(PG8_SB(1, 0), cB + kstep, voffB); PG8_STAGE(PG8_SA(1, 0), cA + kstep, voffA); PG8_STAGE(PG8_SB(1, 1), cB + hstep + kstep, voffB);
        PG8_WAIT_V(6); PG8_BAR;
    }
    for (;;) {
        const bool has_next = S.next(ui + 1, nxt);
        const char* nA = has_next ? (const char*)g.A + (size_t)nxt.arow * rowb : cA; const char* nB = has_next ? (const char*)g.Bt + (size_t)nxt.pn * tstep : cB;
        for (int t = 0; t < nt; t += 2) {
            const bool last = (t == nt - 2);
            const char* a1 = cA + (size_t)(t + 1) * kstep;
            const char* a2 = last ? nA : cA + (size_t)(t + 2) * kstep; const char* b2 = last ? nB : cB + (size_t)(t + 2) * kstep;
            const char* a3 = a2 + kstep; const char* b3 = b2 + kstep;
            if (last && has_next) S.a_ready(nxt);
            if constexpr (SP2) {
            PG8_LDB(B0, 0, 0); PG8_LDB(B1, 0, 1); PG8_SCHED; PG8_LDA(At, 0, 0); PG8_STAGE(PG8_SA(1, 1), a1 + hstep, voffA);
            PG8_WAIT_V(8); PG8_WAIT_L(0); PG8_BAR; PG8_MMA(0, 0, At, B0); PG8_MMA(0, 1, At, B1); PG8_BAR; PG8_SCHED;
            PG8_LDA(At, 0, 1); PG8_STAGE(PG8_SB(0, 0), b2, voffB); PG8_STAGE(PG8_SB(0, 1), b2 + hstep, voffB); PG8_STAGE(PG8_SA(0, 0), a2, voffA);
            PG8_WAIT_V(8); PG8_WAIT_L(0); PG8_BAR; PG8_MMA(1, 0, At, B0); PG8_MMA(1, 1, At, B1); PG8_BAR; PG8_SCHED;
            PG8_LDB(B0, 1, 0); PG8_LDB(B1, 1, 1); PG8_SCHED; PG8_LDA(At, 1, 0); PG8_STAGE(PG8_SA(0, 1), a2 + hstep, voffA);
            PG8_WAIT_V(8); PG8_WAIT_L(0); PG8_BAR; PG8_MMA(0, 0, At, B0); PG8_MMA(0, 1, At, B1); PG8_BAR; PG8_SCHED;
            PG8_LDA(At, 1, 1); PG8_STAGE(PG8_SB(1, 0), b3, voffB); PG8_STAGE(PG8_SB(1, 1), b3 + hstep, voffB); PG8_STAGE(PG8_SA(1, 0), a3, voffA);
            PG8_WAIT_V(8); PG8_WAIT_L(0); PG8_BAR; PG8_MMA(1, 0, At, B0); PG8_MMA(1, 1, At, B1); PG8_BAR; PG8_SCHED;
            } else {
            PG8_LDB(B0, 0, 0); PG8_SCHED; PG8_LDA(At, 0, 0); PG8_STAGE(PG8_SA(1, 1), a1 + hstep, voffA);
            PG8_WAIT_L(8); PG8_BAR; PG8_WAIT_L(0); PG8_MMA(0, 0, At, B0); PG8_BAR; PG8_SCHED;
            PG8_LDB(B1, 0, 1); PG8_STAGE(PG8_SB(0, 0), b2, voffB);
            PG8_BAR; PG8_WAIT_L(0); PG8_MMA(0, 1, At, B1); PG8_BAR;
            PG8_LDA(At, 0, 1); PG8_STAGE(PG8_SA(0, 0), a2, voffA);
            PG8_BAR; PG8_WAIT_L(0); PG8_MMA(1, 0, At, B0); PG8_BAR; PG8_SCHED;
            PG8_STAGE(PG8_SB(0, 1), b2 + hstep, voffB);
            PG8_WAIT_V(6); PG8_BAR; PG8_MMA(1, 1, At, B1); PG8_BAR;
            PG8_LDB(B0, 1, 0); PG8_SCHED; PG8_LDA(At, 1, 0); PG8_STAGE(PG8_SA(0, 1), a2 + hstep, voffA);
            PG8_WAIT_L(8); PG8_BAR; PG8_WAIT_L(0); PG8_MMA(0, 0, At, B0); PG8_BAR; PG8_SCHED;
            PG8_LDB(B1, 1, 1); PG8_STAGE(PG8_SB(1, 0), b3, voffB);
            PG8_BAR; PG8_WAIT_L(0); PG8_MMA(0, 1, At, B1); PG8_BAR;
            PG8_LDA(At, 1, 1); PG8_STAGE(PG8_SA(1, 0), a3, voffA);
            PG8_BAR; PG8_WAIT_L(0); PG8_MMA(1, 0, At, B0); PG8_BAR; PG8_SCHED;
            PG8_STAGE(PG8_SB(1, 1), b3 + hstep, voffB);
            PG8_WAIT_V(6); PG8_BAR; PG8_MMA(1, 1, At, B1); PG8_BAR;
            }
        }
        if constexpr (ALIGN_EPI) { if (wr == 0) PG8_BAR; }
        if constexpr (!Epi::AFTER_DRAIN) { E(acc, cur, wr, wc, fr, fq);
            S.done(cur); }
        if (!has_next) break;
#pragma unroll
        for (int a = 0; a < 2; ++a)
#pragma unroll
            for (int b = 0; b < 2; ++b)
#pragma unroll
                for (int m = 0; m < 4; ++m)
#pragma unroll
                    for (int n = 0; n < 2; ++n) acc[a][b][m][n] = (f32x4){0.f, 0.f, 0.f, 0.f};
        cur = nxt; cA = nA; cB = nB; ++ui;
        if constexpr (ALIGN_EPI) { if (wr == 1) PG8_BAR; }
    }
    PG8_WAIT_V(0);
    if constexpr (!ALIGN_EPI) { if (wr == 0) PG8_BAR; }
    PG8_BAR;
    if constexpr (Epi::AFTER_DRAIN) { E.fused(acc, cur, wr, wc, fr, fq, lds, wid, lane); S.done(cur); }
#undef PG8_SA
#undef PG8_SB
#undef PG8_STAGE
#undef PG8_LDA
#undef PG8_LDB
#undef PG8_MMA
#undef PG8_WAIT_V
#undef PG8_WAIT_L
#undef PG8_BAR
#undef PG8_SCHED
}
}

constexpr int NWAVES = 8;
constexpr int LDS_BYTES = 163840;
constexpr size_t MiB = 1u << 20;
constexpr size_t WS_WIN = 1 * MiB, WS_WEFF = 9 * MiB, WS_WCO = 11 * MiB, WS_WOUT = 12 * MiB, WS_WUP = 14 * MiB, WS_WDN = 25 * MiB;
constexpr size_t WS_H = 32 * MiB;
constexpr size_t WS_PROJ = 161 * MiB;
constexpr size_t WS_H2 = 161 * MiB;
constexpr size_t WS_ACT = 300 * MiB;
constexpr size_t WS_ZB = 675 * MiB;
constexpr size_t WS_F = 740 * MiB;
constexpr size_t WS_MG = 869 * MiB;
constexpr size_t WS_NEED = 1000 * MiB;
constexpr size_t DO_DM = 0, DO_UT = 72 * MiB;
static_assert((size_t)2 * KH * KD * 2 <= DO_UT && DO_UT + (size_t)2 * 4096 * KD * 2 <= 256 * MiB, "d_out scratch map");
static_assert(WS_H + (size_t)R_TOT * DM * 2 <= WS_PROJ && WS_PROJ + (size_t)R_TOT * INC * 2 <= WS_ZB && WS_ZB + (size_t)R_TOT * 512 * 2 <= WS_F && WS_F + (size_t)R_TOT * DM * 2 <= WS_MG && WS_MG + (size_t)R_TOT * DM * 2 <= WS_NEED, "ws map 1");
static_assert(WS_H2 + (size_t)NB * pg8::H2F_PITCH * DM * 2 <= WS_ACT && WS_ACT + (size_t)65536 * DFF * 2 <= WS_MG, "ws map 2");

#define LAS __attribute__((address_space(3)))
typedef unsigned short bf16;
typedef unsigned v4u __attribute__((ext_vector_type(4)));
typedef unsigned v2u __attribute__((ext_vector_type(2)));
typedef float f32x4 __attribute__((ext_vector_type(4)));
#define LDS_WAIT() asm volatile("s_waitcnt lgkmcnt(0)" ::: "memory")
using pg8::cvt_pk_bf16; using pg8::bflo; using pg8::bfhi;

__device__ __forceinline__ float wave_sum(float v) {
#pragma unroll
    for (int o = 1; o < 64; o <<= 1) v += __shfl_xor(v, o);
    return v;
}
__device__ __forceinline__ void unpack8f(const v4u w, float (&f)[8]) { f[0] = bflo(w.x); f[1] = bfhi(w.x); f[2] = bflo(w.y); f[3] = bfhi(w.y); f[4] = bflo(w.z); f[5] = bfhi(w.z); f[6] = bflo(w.w); f[7] = bfhi(w.w); }
__device__ __forceinline__ v4u pack8f(const float (&f)[8]) { v4u w; w.x = cvt_pk_bf16(f[0], f[1]); w.y = cvt_pk_bf16(f[2], f[3]); w.z = cvt_pk_bf16(f[4], f[5]); w.w = cvt_pk_bf16(f[6], f[7]); return w; }
__device__ __forceinline__ void load8f_nt(const float* p, float (&f)[8]) { const f32x4 a = __builtin_nontemporal_load((const f32x4*)p), b = __builtin_nontemporal_load((const f32x4*)(p + 4)); f[0] = a.x; f[1] = a.y; f[2] = a.z; f[3] = a.w; f[4] = b.x; f[5] = b.y; f[6] = b.z; f[7] = b.w; }
__device__ __forceinline__ void load8f(const float* p, float (&f)[8]) { const f32x4 a = *(const f32x4*)p, b = *(const f32x4*)(p + 4); f[0] = a.x; f[1] = a.y; f[2] = a.z; f[3] = a.w; f[4] = b.x; f[5] = b.y; f[6] = b.z; f[7] = b.w; }

struct Args { const float* in[17]; float* out; unsigned char* ws; int ph_lo, ph_hi; };
enum { I_X = 0, I_META, I_GMIXPRE, I_WIN, I_BGATES, I_WFOURIER, I_CWMIX, I_CBMIX, I_WCONVOUT, I_WOUT, I_GMIXPOST, I_GFFNPRE, I_WUP, I_CWFFN, I_CBFFN, I_WDOWN, I_GFFNPOST };

__device__ __forceinline__ void p0_transpose_item(const float* __restrict__ W, int K, int N, bf16* __restrict__ WT, int k0, int n0, int drow0, LAS float* scr, int lane) {
    f32x4 tv[8];
#pragma unroll
    for (int i = 0; i < 8; ++i) tv[i] = *(const f32x4*)(W + (size_t)(k0 + i * 8 + (lane >> 3)) * N + n0 + 4 * (lane & 7));
#pragma unroll
    for (int i = 0; i < 8; ++i) { LAS float* d = scr + (i * 8 + (lane >> 3)) * 33 + 4 * (lane & 7); d[0] = tv[i].x; d[1] = tv[i].y; d[2] = tv[i].z; d[3] = tv[i].w; }
    LDS_WAIT();
    const int c = lane & 7;
#pragma unroll
    for (int j = 0; j < 4; ++j) { const int n = (lane >> 3) + 8 * j; const LAS float* s = scr + (8 * c) * 33 + n;
        v4u o; o.x = cvt_pk_bf16(s[0 * 33], s[1 * 33]); o.y = cvt_pk_bf16(s[2 * 33], s[3 * 33]); o.z = cvt_pk_bf16(s[4 * 33], s[5 * 33]); o.w = cvt_pk_bf16(s[6 * 33], s[7 * 33]);
        *(v4u*)(WT + (size_t)(drow0 + n) * K + k0 + 8 * c) = o; }
    LDS_WAIT();
}
__device__ __forceinline__ int wup_drow(int n0) { return n0 < DFF ? 256 * (n0 >> 7) + (n0 & 127) : 256 * ((n0 - DFF) >> 7) + 128 + ((n0 - DFF) & 127); }

__device__ __forceinline__ void phase0(const Args& a, LAS unsigned char* lds, int gw, int NGW, int wave, int lane) {
    unsigned char* ws = a.ws;
    LAS float* scr = (LAS float*)(lds + wave * 16384);
    constexpr int T_IN = 16 * 128, T_CO = 8 * 32, T_OUT = 16 * 32, T_UP = 16 * 176, T_DN = 44 * 32, T_ALL = T_IN + T_CO + T_OUT + T_UP + T_DN;
    for (int it = gw; it < T_ALL; it += NGW) {
        int r = it;
        if (r < T_IN) { const int kb = r / 128, nb = r % 128; p0_transpose_item(a.in[I_WIN], DM, INC, (bf16*)(ws + WS_WIN), kb * 64, nb * 32, nb * 32, scr, lane); continue; } r -= T_IN;
        if (r < T_CO) { const int kb = r / 32, nb = r % 32; p0_transpose_item(a.in[I_WCONVOUT], 512, DM, (bf16*)(ws + WS_WCO), kb * 64, nb * 32, nb * 32, scr, lane); continue; } r -= T_CO;
        if (r < T_OUT) { const int kb = r / 32, nb = r % 32; p0_transpose_item(a.in[I_WOUT], DM, DM, (bf16*)(ws + WS_WOUT), kb * 64, nb * 32, nb * 32, scr, lane); continue; } r -= T_OUT;
        if (r < T_UP) { const int kb = r / 176, nb = r % 176; p0_transpose_item(a.in[I_WUP], DM, 2 * DFF, (bf16*)(ws + WS_WUP), kb * 64, nb * 32, wup_drow(nb * 32), scr, lane); continue; } r -= T_UP;
        { const int kb = r / 32, nb = r % 32; p0_transpose_item(a.in[I_WDOWN], DFF, DM, (bf16*)(ws + WS_WDN), kb * 64, nb * 32, nb * 32, scr, lane); }
    }
    { const float* wf = a.in[I_WFOURIER]; bf16* we = (bf16*)(ws + WS_WEFF);
      for (int it = gw; it < 8192; it += NGW) { const int jb = it & 15, c = (it >> 4) & 127, g = it >> 11, j = jb * 64 + lane;
          float ac = 0.f, as = 0.f;
#pragma unroll 32
          for (int cp = 0; cp < 128; ++cp) { const float w = wf[(size_t)(g * 128 + cp) * DM + j]; const float ph = (float)((c * cp) & 127) * (1.0f / 128.0f);
              ac += __builtin_amdgcn_cosf(ph) * w; as += __builtin_amdgcn_sinf(ph) * w; }
          const float s = 0.08838834764831845f;
          we[(size_t)j * DM + g * 128 + c] = (bf16)(cvt_pk_bf16(ac * s, 0.f) & 0xffffu); we[(size_t)j * DM + 512 + g * 128 + c] = (bf16)(cvt_pk_bf16(as * s, 0.f) & 0xffffu); } }
    { bf16* dmat = (bf16*)((unsigned char*)a.out + DO_DM); constexpr int CPR = KD / 8;
      for (int it = gw; it < 2 * KH * CPR / 64; it += NGW) { const int chunk = it * 64 + lane, row = chunk / CPR, ci = chunk - row * CPR, n0 = ci * 8, part = row >= KH, k = row - part * KH;
          int mm = (int)(((unsigned)k * (unsigned)n0) % (unsigned)LSEQ); float f[8];
#pragma unroll
          for (int i = 0; i < 8; ++i) { const float ph = (float)mm * (1.0f / (float)LSEQ); const float v = part ? -__builtin_amdgcn_sinf(ph) : __builtin_amdgcn_cosf(ph);
              f[i] = (n0 + i <= NHALF) ? v * 0.011037770f : 0.f; mm += k; if (mm >= LSEQ) mm -= LSEQ; }
          *(v4u*)(dmat + (size_t)row * KD + n0) = pack8f(f); } }
    { const float* g = a.in[I_GMIXPRE]; bf16* h = (bf16*)(ws + WS_H);
      f32x4 gv[4];
#pragma unroll
      for (int j = 0; j < 4; ++j) gv[j] = ((const f32x4*)g)[lane + 64 * j];
      for (int r0 = gw; r0 < R_TOT; r0 += 2 * NGW) {
          f32x4 v[2][4]; float s2[2];
#pragma unroll
          for (int q = 0; q < 2; ++q) { const int r = r0 + q * NGW; s2[q] = 0.f;
              if (r < R_META + NB * NMETA) { const float* src = r < R_META ? a.in[I_X] + (size_t)r * DM : a.in[I_META] + (size_t)((r - R_META) & 15) * DM;
#pragma unroll
                  for (int j = 0; j < 4; ++j) v[q][j] = ((const f32x4*)src)[lane + 64 * j]; }
              else {
#pragma unroll
                  for (int j = 0; j < 4; ++j) v[q][j] = (f32x4){0.f, 0.f, 0.f, 0.f}; } }
#pragma unroll
          for (int q = 0; q < 2; ++q) {
#pragma unroll
              for (int j = 0; j < 4; ++j) s2[q] += (v[q][j].x * v[q][j].x + v[q][j].y * v[q][j].y) + (v[q][j].z * v[q][j].z + v[q][j].w * v[q][j].w); }
#pragma unroll
          for (int q = 0; q < 2; ++q) { const int r = r0 + q * NGW; if (r >= R_TOT) continue;
              const float rstd = rsqrtf(wave_sum(s2[q]) * (1.0f / DM) + RMS_EPS);
              unsigned long long* o8 = (unsigned long long*)(h + (size_t)r * DM) + lane;
#pragma unroll
              for (int j = 0; j < 4; ++j) { const f32x4 o = v[q][j] * rstd * gv[j]; o8[64 * j] = (unsigned long long)cvt_pk_bf16(o.x, o.y) | ((unsigned long long)cvt_pk_bf16(o.z, o.w) << 32); } }
      } }
}

__device__ __forceinline__ void phase2(const Args& a, LAS unsigned char* lds, int gw, int NGW, int wave, int lane) {
    unsigned char* ws = a.ws; const bf16* proj = (const bf16*)(ws + WS_PROJ);
    { bf16* eT = (bf16*)((unsigned char*)a.out + DO_UT); bf16* oT = eT + (size_t)4096 * KD;
      LAS bf16* scrE = (LAS bf16*)(lds + wave * 16896); LAS bf16* scrO = scrE + 64 * 66;
      constexpr int NBLK = KD / 64;
      for (int it = gw; it < NB * 8 * NBLK; it += NGW) { const int nblk = it % NBLK, cb = (it / NBLK) & 7, b = it / (8 * NBLK);
#pragma unroll
          for (int i = 0; i < 8; ++i) { const int nl = i * 8 + (lane >> 3), nh = nblk * 64 + nl, chunk = lane & 7;
              float e[8], o[8];
#pragma unroll
              for (int j = 0; j < 8; ++j) { e[j] = 0.f; o[j] = 0.f; }
              if (nh <= NHALF) { unpack8f(*(const v4u*)(proj + (size_t)row_of(b, nh) * INC + cb * 64 + chunk * 8), e);
                  if (nh >= 1 && nh < NHALF) { float u2[8]; unpack8f(*(const v4u*)(proj + (size_t)row_of(b, LSEQ - nh) * INC + cb * 64 + chunk * 8), u2);
#pragma unroll
                      for (int j = 0; j < 8; ++j) { o[j] = e[j] - u2[j]; e[j] = e[j] + u2[j]; } } }
              LAS bf16* dE = scrE + (chunk * 8) * 66 + nl; LAS bf16* dO = scrO + (chunk * 8) * 66 + nl;
#pragma unroll
              for (int j = 0; j < 8; ++j) { const unsigned w = cvt_pk_bf16(e[j], o[j]); dE[j * 66] = (bf16)(w & 0xffffu); dO[j * 66] = (bf16)(w >> 16); } }
          LDS_WAIT();
#pragma unroll
          for (int i = 0; i < 8; ++i) { const int ch = i * 8 + (lane >> 3), nc = lane & 7; const size_t off = (size_t)(b * 512 + cb * 64 + ch) * KD + nblk * 64 + nc * 8;
              const LAS unsigned* se = (const LAS unsigned*)(scrE + ch * 66 + nc * 8); const LAS unsigned* so = (const LAS unsigned*)(scrO + ch * 66 + nc * 8);
              v4u w; w.x = se[0]; w.y = se[1]; w.z = se[2]; w.w = se[3]; *(v4u*)(eT + off) = w;
              w.x = so[0]; w.y = so[1]; w.z = so[2]; w.w = so[3]; *(v4u*)(oT + off) = w; }
          LDS_WAIT(); } }
    { bf16* zb = (bf16*)(ws + WS_ZB); const float* cw = a.in[I_CWMIX]; const float* cbias = a.in[I_CBMIX];
      float w0[8], w1[8], w2[8], bb[8]; const int ch0 = lane * 8;
      load8f(cw + ch0, w0); load8f(cw + 512 + ch0, w1); load8f(cw + 1024 + ch0, w2); load8f(cbias + ch0, bb);
      for (int it = gw; it < NB * LSEQ; it += NGW) { const int b = it / LSEQ, p = it - b * LSEQ; const size_t r = (size_t)row_of(b, p);
          float cc[8], vv[8], bg[8], acc[8];
          unpack8f(*(const v4u*)(proj + r * INC + 512 + ch0), cc); unpack8f(*(const v4u*)(proj + r * INC + 1536 + ch0), vv); unpack8f(*(const v4u*)(proj + r * INC + 1024 + ch0), bg);
#pragma unroll
          for (int e = 0; e < 8; ++e) acc[e] = bb[e] + w1[e] * (cc[e] * vv[e]);
          if (p > 0) { const size_t rp = (size_t)row_of(b, p - 1); unpack8f(*(const v4u*)(proj + rp * INC + 512 + ch0), cc); unpack8f(*(const v4u*)(proj + rp * INC + 1536 + ch0), vv);
#pragma unroll
              for (int e = 0; e < 8; ++e) acc[e] += w0[e] * (cc[e] * vv[e]); }
          if (p < LSEQ - 1) { const size_t rn = (size_t)row_of(b, p + 1); unpack8f(*(const v4u*)(proj + rn * INC + 512 + ch0), cc); unpack8f(*(const v4u*)(proj + rn * INC + 1536 + ch0), vv);
#pragma unroll
              for (int e = 0; e < 8; ++e) acc[e] += w2[e] * (cc[e] * vv[e]); }
#pragma unroll
          for (int e = 0; e < 8; ++e) acc[e] *= bg[e];
          *(v4u*)(zb + r * 512 + ch0) = pack8f(acc); } }
}

template <int EPL> __device__ __forceinline__ void sk_load(unsigned (&a)[8][EPL / 2], const bf16* A, int lda, int row0, int rstride, int lane) {
#pragma unroll
    for (int r = 0; r < 8; ++r) { const v4u* p = (const v4u*)(A + (size_t)(row0 + r * rstride) * lda + lane * EPL);
#pragma unroll
        for (int i = 0; i < EPL / 8; ++i) { const v4u w = p[i]; a[r][4 * i] = w.x; a[r][4 * i + 1] = w.y; a[r][4 * i + 2] = w.z; a[r][4 * i + 3] = w.w; } }
}
template <int EPL> __device__ __forceinline__ float sk_dot(const unsigned (&a)[8][EPL / 2], const bf16* btrow, int lane) {
    unsigned b[EPL / 2];
#pragma unroll
    for (int i = 0; i < EPL / 8; ++i) { const v4u w = ((const v4u*)(btrow + lane * EPL))[i]; b[4 * i] = w.x; b[4 * i + 1] = w.y; b[4 * i + 2] = w.z; b[4 * i + 3] = w.w; }
    float acc[8];
#pragma unroll
    for (int r = 0; r < 8; ++r) acc[r] = 0.f;
#pragma unroll
    for (int i = 0; i < EPL / 2; ++i) { const float bl = bflo(b[i]), bh = bfhi(b[i]);
#pragma unroll
        for (int r = 0; r < 8; ++r) acc[r] += bflo(a[r][i]) * bl + bfhi(a[r][i]) * bh; }
    float res = 0.f;
#pragma unroll
    for (int r = 0; r < 8; ++r) { const float t = wave_sum(acc[r]); res = (lane == r) ? t : res; }
    return res;
}
__device__ __forceinline__ bf16 f2bf1(float v) { return (bf16)(cvt_pk_bf16(v, 0.f) & 0xffffu); }
__device__ __forceinline__ float bf2f1(bf16 h) { return __uint_as_float((unsigned)h << 16); }
constexpr int EDGE_ROW0 = R_META + NMETA - 1;

__device__ __forceinline__ void p1_meta(const Args& a, int gw, int NGW, int lane) {
    unsigned char* ws = a.ws; const bf16* h = (const bf16*)(ws + WS_H); const bf16* wt = (const bf16*)(ws + WS_WIN); bf16* proj = (bf16*)(ws + WS_PROJ); const float* bg = a.in[I_BGATES];
#pragma unroll 1
    for (int rg = 0; rg < 2; ++rg) { unsigned av[8][8]; sk_load<16>(av, h, DM, R_META + rg * 8, 1, lane);
#pragma unroll 1
        for (int j = gw; j < INC; j += NGW) { float v = sk_dot<16>(av, wt + (size_t)j * DM, lane);
            if (lane < 8) { if (j >= 2048) v = pg8::sigmoidf_(v + bg[j - 2048]); const bf16 o = f2bf1(v); const int pp = rg * 8 + lane;
#pragma unroll
                for (int b = 0; b < NB; ++b) proj[(size_t)(R_META + b * NMETA + pp) * INC + j] = o; } } }
}
__device__ __forceinline__ void p4_edge(const Args& a, int gw, int lane) {
    if (gw >= DM) return;
    unsigned char* ws = a.ws; const bf16* proj = (const bf16*)(ws + WS_PROJ); bf16* mg = (bf16*)(ws + WS_MG);
    unsigned aF[8][8], aZ[8][4]; sk_load<16>(aF, (const bf16*)(ws + WS_F), DM, EDGE_ROW0, NMETA, lane); sk_load<8>(aZ, (const bf16*)(ws + WS_ZB), 512, EDGE_ROW0, NMETA, lane);
    const int j = gw;
    const float ya = sk_dot<16>(aF, (const bf16*)(ws + WS_WEFF) + (size_t)j * DM, lane), yb = sk_dot<8>(aZ, (const bf16*)(ws + WS_WCO) + (size_t)j * 512, lane);
    if (lane < 8) { const size_t r = (size_t)(EDGE_ROW0 + lane * NMETA); mg[r * DM + j] = f2bf1(bf2f1(proj[r * INC + 2048 + j]) * ya + bf2f1(proj[r * INC + 3072 + j]) * yb); }
}
__device__ __forceinline__ void edge_gemm(const bf16* A, const bf16* Bt, int N, bf16* O, int ldo, int orow0, int ostride, int gw, int NGW, int lane) {
    if (gw >= N) return;
    unsigned av[8][8]; sk_load<16>(av, A, DM, EDGE_ROW0, NMETA, lane);
#pragma unroll 1
    for (int j = gw; j < N; j += NGW) { const float v = sk_dot<16>(av, Bt + (size_t)j * DM, lane);
        if (lane < 8) O[(size_t)(orow0 + lane * ostride) * ldo + j] = f2bf1(v); }
}

__device__ __forceinline__ void dft_tail(const Args& a, int gw, int NGW, int lane) {
    const bf16* dm = (const bf16*)((unsigned char*)a.out + DO_DM); const bf16* eT = (const bf16*)((unsigned char*)a.out + DO_UT); const bf16* oT = eT + (size_t)4096 * KD;
    bf16* F = (bf16*)(a.ws + WS_F);
    for (int row = gw; row < 4096; row += NGW) {
        float se[9], so[9];
#pragma unroll
        for (int kx = 0; kx < 9; ++kx) { se[kx] = 0.f; so[kx] = 0.f; }
        for (int it = 0; it < 9; ++it) { const int off = it * 512 + lane * 8;
            if (off < KD) { float ev[8], ov[8]; unpack8f(*(const v4u*)(eT + (size_t)row * KD + off), ev); unpack8f(*(const v4u*)(oT + (size_t)row * KD + off), ov);
#pragma unroll
                for (int kx = 0; kx < 9; ++kx) { float c[8], sn[8]; unpack8f(*(const v4u*)(dm + (size_t)(4096 + kx) * KD + off), c); unpack8f(*(const v4u*)(dm + (size_t)(KH + 4096 + kx) * KD + off), sn);
#pragma unroll
                    for (int e = 0; e < 8; ++e) { se[kx] += ev[e] * c[e]; so[kx] += ov[e] * sn[e]; } } } }
        float ve = 0.f, vo = 0.f;
#pragma unroll
        for (int kx = 0; kx < 9; ++kx) { const float te = wave_sum(se[kx]), to = wave_sum(so[kx]); if (lane == kx) { ve = te; vo = to; } }
        if (lane < 9) { const int b = row >> 9, ch = row & 511, k = 4096 + lane;
            const unsigned w = cvt_pk_bf16(ve, vo);
            F[(size_t)row_of(b, k) * DM + ch] = (bf16)(w & 0xffffu); F[(size_t)row_of(b, k) * DM + 512 + ch] = (bf16)(w >> 16);
            if (k != NHALF) { F[(size_t)row_of(b, LSEQ - k) * DM + ch] = (bf16)(w & 0xffffu); F[(size_t)row_of(b, LSEQ - k) * DM + 512 + ch] = (bf16)((w >> 16) ^ 0x8000u); } }
    }
}

__device__ __forceinline__ void phase6(const Args& a, int gw, int NGW, int lane) {
    unsigned char* ws = a.ws; const bf16* mix = (const bf16*)(ws + WS_H); bf16* h2 = (bf16*)(ws + WS_H2);
    float g1[2][8], g2[2][8];
#pragma unroll
    for (int j = 0; j < 2; ++j) { load8f(a.in[I_GMIXPOST] + 8 * lane + 512 * j, g1[j]); load8f(a.in[I_GFFNPRE] + 8 * lane + 512 * j, g2[j]); }
    constexpr int NR = R_META + 2 * NB;
    for (int r0 = gw; r0 < NR; r0 += 2 * NGW) {
        float mv[2][2][8], xv[2][2][8];
#pragma unroll
        for (int q = 0; q < 2; ++q) { int ri = (r0 + q * NGW < NR) ? r0 + q * NGW : r0; if (ri >= R_META + NB) ri = R_META;
            const int r = ri < R_META ? ri : EDGE_ROW0 + (ri - R_META) * NMETA;
            const float* src = r < R_META ? a.in[I_X] + (size_t)r * DM : a.in[I_META] + (size_t)(NMETA - 1) * DM;
#pragma unroll
            for (int j = 0; j < 2; ++j) { unpack8f(*(const v4u*)(mix + (size_t)r * DM + 8 * lane + 512 * j), mv[q][j]); load8f(src + 8 * lane + 512 * j, xv[q][j]); } }
#pragma unroll
        for (int q = 0; q < 2; ++q) { const int ri = r0 + q * NGW; if (ri >= NR) continue;
            const size_t orow = ri < R_META ? (size_t)(ri >> 13) * pg8::H2F_PITCH + (ri & 8191) + 1 : (ri < R_META + NB ? (size_t)(ri - R_META) * pg8::H2F_PITCH : (size_t)(ri - R_META - NB) * pg8::H2F_PITCH + SEQ + 1);
            if (ri >= R_META + NB) {
#pragma unroll
                for (int j = 0; j < 2; ++j) *(v4u*)(h2 + orow * DM + 8 * lane + 512 * j) = (v4u){0u, 0u, 0u, 0u};
                continue; }
            float s = 0.f;
#pragma unroll
            for (int j = 0; j < 2; ++j)
#pragma unroll
                for (int e = 0; e < 8; ++e) s += mv[q][j][e] * mv[q][j][e];
            const float r1 = rsqrtf(wave_sum(s) * (1.0f / DM) + RMS_EPS); float s2 = 0.f;
#pragma unroll
            for (int j = 0; j < 2; ++j)
#pragma unroll
                for (int e = 0; e < 8; ++e) { const float hr = xv[q][j][e] + mv[q][j][e] * r1 * g1[j][e]; xv[q][j][e] = hr; s2 += hr * hr; }
            const float r2 = rsqrtf(wave_sum(s2) * (1.0f / DM) + RMS_EPS);
#pragma unroll
            for (int j = 0; j < 2; ++j) { float o[8];
#pragma unroll
                for (int e = 0; e < 8; ++e) o[e] = xv[q][j][e] * r2 * g2[j][e];
                *(v4u*)(h2 + orow * DM + 8 * lane + 512 * j) = pack8f(o); } }
    }
}

__device__ __forceinline__ void phase10(const Args& a, int gw, int NGW, int lane) {
    unsigned char* ws = a.ws; const bf16* mix = (const bf16*)(ws + WS_H); const bf16* ffn = (const bf16*)(ws + WS_MG);
    float g1[2][8], g3[2][8];
#pragma unroll
    for (int j = 0; j < 2; ++j) { load8f(a.in[I_GMIXPOST] + 8 * lane + 512 * j, g1[j]); load8f(a.in[I_GFFNPOST] + 8 * lane + 512 * j, g3[j]); }
    for (int r0 = gw; r0 < R_META; r0 += 2 * NGW) {
        float mv[2][2][8], xv[2][2][8], fv[2][2][8];
#pragma unroll
        for (int q = 0; q < 2; ++q) { const int r = (r0 + q * NGW < R_META) ? r0 + q * NGW : r0;
#pragma unroll
            for (int j = 0; j < 2; ++j) { const size_t off = (size_t)r * DM + 8 * lane + 512 * j;
                unpack8f(*(const v4u*)(mix + off), mv[q][j]); unpack8f(*(const v4u*)(ffn + off), fv[q][j]); load8f_nt(a.in[I_X] + off, xv[q][j]); } }
#pragma unroll
        for (int q = 0; q < 2; ++q) { const int r = r0 + q * NGW; if (r >= R_META) continue;
            float s = 0.f, s3 = 0.f;
#pragma unroll
            for (int j = 0; j < 2; ++j)
#pragma unroll
                for (int e = 0; e < 8; ++e) { s += mv[q][j][e] * mv[q][j][e]; s3 += fv[q][j][e] * fv[q][j][e]; }
            const float r1 = rsqrtf(wave_sum(s) * (1.0f / DM) + RMS_EPS), r3 = rsqrtf(wave_sum(s3) * (1.0f / DM) + RMS_EPS);
#pragma unroll
            for (int j = 0; j < 2; ++j) { float o[8];
#pragma unroll
                for (int e = 0; e < 8; ++e) o[e] = xv[q][j][e] + mv[q][j][e] * r1 * g1[j][e] + fv[q][j][e] * r3 * g3[j][e];
                float* op = a.out + (size_t)r * DM + 8 * lane + 512 * j;
                __builtin_nontemporal_store((f32x4){o[0], o[1], o[2], o[3]}, (f32x4*)op); __builtin_nontemporal_store((f32x4){o[4], o[5], o[6], o[7]}, (f32x4*)(op + 4)); } }
    }
}

#define XB_TMO      128
#define XB_XCNT(j)  (256  + 64 * (j))
#define XB_XSUB(j)  (1280 + 64 * (j))
#define XB_XGEN(j)  (2304 + 64 * (j))
#define XB_TOP      3328
#define XB_TOPGEN   3392
#define XCD_BAR_WORDS 3456
#define XB_SPIN_CAP (1u << 18)

__device__ __forceinline__ unsigned xb_ld(unsigned* p)              { return __hip_atomic_load(p, __ATOMIC_RELAXED, __HIP_MEMORY_SCOPE_AGENT); }
__device__ __forceinline__ unsigned xb_add(unsigned* p, unsigned v) { return __hip_atomic_fetch_add(p, v, __ATOMIC_RELAXED, __HIP_MEMORY_SCOPE_AGENT); }
__device__ __forceinline__ unsigned xb_xcc_id() { return (unsigned)__builtin_amdgcn_s_getreg((3 << 11) | 20) & 0xFu; }
#define XB_SPIN(cond, bar) do { unsigned _sp = 0; while (cond) { __builtin_amdgcn_s_sleep(1); \
    if ((++_sp & 255u) == 0u) { if (xb_ld(&(bar)[XB_TMO])) break; if (_sp > XB_SPIN_CAP) { atomicAdd(&(bar)[XB_TMO], 1u); break; } } } } while (0)

struct XcdBarrier {
    unsigned* bar; unsigned x;
    unsigned nloc, nx;
    unsigned rank;
};

__device__ __forceinline__ XcdBarrier xcd_barrier_post(unsigned* bar) {
    XcdBarrier b; b.bar = bar; b.x = xb_xcc_id(); b.nloc = 0u; b.nx = 0u;
    b.rank = 0u; if (threadIdx.x == 0) b.rank = xb_add(&bar[XB_XCNT(b.x)], 1u);
    return b;
}
__device__ __forceinline__ void xcd_barrier_complete(unsigned* bar, unsigned x, unsigned& nloc, unsigned& nx) {
    const unsigned G = gridDim.x * gridDim.y * gridDim.z;
    unsigned sum, cnt, mine, sp = 0u;
    for (;;) {
        sum = 0u; cnt = 0u; mine = 0u;
#pragma unroll
        for (unsigned j = 0; j < 16; ++j) { const unsigned c = xb_ld(&bar[XB_XCNT(j)]); sum += c; cnt += (c > 0u) ? 1u : 0u; mine = (j == x) ? c : mine; }
        if (sum == G) break;
        __builtin_amdgcn_s_sleep(1);
        if ((++sp & 255u) == 0u) { if (xb_ld(&bar[XB_TMO])) break; if (sp > XB_SPIN_CAP) { atomicAdd(&bar[XB_TMO], 1u); break; } }
    }
    nloc = mine > 0u ? mine : 1u; nx = cnt > 0u ? cnt : 1u;
}

__device__ __forceinline__ void xcd_barrier(XcdBarrier& b) {
    asm volatile("s_waitcnt vmcnt(0)" ::: "memory");
    __syncthreads();
    if (threadIdx.x == 0) {
        unsigned* bar = b.bar;
        __builtin_amdgcn_s_waitcnt(0);
        unsigned nloc = b.nloc, nx = b.nx;
        if (nloc == 0u) { xcd_barrier_complete(bar, b.x, nloc, nx); b.nloc = nloc; b.nx = nx; }
        const unsigned old = xb_add(&bar[XB_XSUB(b.x)], 1u);
        const unsigned gen = old / nloc;
        if (old + 1u == (gen + 1u) * nloc) {
            __builtin_amdgcn_fence(__ATOMIC_RELEASE, "agent");
            asm volatile("s_waitcnt vmcnt(0)" ::: "memory");
            const unsigned og = xb_add(&bar[XB_TOP], 1u);
            const unsigned tg = og / nx;
            if (og + 1u == (tg + 1u) * nx) xb_add(&bar[XB_TOPGEN], 1u);
            else XB_SPIN(xb_ld(&bar[XB_TOPGEN]) == tg, bar);
            __builtin_amdgcn_fence(__ATOMIC_ACQUIRE, "agent");
            xb_add(&bar[XB_XGEN(b.x)], 1u);
            asm volatile("s_waitcnt vmcnt(0)" ::: "memory");
        } else {
            XB_SPIN(xb_ld(&bar[XB_XGEN(b.x)]) == gen, bar);
            __builtin_amdgcn_fence(__ATOMIC_ACQUIRE, "agent");
            asm volatile("s_waitcnt vmcnt(0)" ::: "memory");
        }
    }
    __syncthreads();
}


#ifndef STAGGER_TICKS
#define STAGGER_TICKS 1000
#endif
__device__ __forceinline__ void stagger(int bx, unsigned ticks) {
    const unsigned frac = __brev((unsigned)bx) >> 24;
    const unsigned long long t0 = __builtin_amdgcn_s_memrealtime(), dt = (unsigned long long)ticks * frac / 256;
    while (__builtin_amdgcn_s_memrealtime() - t0 < dt) __builtin_amdgcn_s_sleep(8);
}

constexpr int N_PHASES = 11;
__global__ void __launch_bounds__(NWAVES * 64, 2) fwd_megakernel(Args args) {
    extern __shared__ __attribute__((aligned(16))) unsigned char lds_raw[];
    LAS unsigned char* lds = (LAS unsigned char*)lds_raw;
    cg::grid_group grid = cg::this_grid();
    const int tid = threadIdx.x, lane = tid & 63, wave = __builtin_amdgcn_readfirstlane(tid >> 6);
    const int G = gridDim.x, bx = blockIdx.x;
    const int vcu = (G % 8 == 0) ? (bx % 8) * (G / 8) + bx / 8 : bx;
    const int gw = vcu * NWAVES + wave, NGW = G * NWAVES;
    unsigned char* ws = args.ws;
    const int lo = args.ph_lo, hi = args.ph_hi;
    unsigned* barw = (unsigned*)ws;
    if (args.ph_hi < 0) grid.sync();
    XcdBarrier xbar = xcd_barrier_post(barw);
    int vbx = bx;
    if (G == 256) { if (tid == 0) *(volatile LAS unsigned*)lds = xbar.x + 8u * xbar.rank; __syncthreads(); const unsigned v_ = *(volatile LAS unsigned*)lds; __syncthreads(); if (v_ < 256u) vbx = (int)v_; }
#ifndef PHASE_MASK
#define PHASE_MASK 0x7ff
#endif
#define IN(k) (((PHASE_MASK >> (k)) & 1) && lo <= (k) && (k) < hi)
#define SEAM(k) do { if ((k) + 1 < hi) xcd_barrier(xbar); } while (0)
    using namespace pg8;
    if (IN(0)) { phase0(args, lds, gw, NGW, wave, lane);
        SEAM(0); }
    if (IN(1)) {
        Gemm g{(const bf16_t*)(ws + WS_H), (const bf16_t*)(ws + WS_WIN), DM}; Order S; S.init(256, 0, -1, INC / 256, G, vbx);
        p1_meta(args, gw, NGW, lane);
        EpiProj E{(bf16_t*)(ws + WS_PROJ), args.in[I_BGATES]};
        gemm_phase<EpiProj, Order>(lds, g, S, E); SEAM(1); }
    if (IN(2)) { phase2(args, lds, gw, NGW, wave, lane);
        SEAM(2); }
    if (IN(3)) {
        dft_tail(args, gw, NGW, lane);
        Gemm g{(const bf16_t*)((unsigned char*)args.out + DO_DM), (const bf16_t*)((unsigned char*)args.out + DO_UT), KD}; OrderDft S; S.init(G, vbx);
        EpiDft E{(bf16_t*)(ws + WS_F)};
        gemm_phase<EpiDft, OrderDft>(lds, g, S, E); SEAM(3); }
    if (IN(4)) {
        Gemm g{(const bf16_t*)(ws + WS_F), (const bf16_t*)(ws + WS_WEFF), DM}; Order S; S.init(256, 0, -1, DM / 256, G, vbx);
        p4_edge(args, gw, lane);
        EpiYa E{(bf16_t*)(ws + WS_MG), (const bf16_t*)(ws + WS_PROJ)};
        gemm_phase<EpiYa, Order>(lds, g, S, E); }
    if (IN(5)) {
        Gemm g{(const bf16_t*)(ws + WS_ZB), (const bf16_t*)(ws + WS_WCO), 512}; Order S; S.init(256, 0, -1, DM / 256, G, vbx);
        EpiYb E{(bf16_t*)(ws + WS_MG), (const bf16_t*)(ws + WS_PROJ)};
        gemm_phase<EpiYb, Order>(lds, g, S, E); SEAM(5); }
    if (IN(6)) {
        Gemm g{(const bf16_t*)(ws + WS_MG), (const bf16_t*)(ws + WS_WOUT), DM}; Order S; S.init(256, 0, -1, DM / 256, G, vbx);
        edge_gemm((const bf16*)(ws + WS_MG), (const bf16*)(ws + WS_WOUT), DM, (bf16*)(ws + WS_H), DM, EDGE_ROW0, NMETA, gw, NGW, lane);
        EpiStore E{(bf16_t*)(ws + WS_H), DM, 0, -1, 0};
        gemm_phase<EpiStore, Order>(lds, g, S, E); SEAM(6); }
    if (IN(7)) { phase6(args, gw, NGW, lane);
        SEAM(7); }
    if (IN(8)) {
        Gemm g{(const bf16_t*)(ws + WS_H2), (const bf16_t*)(ws + WS_WUP), DM}; OrderFfn S; S.init(NB * FFN_TPB, 0, -1, 2 * DFF / 256, G, vbx);
        EpiFfn E{(bf16_t*)(ws + WS_ACT), args.in[I_CWFFN], args.in[I_CBFFN], lds + STAGE_BYTES};
        gemm_phase<EpiFfn, OrderFfn>(lds, g, S, E); SEAM(8); }
    if (IN(9)) {
        Gemm g{(const bf16_t*)(ws + WS_ACT), (const bf16_t*)(ws + WS_WDN), DFF}; Order S; S.init(256, 0, -1, DM / 256, G, vbx);
        EpiStore E{(bf16_t*)(ws + WS_MG), DM, 0, -1, 0};
        gemm_phase<EpiStore, Order>(lds, g, S, E); SEAM(9); }
    if (IN(10)) { phase10(args, gw, NGW, lane);
    }
#undef IN
#undef SEAM
}

extern "C" void kernel_launch(void* const* d_in, const int* in_sizes, int n_in, void* d_out, int out_size, void* d_ws, size_t ws_size, hipStream_t stream) {
    static int grid = 0;
    if (grid == 0) {
        if (n_in != 17 || ws_size < WS_NEED || out_size != NB * SEQ * DM) { fprintf(stderr, "kernel_launch: unexpected problem (n_in %d, ws %zu, out %d)\n", n_in, ws_size, out_size); grid = -1; return; }
        int dev = 0, cus = 0, per_cu = 0;
        if (hipGetDevice(&dev) != hipSuccess || hipDeviceGetAttribute(&cus, hipDeviceAttributeMultiprocessorCount, dev) != hipSuccess) { grid = -1; return; }
        if (hipFuncSetAttribute((const void*)fwd_megakernel, hipFuncAttributeMaxDynamicSharedMemorySize, LDS_BYTES) != hipSuccess) { fprintf(stderr, "kernel_launch: hipFuncSetAttribute failed\n"); grid = -1; return; }
        if (hipOccupancyMaxActiveBlocksPerMultiprocessor(&per_cu, (const void*)fwd_megakernel, NWAVES * 64, LDS_BYTES) != hipSuccess || per_cu < 1) { fprintf(stderr, "kernel_launch: occupancy query says %d\n", per_cu); per_cu = 1; }
        (void)hipGetLastError();
        grid = cus * 1;
    }
    if (grid < 0) return;
    if (hipMemsetAsync(d_ws, 0, 16384, stream) != hipSuccess) { fprintf(stderr, "kernel_launch: memset of the barrier words failed\n"); return; }
    Args a{};
    for (int i = 0; i < 17; ++i) a.in[i] = (const float*)d_in[i];
    a.out = (float*)d_out; a.ws = (unsigned char*)d_ws; a.ph_lo = 0; a.ph_hi = N_PHASES;
    void* kargs[] = {&a};
    hipError_t e = hipLaunchCooperativeKernel((const void*)fwd_megakernel, dim3(grid), dim3(NWAVES * 64), kargs, LDS_BYTES, stream);
    if (e != hipSuccess) fprintf(stderr, "kernel_launch: cooperative launch failed: %s (grid %d)\n", hipGetErrorString(e), grid);
}
```

```cpp
#include <hip/hip_runtime.h>
#include <hip/hip_cooperative_groups.h>
#include <cstdio>
#include <cstdint>
namespace cg = cooperative_groups;

constexpr int NB = 8, SEQ = 8192, NMETA = 16, LSEQ = 8208, DM = 1024, DFF = 2816, INC = 4096;
constexpr int R_META = 65536, R_TOT = 65792;
constexpr int NHALF = LSEQ / 2;
constexpr int QL = LSEQ / 4, QH = QL / 2;
constexpr int KD = 1152;
constexpr int KH = 1280, KHT = 5;
constexpr int NCOL = 4 * 4096;
constexpr float RMS_EPS = 1e-6f;
__device__ __forceinline__ int row_of(int b, int pos) { return pos >= NMETA ? b * SEQ + pos - NMETA : R_META + b * NMETA + pos; }

namespace pg8 {
#define PG8_LAS __attribute__((address_space(3)))
typedef unsigned short bf16_t;
typedef short bf16x8 __attribute__((ext_vector_type(8)));
typedef float f32x4 __attribute__((ext_vector_type(4)));
typedef unsigned u32x4 __attribute__((ext_vector_type(4)));
constexpr int BM = 256, BK = 64, HALF = 128, HTB = HALF * BK * 2, STAGE_BYTES = 8 * HTB, NXCD = 8, WGM = 8;

__host__ __device__ __forceinline__ int lds_byte(int r, int c) { const int st = (r >> 4) * 2 + (c >> 5), rr = r & 15, cc = c & 31, ob = rr * 64 + cc * 2; return st * 1024 + (ob ^ (((ob >> 9) & 1) << 5)); }
__host__ __device__ __forceinline__ void stage_rc(int b, int& R, int& C) { const int st = b / 1024, sb = b % 1024, swz = sb ^ (((sb >> 9) & 1) << 5); R = (st >> 1) * 16 + swz / 64; C = (st & 1) * 32 + (swz % 64) / 2; }
__host__ __device__ __forceinline__ int perm32(int rho) { const int n = rho >> 4, i = rho & 15; return 8 * (i >> 2) + 4 * n + (i & 3); }

struct Unit { int pm, pn, arow; };
struct Gemm { const bf16_t* A; const bf16_t* Bt; int K; };

struct Order {
    int nM, nN, nwg, G, c, pm0, nMain, pm_extra;
    __device__ void init(int nMain_, int pm0_, int pm_extra_, int nN_, int G_, int c_) { nMain = nMain_; pm0 = pm0_; pm_extra = pm_extra_; nM = nMain_ + (pm_extra_ >= 0 ? 1 : 0); nN = nN_; nwg = nM * nN; G = G_; c = c_; }
    __device__ bool next(int i, Unit& u) const {
        const long L = (long)i * G + c; if (L >= nwg) return false;
        int wgid = (int)L; { const int q = nwg / NXCD, r = nwg % NXCD, xcd = wgid % NXCD, off = wgid / NXCD; wgid = (xcd < r ? xcd * (q + 1) : r * (q + 1) + (xcd - r) * q) + off; }
        const int nig = WGM * nN, gid = wgid / nig, fm = gid * WGM, gsz = (nM - fm) < WGM ? (nM - fm) : WGM;
        const int t = fm + ((wgid % nig) % gsz); u.pm = (t < nMain) ? pm0 + t : pm_extra; u.pn = (wgid % nig) / gsz; u.arow = u.pm * BM; return true;
    }
    __device__ __forceinline__ void a_ready(const Unit&) const {}
    __device__ __forceinline__ void done(const Unit&) const {}
};
struct OrderDft {
    int G, c;
    __device__ void init(int G_, int c_) { G = G_; c = c_; }
    __device__ bool next(int i, Unit& u) const {
        constexpr int nM = 8, nN = 64, nwg = nM * nN;
        const long L = (long)i * G + c; if (L >= nwg) return false;
        int wgid = (int)L; { const int q = nwg / NXCD, xcd = wgid % NXCD, off = wgid / NXCD; wgid = xcd * q + off; }
        const int t = wgid & 7, pn = wgid >> 3, part = t >> 2;
        u.pm = part * KHT + (t & 3); u.pn = part * 64 + pn; u.arow = u.pm * BM; return true;
    }
    __device__ __forceinline__ void a_ready(const Unit&) const {}
    __device__ __forceinline__ void done(const Unit&) const {}
};
constexpr int H2F_PITCH = 8448, FFN_TPB = 33, FFN_STEP = 254;
struct OrderFfn : Order {
    __device__ bool next(int i, Unit& u) const { if (!Order::next(i, u)) return false; const int b = u.pm / FFN_TPB, t = u.pm - b * FFN_TPB; u.arow = b * H2F_PITCH + FFN_STEP * t; return true; }
};
__device__ __forceinline__ unsigned cvt_pk_bf16(float lo, float hi) { unsigned r; asm volatile("v_cvt_pk_bf16_f32 %0, %1, %2" : "=v"(r) : "v"(lo), "v"(hi)); return r; }
__device__ __forceinline__ u32x4 pack8(const f32x4 v0, const f32x4 v1) { u32x4 w; w.x = cvt_pk_bf16(v0[0], v0[1]); w.y = cvt_pk_bf16(v0[2], v0[3]); w.z = cvt_pk_bf16(v1[0], v1[1]); w.w = cvt_pk_bf16(v1[2], v1[3]); return w; }
__device__ __forceinline__ float bflo(unsigned w) { return __uint_as_float(w << 16); }
__device__ __forceinline__ float bfhi(unsigned w) { return __uint_as_float(w & 0xffff0000u); }
__device__ __forceinline__ void unpack8(const u32x4 w, f32x4& v0, f32x4& v1) { v0 = (f32x4){bflo(w.x), bfhi(w.x), bflo(w.y), bfhi(w.y)}; v1 = (f32x4){bflo(w.z), bfhi(w.z), bflo(w.w), bfhi(w.w)}; }
__device__ __forceinline__ float sigmoidf_(float x) { return __builtin_amdgcn_rcpf(1.0f + __expf(-x)); }
#define EPI_LOOP_AM _Pragma("unroll") for (int ai = 0; ai < 2; ++ai) _Pragma("unroll") for (int m = 0; m < 4; ++m)
#define EPI_LOOP_BJ _Pragma("unroll") for (int bj = 0; bj < 2; ++bj)
typedef const f32x4 (&AccT)[2][2][4][2];

struct EpiProj { static constexpr bool PERM = true, AFTER_DRAIN = false, RPT = true;
    bf16_t* P; const float* bg;
    __device__ __forceinline__ void operator()(AccT acc, const Unit& u, int wr, int wc, int fr, int fq) const {
        const int row0 = u.pm * BM + wr * 64 + fr, colt = u.pn * BM + wc * 32 + 8 * fq;
        const bool gate = u.pn >= 8;
        f32x4 bv[2][2];
        EPI_LOOP_BJ { _Pragma("unroll") for (int n = 0; n < 2; ++n) bv[bj][n] = gate ? *(const f32x4*)(bg + (colt - 2048) + bj * HALF + 4 * n) : (f32x4){0.f, 0.f, 0.f, 0.f}; }
        EPI_LOOP_AM { bf16_t* rowp = P + (size_t)(row0 + ai * HALF + m * 16) * INC + colt;
            EPI_LOOP_BJ { f32x4 v0 = acc[ai][bj][m][0] + bv[bj][0], v1 = acc[ai][bj][m][1] + bv[bj][1];
                if (gate) { _Pragma("unroll") for (int j = 0; j < 4; ++j) { v0[j] = sigmoidf_(v0[j]); v1[j] = sigmoidf_(v1[j]); } }
                *(u32x4*)(rowp + bj * HALF) = pack8(v0, v1); } }
    }
};
struct EpiDft { static constexpr bool PERM = true, AFTER_DRAIN = false, RPT = true;
    bf16_t* S;
    __device__ __forceinline__ void operator()(AccT acc, const Unit& u, int wr, int wc, int fr, int fq) const {
        const int part = u.pm / KHT, kt = u.pm - part * KHT;
        const int row0 = part * KH + kt * BM + wr * 64 + fr, colt = (u.pn & 63) * BM + wc * 32 + 8 * fq;
        EPI_LOOP_AM { bf16_t* rowp = S + (size_t)(row0 + ai * HALF + m * 16) * NCOL + colt;
            EPI_LOOP_BJ { *(u32x4*)(rowp + bj * HALF) = pack8(acc[ai][bj][m][0], acc[ai][bj][m][1]); } }
    }
};
struct EpiYa { static constexpr bool PERM = true, AFTER_DRAIN = false, RPT = true;
    bf16_t* Mg; const bf16_t* P;
    __device__ __forceinline__ void operator()(AccT acc, const Unit& u, int wr, int wc, int fr, int fq) const {
        const int row0 = u.pm * BM + wr * 64 + fr, colt = u.pn * BM + wc * 32 + 8 * fq;
        EPI_LOOP_AM { const size_t row = (size_t)(row0 + ai * HALF + m * 16);
            EPI_LOOP_BJ { const u32x4 gw = *(const u32x4*)(P + row * INC + 2048 + colt + bj * HALF); f32x4 g0, g1; unpack8(gw, g0, g1);
                *(u32x4*)(Mg + row * DM + colt + bj * HALF) = pack8(acc[ai][bj][m][0] * g0, acc[ai][bj][m][1] * g1); }
            asm volatile("" ::: "memory"); }
    }
};
struct EpiYb { static constexpr bool PERM = true, AFTER_DRAIN = false, RPT = false;
    bf16_t* Mg; const bf16_t* P;
    __device__ __forceinline__ void operator()(AccT acc, const Unit& u, int wr, int wc, int fr, int fq) const {
        const int row0 = u.pm * BM + wr * 64 + fr, colt = u.pn * BM + wc * 32 + 8 * fq;
        EPI_LOOP_AM { const size_t row = (size_t)(row0 + ai * HALF + m * 16);
            EPI_LOOP_BJ { const u32x4 gw = *(const u32x4*)(P + row * INC + 3072 + colt + bj * HALF); f32x4 g0, g1; unpack8(gw, g0, g1);
                const u32x4 tw = *(const u32x4*)(Mg + row * DM + colt + bj * HALF); f32x4 t0, t1; unpack8(tw, t0, t1);
                *(u32x4*)(Mg + row * DM + colt + bj * HALF) = pack8(t0 + acc[ai][bj][m][0] * g0, t1 + acc[ai][bj][m][1] * g1); }
            asm volatile("" ::: "memory"); }
    }
};
struct EpiStore { static constexpr bool PERM = true, AFTER_DRAIN = false, RPT = true;
    bf16_t* O; int ldc, pm0, pm_extra, extra_local;
    __device__ __forceinline__ void operator()(AccT acc, const Unit& u, int wr, int wc, int fr, int fq) const {
        const int lt = (u.pm == pm_extra) ? extra_local : u.pm - pm0;
        const int row0 = lt * BM + wr * 64 + fr, colt = u.pn * BM + wc * 32 + 8 * fq;
        EPI_LOOP_AM { bf16_t* rowp = O + (size_t)(row0 + ai * HALF + m * 16) * ldc + colt;
            EPI_LOOP_BJ { *(u32x4*)(rowp + bj * HALF) = pack8(acc[ai][bj][m][0], acc[ai][bj][m][1]); } }
    }
};
struct EpiF32 { static constexpr bool PERM = false, AFTER_DRAIN = false, RPT = true;
    float* C; int ldc, tile_off;
    __device__ __forceinline__ void operator()(AccT acc, const Unit& u, int wr, int wc, int fr, int fq) const {
        const int row0 = (u.pm + tile_off) * BM + wr * 64 + fr, col0 = u.pn * BM + wc * 32 + 4 * fq;
        EPI_LOOP_AM { float* rowp = C + (size_t)(row0 + ai * HALF + m * 16) * ldc + col0;
            EPI_LOOP_BJ { _Pragma("unroll") for (int n = 0; n < 2; ++n) *(f32x4*)(rowp + bj * HALF + n * 16) = acc[ai][bj][m][n]; } }
    }
};

struct EpiFfn { static constexpr bool PERM = true, AFTER_DRAIN = false, RPT = true;
    bf16_t* act; const float* cw; const float* cb; PG8_LAS unsigned char* slab;
    typedef unsigned u32x2 __attribute__((ext_vector_type(2)));
    __device__ __forceinline__ static f32x4 up4(const u32x2 w) { return (f32x4){bflo(w.x), bfhi(w.x), bflo(w.y), bfhi(w.y)}; }
    __device__ __forceinline__ void operator()(AccT acc, const Unit& u, int wr, int wc, int fr, int fq) const {
        const int tid = threadIdx.x, cg8 = tid & 7, rrow = tid >> 3, chunk = cg8 >> 1, hoff = (cg8 & 1) * 8;
        const int b = u.pm / FFN_TPB, t = u.pm - b * FFN_TPB;
#pragma unroll 1
        for (int s = 0; s < 4; ++s) {
            if (wc == s) {
                EPI_LOOP_AM { const int row = ai * HALF + wr * 64 + m * 16 + fr; PG8_LAS unsigned char* rp = slab + row * 128;
                    *(PG8_LAS u32x4*)(rp + ((fq ^ (row & 7)) << 4)) = pack8(acc[ai][0][m][0], acc[ai][0][m][1]);
                    *(PG8_LAS u32x4*)(rp + (((4 + fq) ^ (row & 7)) << 4)) = pack8(acc[ai][1][m][0], acc[ai][1][m][1]); } }
            asm volatile("s_waitcnt lgkmcnt(0)" ::: "memory"); __builtin_amdgcn_s_barrier(); asm volatile("" ::: "memory");
            const int j0 = u.pn * HALF + s * 32 + cg8 * 4;
            const f32x4 ka0 = *(const f32x4*)(cw + j0), ka1 = *(const f32x4*)(cw + 2 * DFF + j0), ka2 = *(const f32x4*)(cw + 4 * DFF + j0), kab = *(const f32x4*)(cb + j0);
            const f32x4 kv0 = *(const f32x4*)(cw + DFF + j0), kv1 = *(const f32x4*)(cw + 3 * DFF + j0), kv2 = *(const f32x4*)(cw + 5 * DFF + j0), kvb = *(const f32x4*)(cb + DFF + j0);
#pragma unroll 1
            for (int i2 = 0; i2 < 4; ++i2) { const int row = rrow + 64 * i2, iloc = FFN_STEP * t + row;
                if (row >= 1 && row <= 254 && iloc <= SEQ) {
                    const PG8_LAS unsigned char* p0 = slab + (row - 1) * 128 + hoff; const PG8_LAS unsigned char* p1 = p0 + 128; const PG8_LAS unsigned char* p2 = p1 + 128;
                    const int s0 = (row - 1) & 7, s1 = row & 7, s2 = (row + 1) & 7;
                    const f32x4 a0 = up4(*(const PG8_LAS u32x2*)(p0 + ((chunk ^ s0) << 4))), a1 = up4(*(const PG8_LAS u32x2*)(p1 + ((chunk ^ s1) << 4))), a2 = up4(*(const PG8_LAS u32x2*)(p2 + ((chunk ^ s2) << 4)));
                    const f32x4 v0 = up4(*(const PG8_LAS u32x2*)(p0 + (((4 + chunk) ^ s0) << 4))), v1 = up4(*(const PG8_LAS u32x2*)(p1 + (((4 + chunk) ^ s1) << 4))), v2 = up4(*(const PG8_LAS u32x2*)(p2 + (((4 + chunk) ^ s2) << 4)));
                    const f32x4 ca = kab + ka0 * a0 + ka1 * a1 + ka2 * a2, cv = kvb + kv0 * v0 + kv1 * v1 + kv2 * v2;
                    f32x4 o;
#pragma unroll
                    for (int e = 0; e < 4; ++e) { const float x = ca[e]; const float z2 = 1.5957691216057308f * (x + 0.044715f * x * x * x); o[e] = x * __builtin_amdgcn_rcpf(1.0f + __expf(-z2)) * cv[e]; }
                    u32x2 w; w.x = cvt_pk_bf16(o[0], o[1]); w.y = cvt_pk_bf16(o[2], o[3]);
                    *(u32x2*)(act + (size_t)(b * SEQ + iloc - 1) * DFF + j0) = w;
                } }
            asm volatile("s_waitcnt lgkmcnt(0)" ::: "memory"); __builtin_amdgcn_s_barrier(); asm volatile("" ::: "memory");
        }
    }
};

template <class Epi, class Sched, bool ALIGN_EPI = true, bool SP2 = true>
__device__ __forceinline__ void gemm_phase(PG8_LAS unsigned char* lds, const Gemm g, const Sched& S, const Epi& E) {
    const int tid = threadIdx.x, wid = __builtin_amdgcn_readfirstlane(tid >> 6), lane = tid & 63, wr = wid >> 2, wc = wid & 3, fr = lane & 15, fq = lane >> 4;
    const int K = g.K, nt = K / BK;
    unsigned voffA[2], voffB[2];
#pragma unroll
    for (int i = 0; i < 2; ++i) { int R, C; stage_rc(tid * 16 + i * 8192, R, C); const int Rb = Epi::PERM ? ((R & ~31) + perm32(R & 31)) : R;
        voffA[i] = (unsigned)(R * K + C) * 2u; voffB[i] = (unsigned)(Rb * K + C) * 2u; }
    const size_t kstep = (size_t)(BK * 2);
    const size_t hstep = (size_t)HALF * K * 2;
    const size_t tstep = 2 * hstep;
    const unsigned ldsw = (unsigned)wid * 1024u;
    const int aoff = lds_byte(wr * 64 + fr, fq * 8), boff = lds_byte(wc * 32 + fr, fq * 8);
#define PG8_SA(b, h) (((b) * 2 + (h)) * HTB)
#define PG8_SB(b, h) ((4 + (b) * 2 + (h)) * HTB)
#define PG8_STAGE(bufoff, gbase, voff) do { _Pragma("unroll") for (int _i = 0; _i < 2; ++_i) \
        __builtin_amdgcn_global_load_lds((const unsigned*)((const char*)(gbase) + (voff)[_i]), (PG8_LAS unsigned*)(lds + (bufoff) + ldsw + _i * 8192), 16, 0, 0); } while (0)
#define PG8_LDA(dst, b, h) do { _Pragma("unroll") for (int m = 0; m < 4; ++m) _Pragma("unroll") for (int k = 0; k < 2; ++k) dst[m][k] = *(const PG8_LAS bf16x8*)(lds + PG8_SA(b, h) + aoff + m * 2048 + k * 1024); } while (0)
#define PG8_LDB(dst, b, h) do { _Pragma("unroll") for (int n = 0; n < 2; ++n) _Pragma("unroll") for (int k = 0; k < 2; ++k) dst[n][k] = *(const PG8_LAS bf16x8*)(lds + PG8_SB(b, h) + boff + n * 2048 + k * 1024); } while (0)
#define PG8_MMA(ai, bj, At, Bt) do { __builtin_amdgcn_s_setprio(1); _Pragma("unroll") for (int m = 0; m < 4; ++m) _Pragma("unroll") for (int n = 0; n < 2; ++n) _Pragma("unroll") for (int k = 0; k < 2; ++k) \
        acc[ai][bj][m][n] = __builtin_amdgcn_mfma_f32_16x16x32_bf16(Bt[n][k], At[m][k], acc[ai][bj][m][n], 0, 0, 0); __builtin_amdgcn_s_setprio(0); } while (0)
#define PG8_WAIT_V(n) asm volatile("s_waitcnt vmcnt(" #n ")" ::: "memory")
#define PG8_WAIT_L(n) asm volatile("s_waitcnt lgkmcnt(" #n ")" ::: "memory")
#define PG8_BAR __builtin_amdgcn_s_barrier()
#define PG8_SCHED __builtin_amdgcn_sched_barrier(0)
    Unit cur, nxt; int ui = 0;
    if (!S.next(0, cur)) return;
    f32x4 acc[2][2][4][2];
#pragma unroll
    for (int a = 0; a < 2; ++a)
#pragma unroll
        for (int b = 0; b < 2; ++b)
#pragma unroll
            for (int m = 0; m < 4; ++m)
#pragma unroll
                for (int n = 0; n < 2; ++n) acc[a][b][m][n] = (f32x4){0.f, 0.f, 0.f, 0.f};
    bf16x8 At[4][2], B0[2][2], B1[2][2];
    const size_t rowb = (size_t)K * 2; const char* cA = (const char*)g.A + (size_t)cur.arow * rowb; const char* cB = (const char*)g.Bt + (size_t)cur.pn * tstep;
    S.a_ready(cur);
    if constexpr (SP2) {
        PG8_STAGE(PG8_SB(0, 0), cB, voffB); PG8_STAGE(PG8_SB(0, 1), cB + hstep, voffB); PG8_STAGE(PG8_SA(0, 0), cA, voffA); PG8_STAGE(PG8_SA(0, 1), cA + hstep, voffA);
        if (wr == 1) PG8_BAR;
        PG8_WAIT_V(2); PG8_BAR;
        PG8_STAGE(PG8_SB(1, 0), cB + kstep, voffB); PG8_STAGE(PG8_SA(1, 0), cA + kstep, voffA); PG8_STAGE(PG8_SB(1, 1), cB + hstep + kstep, voffB);
        PG8_WAIT_V(6); PG8_BAR;
    } else {
        PG8_STAGE(PG8_SB(0, 0), cB, voffB); PG8_STAGE(PG8_SA(0, 0), cA, voffA); PG8_STAGE(PG8_SB(0, 1), cB + hstep, voffB); PG8_STAGE(PG8_SA(0, 1), cA + hstep, voffA);
        if (wr == 1) PG8_BAR;
        PG8_WAIT_V(4); PG8_BAR;
        PG8_STAGE(PG8_SB(1, 0), cB + kstep, voffB); PG8_STAGE(PG8_SA(1, 0), cA + kstep, voffA); PG8_STAGE(PG8_SB(1, 1), cB + hstep + kstep, voffB);
        PG8_WAIT_V(6); PG8_BAR;
    }
    for (;;) {
        const bool has_next = S.next(ui + 1, nxt);
        const char* nA = has_next ? (const char*)g.A + (size_t)nxt.arow * rowb : cA; const char* nB = has_next ? (const char*)g.Bt + (size_t)nxt.pn * tstep : cB;
        for (int t = 0; t < nt; t += 2) {
            const bool last = (t == nt - 2);
            const char* a1 = cA + (size_t)(t + 1) * kstep;
            const char* a2 = last ? nA : cA + (size_t)(t + 2) * kstep; const char* b2 = last ? nB : cB + (size_t)(t + 2) * kstep;
            const char* a3 = a2 + kstep; const char* b3 = b2 + kstep;
            if (last && has_next) S.a_ready(nxt);
            if constexpr (SP2) {
            PG8_LDB(B0, 0, 0); PG8_LDB(B1, 0, 1); PG8_SCHED; PG8_LDA(At, 0, 0); PG8_STAGE(PG8_SA(1, 1), a1 + hstep, voffA);
            PG8_WAIT_V(8); PG8_WAIT_L(0); PG8_BAR; PG8_MMA(0, 0, At, B0); PG8_MMA(0, 1, At, B1); PG8_BAR; PG8_SCHED;
            PG8_LDA(At, 0, 1); PG8_STAGE(PG8_SB(0, 0), b2, voffB); PG8_STAGE(PG8_SB(0, 1), b2 + hstep, voffB); PG8_STAGE(PG8_SA(0, 0), a2, voffA);
            PG8_WAIT_V(8); PG8_WAIT_L(0); PG8_BAR; PG8_MMA(1, 0, At, B0); PG8_MMA(1, 1, At, B1); PG8_BAR; PG8_SCHED;
            PG8_LDB(B0, 1, 0); PG8_LDB(B1, 1, 1); PG8_SCHED; PG8_LDA(At, 1, 0); PG8_STAGE(PG8_SA(0, 1), a2 + hstep, voffA);
            PG8_WAIT_V(8); PG8_WAIT_L(0); PG8_BAR; PG8_MMA(0, 0, At, B0); PG8_MMA(0, 1, At, B1); PG8_BAR; PG8_SCHED;
            PG8_LDA(At, 1, 1); PG8_STAGE(PG8_SB(1, 0), b3, voffB); PG8_STAGE(PG8_SB(1, 1), b3 + hstep, voffB); PG8_STAGE(PG8_SA(1, 0), a3, voffA);
            PG8_WAIT_V(8); PG8_WAIT_L(0); PG8_BAR; PG8_MMA(1, 0, At, B0); PG8_MMA(1, 1, At, B1); PG8_BAR; PG8_SCHED;
            } else {
            PG8_LDB(B0, 0, 0); PG8_SCHED; PG8_LDA(At, 0, 0); PG8_STAGE(PG8_SA(1, 1), a1 + hstep, voffA);
            PG8_WAIT_L(8); PG8_BAR; PG8_WAIT_L(0); PG8_MMA(0, 0, At, B0); PG8_BAR; PG8_SCHED;
            PG8_LDB(B1, 0, 1); PG8_STAGE(PG8_SB(0, 0), b2, voffB);
            PG8_BAR; PG8_WAIT_L(0); PG8_MMA(0, 1, At, B1); PG8_BAR;
            PG8_LDA(At, 0, 1); PG8_STAGE(PG8_SA(0, 0), a2, voffA);
            PG8_BAR; PG8_WAIT_L(0); PG8_MMA(1, 0, At, B0); PG8_BAR; PG8_SCHED;
            PG8_STAGE(PG8_SB(0, 1), b2 + hstep, voffB);
            PG8_WAIT_V(6); PG8_BAR; PG8_MMA(1, 1, At, B1); PG8_BAR;
            PG8_LDB(B0, 1, 0); PG8_SCHED; PG8_LDA(At, 1, 0); PG8_STAGE(PG8_SA(0, 1), a2 + hstep, voffA);
            PG8_WAIT_L(8); PG8_BAR; PG8_WAIT_L(0); PG8_MMA(0, 0, At, B0); PG8_BAR; PG8_SCHED;
            PG8_LDB(B1, 1, 1); PG8_STAGE(PG8_SB(1, 0), b3, voffB);
            PG8_BAR; PG8_WAIT_L(0); PG8_MMA(0, 1, At, B1); PG8_BAR;
            PG8_LDA(At, 1, 1); PG8_STAGE(PG8_SA(1, 0), a3, voffA);
            PG8_BAR; PG8_WAIT_L(0); PG8_MMA(1, 0, At, B0); PG8_BAR; PG8_SCHED;
            PG8_STAGE(PG8_SB(1, 1), b3 + hstep, voffB);
            PG8_WAIT_V(6); PG8_BAR; PG8_MMA(1, 1, At, B1); PG8_BAR;
            }
        }
        if constexpr (ALIGN_EPI) { if (wr == 0) PG8_BAR; }
        if constexpr (!Epi::AFTER_DRAIN) { E(acc, cur, wr, wc, fr, fq);
            S.done(cur); }
        if (!has_next) break;
#pragma unroll
        for (int a = 0; a < 2; ++a)
#pragma unroll
            for (int b = 0; b < 2; ++b)
#pragma unroll
                for (int m = 0; m < 4; ++m)
#pragma unroll
                    for (int n = 0; n < 2; ++n) acc[a][b][m][n] = (f32x4){0.f, 0.f, 0.f, 0.f};
        cur = nxt; cA = nA; cB = nB; ++ui;
        if constexpr (ALIGN_EPI) { if (wr == 1) PG8_BAR; }
    }
    PG8_WAIT_V(0);
    if constexpr (!ALIGN_EPI) { if (wr == 0) PG8_BAR; }
    PG8_BAR;
    if constexpr (Epi::AFTER_DRAIN) { E.fused(acc, cur, wr, wc, fr, fq, lds, wid, lane); S.done(cur); }
#undef PG8_SA
#undef PG8_SB
#undef PG8_STAGE
#undef PG8_LDA
#undef PG8_LDB
#undef PG8_MMA
#undef PG8_WAIT_V
#undef PG8_WAIT_L
#undef PG8_BAR
#undef PG8_SCHED
}
}

constexpr int NWAVES = 8;
constexpr int LDS_BYTES = 163840;
constexpr size_t MiB = 1u << 20;
constexpr size_t WS_WIN = 1 * MiB, WS_WEFF = 9 * MiB, WS_WCO = 11 * MiB, WS_WOUT = 12 * MiB, WS_WUP = 14 * MiB, WS_WDN = 25 * MiB;
constexpr size_t WS_H = 32 * MiB;
constexpr size_t WS_PROJ = 161 * MiB;
constexpr size_t WS_H2 = 161 * MiB;
constexpr size_t WS_ACT = 300 * MiB;
constexpr size_t WS_ZB = 675 * MiB;
constexpr size_t WS_F = 740 * MiB;
constexpr size_t WS_MG = 869 * MiB;
constexpr size_t WS_NEED = 1000 * MiB;
constexpr size_t DO_DM = 0, DO_UT = 8 * MiB, DO_S = 96 * MiB;
static_assert((size_t)2 * KH * KD * 2 <= DO_UT && DO_UT + (size_t)2 * NCOL * KD * 2 <= DO_S && DO_S + (size_t)2 * KH * NCOL * 2 <= 256 * MiB, "d_out scratch map");
static_assert(WS_H + (size_t)R_TOT * DM * 2 <= WS_PROJ && WS_PROJ + (size_t)R_TOT * INC * 2 <= WS_ZB && WS_ZB + (size_t)R_TOT * 512 * 2 <= WS_F && WS_F + (size_t)R_TOT * DM * 2 <= WS_MG && WS_MG + (size_t)R_TOT * DM * 2 <= WS_NEED, "ws map 1");
static_assert(WS_H2 + (size_t)NB * pg8::H2F_PITCH * DM * 2 <= WS_ACT && WS_ACT + (size_t)65536 * DFF * 2 <= WS_MG, "ws map 2");

#define LAS __attribute__((address_space(3)))
typedef unsigned short bf16;
typedef unsigned v4u __attribute__((ext_vector_type(4)));
typedef unsigned v2u __attribute__((ext_vector_type(2)));
typedef float f32x4 __attribute__((ext_vector_type(4)));
#define LDS_WAIT() asm volatile("s_waitcnt lgkmcnt(0)" ::: "memory")
using pg8::cvt_pk_bf16; using pg8::bflo; using pg8::bfhi;

__device__ __forceinline__ float wave_sum(float v) {
#pragma unroll
    for (int o = 1; o < 64; o <<= 1) v += __shfl_xor(v, o);
    return v;
}
__device__ __forceinline__ void unpack8f(const v4u w, float (&f)[8]) { f[0] = bflo(w.x); f[1] = bfhi(w.x); f[2] = bflo(w.y); f[3] = bfhi(w.y); f[4] = bflo(w.z); f[5] = bfhi(w.z); f[6] = bflo(w.w); f[7] = bfhi(w.w); }
__device__ __forceinline__ v4u pack8f(const float (&f)[8]) { v4u w; w.x = cvt_pk_bf16(f[0], f[1]); w.y = cvt_pk_bf16(f[2], f[3]); w.z = cvt_pk_bf16(f[4], f[5]); w.w = cvt_pk_bf16(f[6], f[7]); return w; }
__device__ __forceinline__ void load8f_nt(const float* p, float (&f)[8]) { const f32x4 a = __builtin_nontemporal_load((const f32x4*)p), b = __builtin_nontemporal_load((const f32x4*)(p + 4)); f[0] = a.x; f[1] = a.y; f[2] = a.z; f[3] = a.w; f[4] = b.x; f[5] = b.y; f[6] = b.z; f[7] = b.w; }
__device__ __forceinline__ void load8f(const float* p, float (&f)[8]) { const f32x4 a = *(const f32x4*)p, b = *(const f32x4*)(p + 4); f[0] = a.x; f[1] = a.y; f[2] = a.z; f[3] = a.w; f[4] = b.x; f[5] = b.y; f[6] = b.z; f[7] = b.w; }

struct Args { const float* in[17]; float* out; unsigned char* ws; int ph_lo, ph_hi; };
enum { I_X = 0, I_META, I_GMIXPRE, I_WIN, I_BGATES, I_WFOURIER, I_CWMIX, I_CBMIX, I_WCONVOUT, I_WOUT, I_GMIXPOST, I_GFFNPRE, I_WUP, I_CWFFN, I_CBFFN, I_WDOWN, I_GFFNPOST };

__device__ __forceinline__ void p0_transpose_item(const float* __restrict__ W, int K, int N, bf16* __restrict__ WT, int k0, int n0, int drow0, LAS float* scr, int lane) {
    f32x4 tv[8];
#pragma unroll
    for (int i = 0; i < 8; ++i) tv[i] = *(const f32x4*)(W + (size_t)(k0 + i * 8 + (lane >> 3)) * N + n0 + 4 * (lane & 7));
#pragma unroll
    for (int i = 0; i < 8; ++i) { LAS float* d = scr + (i * 8 + (lane >> 3)) * 33 + 4 * (lane & 7); d[0] = tv[i].x; d[1] = tv[i].y; d[2] = tv[i].z; d[3] = tv[i].w; }
    LDS_WAIT();
    const int c = lane & 7;
#pragma unroll
    for (int j = 0; j < 4; ++j) { const int n = (lane >> 3) + 8 * j; const LAS float* s = scr + (8 * c) * 33 + n;
        v4u o; o.x = cvt_pk_bf16(s[0 * 33], s[1 * 33]); o.y = cvt_pk_bf16(s[2 * 33], s[3 * 33]); o.z = cvt_pk_bf16(s[4 * 33], s[5 * 33]); o.w = cvt_pk_bf16(s[6 * 33], s[7 * 33]);
        *(v4u*)(WT + (size_t)(drow0 + n) * K + k0 + 8 * c) = o; }
    LDS_WAIT();
}
__device__ __forceinline__ int wup_drow(int n0) { return n0 < DFF ? 256 * (n0 >> 7) + (n0 & 127) : 256 * ((n0 - DFF) >> 7) + 128 + ((n0 - DFF) & 127); }

__device__ __forceinline__ void phase0(const Args& a, LAS unsigned char* lds, int gw, int NGW, int wave, int lane) {
    unsigned char* ws = a.ws;
    LAS float* scr = (LAS float*)(lds + wave * 16384);
    constexpr int T_IN = 16 * 128, T_CO = 8 * 32, T_OUT = 16 * 32, T_UP = 16 * 176, T_DN = 44 * 32, T_ALL = T_IN + T_CO + T_OUT + T_UP + T_DN;
    for (int it = gw; it < T_ALL; it += NGW) {
        int r = it;
        if (r < T_IN) { const int kb = r / 128, nb = r % 128; p0_transpose_item(a.in[I_WIN], DM, INC, (bf16*)(ws + WS_WIN), kb * 64, nb * 32, nb * 32, scr, lane); continue; } r -= T_IN;
        if (r < T_CO) { const int kb = r / 32, nb = r % 32; p0_transpose_item(a.in[I_WCONVOUT], 512, DM, (bf16*)(ws + WS_WCO), kb * 64, nb * 32, nb * 32, scr, lane); continue; } r -= T_CO;
        if (r < T_OUT) { const int kb = r / 32, nb = r % 32; p0_transpose_item(a.in[I_WOUT], DM, DM, (bf16*)(ws + WS_WOUT), kb * 64, nb * 32, nb * 32, scr, lane); continue; } r -= T_OUT;
        if (r < T_UP) { const int kb = r / 176, nb = r % 176; p0_transpose_item(a.in[I_WUP], DM, 2 * DFF, (bf16*)(ws + WS_WUP), kb * 64, nb * 32, wup_drow(nb * 32), scr, lane); continue; } r -= T_UP;
        { const int kb = r / 32, nb = r % 32; p0_transpose_item(a.in[I_WDOWN], DFF, DM, (bf16*)(ws + WS_WDN), kb * 64, nb * 32, nb * 32, scr, lane); }
    }
    { const float* wf = a.in[I_WFOURIER]; bf16* we = (bf16*)(ws + WS_WEFF);
      for (int it = gw; it < 8192; it += NGW) { const int jb = it & 15, c = (it >> 4) & 127, g = it >> 11, j = jb * 64 + lane;
          float ac = 0.f, as = 0.f;
#pragma unroll 32
          for (int cp = 0; cp < 128; ++cp) { const float w = wf[(size_t)(g * 128 + cp) * DM + j]; const float ph = (float)((c * cp) & 127) * (1.0f / 128.0f);
              ac += __builtin_amdgcn_cosf(ph) * w; as += __builtin_amdgcn_sinf(ph) * w; }
          const float s = 0.08838834764831845f;
          we[(size_t)j * DM + g * 128 + c] = (bf16)(cvt_pk_bf16(ac * s, 0.f) & 0xffffu); we[(size_t)j * DM + 512 + g * 128 + c] = (bf16)(cvt_pk_bf16(as * s, 0.f) & 0xffffu); } }
    { bf16* dmat = (bf16*)((unsigned char*)a.out + DO_DM); constexpr int CPR = KD / 8;
      for (int it = gw; it < 2 * KH * CPR / 64; it += NGW) { const int chunk = it * 64 + lane, row = chunk / CPR, ci = chunk - row * CPR, n0 = ci * 8, part = row >= KH, k = row - part * KH;
          int mm = (int)(((unsigned)k * (unsigned)n0) % (unsigned)QL); const int kq = k % QL; float f[8];
#pragma unroll
          for (int i = 0; i < 8; ++i) { const float ph = (float)mm * (1.0f / (float)QL); const float v = part ? -__builtin_amdgcn_sinf(ph) : __builtin_amdgcn_cosf(ph);
              f[i] = (n0 + i <= QH) ? v * 0.011037770f : 0.f; mm += kq; if (mm >= QL) mm -= QL; }
          *(v4u*)(dmat + (size_t)row * KD + n0) = pack8f(f); } }
    { const float* g = a.in[I_GMIXPRE]; bf16* h = (bf16*)(ws + WS_H);
      f32x4 gv[4];
#pragma unroll
      for (int j = 0; j < 4; ++j) gv[j] = ((const f32x4*)g)[lane + 64 * j];
      for (int r0 = gw; r0 < R_TOT; r0 += 2 * NGW) {
          f32x4 v[2][4]; float s2[2];
#pragma unroll
          for (int q = 0; q < 2; ++q) { const int r = r0 + q * NGW; s2[q] = 0.f;
              if (r < R_META + NB * NMETA) { const float* src = r < R_META ? a.in[I_X] + (size_t)r * DM : a.in[I_META] + (size_t)((r - R_META) & 15) * DM;
#pragma unroll
                  for (int j = 0; j < 4; ++j) v[q][j] = ((const f32x4*)src)[lane + 64 * j]; }
              else {
#pragma unroll
                  for (int j = 0; j < 4; ++j) v[q][j] = (f32x4){0.f, 0.f, 0.f, 0.f}; } }
#pragma unroll
          for (int q = 0; q < 2; ++q) {
#pragma unroll
              for (int j = 0; j < 4; ++j) s2[q] += (v[q][j].x * v[q][j].x + v[q][j].y * v[q][j].y) + (v[q][j].z * v[q][j].z + v[q][j].w * v[q][j].w); }
#pragma unroll
          for (int q = 0; q < 2; ++q) { const int r = r0 + q * NGW; if (r >= R_TOT) continue;
              const float rstd = rsqrtf(wave_sum(s2[q]) * (1.0f / DM) + RMS_EPS);
              unsigned long long* o8 = (unsigned long long*)(h + (size_t)r * DM) + lane;
#pragma unroll
              for (int j = 0; j < 4; ++j) { const f32x4 o = v[q][j] * rstd * gv[j]; o8[64 * j] = (unsigned long long)cvt_pk_bf16(o.x, o.y) | ((unsigned long long)cvt_pk_bf16(o.z, o.w) << 32); } }
      } }
}

__device__ __forceinline__ void phase2(const Args& a, LAS unsigned char* lds, int gw, int NGW, int wave, int lane) {
    unsigned char* ws = a.ws; const bf16* proj = (const bf16*)(ws + WS_PROJ);
    { bf16* eT = (bf16*)((unsigned char*)a.out + DO_UT); bf16* oT = eT + (size_t)NCOL * KD;
      LAS bf16* scrE = (LAS bf16*)(lds + wave * 16896); LAS bf16* scrO = scrE + 64 * 66;
      constexpr int NBLK = KD / 64;
      for (int it = gw; it < 4 * NB * 8 * NBLK; it += NGW) { const int nblk = it % NBLK, cb = (it / NBLK) & 7, b = (it / (8 * NBLK)) & 7, r = it / (64 * NBLK);
#pragma unroll
          for (int i = 0; i < 8; ++i) { const int nl = i * 8 + (lane >> 3), mh = nblk * 64 + nl, chunk = lane & 7;
              float e[8], o[8];
#pragma unroll
              for (int j = 0; j < 8; ++j) { e[j] = 0.f; o[j] = 0.f; }
              if (mh <= QH) { unpack8f(*(const v4u*)(proj + (size_t)row_of(b, 4 * mh + r) * INC + cb * 64 + chunk * 8), e);
                  if (mh >= 1 && mh < QH) { float u2[8]; unpack8f(*(const v4u*)(proj + (size_t)row_of(b, LSEQ - 4 * mh + r) * INC + cb * 64 + chunk * 8), u2);
#pragma unroll
                      for (int j = 0; j < 8; ++j) { o[j] = e[j] - u2[j]; e[j] = e[j] + u2[j]; } } }
              LAS bf16* dE = scrE + (chunk * 8) * 66 + nl; LAS bf16* dO = scrO + (chunk * 8) * 66 + nl;
#pragma unroll
              for (int j = 0; j < 8; ++j) { const unsigned w = cvt_pk_bf16(e[j], o[j]); dE[j * 66] = (bf16)(w & 0xffffu); dO[j * 66] = (bf16)(w >> 16); } }
          LDS_WAIT();
#pragma unroll
          for (int i = 0; i < 8; ++i) { const int ch = i * 8 + (lane >> 3), nc = lane & 7; const size_t off = (size_t)(r * 4096 + b * 512 + cb * 64 + ch) * KD + nblk * 64 + nc * 8;
              const LAS unsigned* se = (const LAS unsigned*)(scrE + ch * 66 + nc * 8); const LAS unsigned* so = (const LAS unsigned*)(scrO + ch * 66 + nc * 8);
              v4u w; w.x = se[0]; w.y = se[1]; w.z = se[2]; w.w = se[3]; *(v4u*)(eT + off) = w;
              w.x = so[0]; w.y = so[1]; w.z = so[2]; w.w = so[3]; *(v4u*)(oT + off) = w; }
          LDS_WAIT(); } }
    { bf16* zb = (bf16*)(ws + WS_ZB); const float* cw = a.in[I_CWMIX]; const float* cbias = a.in[I_CBMIX];
      float w0[8], w1[8], w2[8], bb[8]; const int ch0 = lane * 8;
      load8f(cw + ch0, w0); load8f(cw + 512 + ch0, w1); load8f(cw + 1024 + ch0, w2); load8f(cbias + ch0, bb);
      for (int it = gw; it < NB * LSEQ; it += NGW) { const int b = it / LSEQ, p = it - b * LSEQ; const size_t r = (size_t)row_of(b, p);
          float cc[8], vv[8], bg[8], acc[8];
          unpack8f(*(const v4u*)(proj + r * INC + 512 + ch0), cc); unpack8f(*(const v4u*)(proj + r * INC + 1536 + ch0), vv); unpack8f(*(const v4u*)(proj + r * INC + 1024 + ch0), bg);
#pragma unroll
          for (int e = 0; e < 8; ++e) acc[e] = bb[e] + w1[e] * (cc[e] * vv[e]);
          if (p > 0) { const size_t rp = (size_t)row_of(b, p - 1); unpack8f(*(const v4u*)(proj + rp * INC + 512 + ch0), cc); unpack8f(*(const v4u*)(proj + rp * INC + 1536 + ch0), vv);
#pragma unroll
              for (int e = 0; e < 8; ++e) acc[e] += w0[e] * (cc[e] * vv[e]); }
          if (p < LSEQ - 1) { const size_t rn = (size_t)row_of(b, p + 1); unpack8f(*(const v4u*)(proj + rn * INC + 512 + ch0), cc); unpack8f(*(const v4u*)(proj + rn * INC + 1536 + ch0), vv);
#pragma unroll
              for (int e = 0; e < 8; ++e) acc[e] += w2[e] * (cc[e] * vv[e]); }
#pragma unroll
          for (int e = 0; e < 8; ++e) acc[e] *= bg[e];
          *(v4u*)(zb + r * 512 + ch0) = pack8f(acc); } }
}

template <int EPL> __device__ __forceinline__ void sk_load(unsigned (&a)[8][EPL / 2], const bf16* A, int lda, int row0, int rstride, int lane) {
#pragma unroll
    for (int r = 0; r < 8; ++r) { const v4u* p = (const v4u*)(A + (size_t)(row0 + r * rstride) * lda + lane * EPL);
#pragma unroll
        for (int i = 0; i < EPL / 8; ++i) { const v4u w = p[i]; a[r][4 * i] = w.x; a[r][4 * i + 1] = w.y; a[r][4 * i + 2] = w.z; a[r][4 * i + 3] = w.w; } }
}
template <int EPL> __device__ __forceinline__ float sk_dot(const unsigned (&a)[8][EPL / 2], const bf16* btrow, int lane) {
    unsigned b[EPL / 2];
#pragma unroll
    for (int i = 0; i < EPL / 8; ++i) { const v4u w = ((const v4u*)(btrow + lane * EPL))[i]; b[4 * i] = w.x; b[4 * i + 1] = w.y; b[4 * i + 2] = w.z; b[4 * i + 3] = w.w; }
    float acc[8];
#pragma unroll
    for (int r = 0; r < 8; ++r) acc[r] = 0.f;
#pragma unroll
    for (int i = 0; i < EPL / 2; ++i) { const float bl = bflo(b[i]), bh = bfhi(b[i]);
#pragma unroll
        for (int r = 0; r < 8; ++r) acc[r] += bflo(a[r][i]) * bl + bfhi(a[r][i]) * bh; }
    float res = 0.f;
#pragma unroll
    for (int r = 0; r < 8; ++r) { const float t = wave_sum(acc[r]); res = (lane == r) ? t : res; }
    return res;
}
__device__ __forceinline__ bf16 f2bf1(float v) { return (bf16)(cvt_pk_bf16(v, 0.f) & 0xffffu); }
__device__ __forceinline__ float bf2f1(bf16 h) { return __uint_as_float((unsigned)h << 16); }
constexpr int EDGE_ROW0 = R_META + NMETA - 1;

__device__ __forceinline__ void p1_meta(const Args& a, int gw, int NGW, int lane) {
    unsigned char* ws = a.ws; const bf16* h = (const bf16*)(ws + WS_H); const bf16* wt = (const bf16*)(ws + WS_WIN); bf16* proj = (bf16*)(ws + WS_PROJ); const float* bg = a.in[I_BGATES];
#pragma unroll 1
    for (int rg = 0; rg < 2; ++rg) { unsigned av[8][8]; sk_load<16>(av, h, DM, R_META + rg * 8, 1, lane);
#pragma unroll 1
        for (int j = gw; j < INC; j += NGW) { float v = sk_dot<16>(av, wt + (size_t)j * DM, lane);
            if (lane < 8) { if (j >= 2048) v = pg8::sigmoidf_(v + bg[j - 2048]); const bf16 o = f2bf1(v); const int pp = rg * 8 + lane;
#pragma unroll
                for (int b = 0; b < NB; ++b) proj[(size_t)(R_META + b * NMETA + pp) * INC + j] = o; } } }
}
__device__ __forceinline__ void p4_edge(const Args& a, int gw, int lane) {
    if (gw >= DM) return;
    unsigned char* ws = a.ws; const bf16* proj = (const bf16*)(ws + WS_PROJ); bf16* mg = (bf16*)(ws + WS_MG);
    unsigned aF[8][8], aZ[8][4]; sk_load<16>(aF, (const bf16*)(ws + WS_F), DM, EDGE_ROW0, NMETA, lane); sk_load<8>(aZ, (const bf16*)(ws + WS_ZB), 512, EDGE_ROW0, NMETA, lane);
    const int j = gw;
    const float ya = sk_dot<16>(aF, (const bf16*)(ws + WS_WEFF) + (size_t)j * DM, lane), yb = sk_dot<8>(aZ, (const bf16*)(ws + WS_WCO) + (size_t)j * 512, lane);
    if (lane < 8) { const size_t r = (size_t)(EDGE_ROW0 + lane * NMETA); mg[r * DM + j] = f2bf1(bf2f1(proj[r * INC + 2048 + j]) * ya + bf2f1(proj[r * INC + 3072 + j]) * yb); }
}
__device__ __forceinline__ void edge_gemm(const bf16* A, const bf16* Bt, int N, bf16* O, int ldo, int orow0, int ostride, int gw, int NGW, int lane) {
    if (gw >= N) return;
    unsigned av[8][8]; sk_load<16>(av, A, DM, EDGE_ROW0, NMETA, lane);
#pragma unroll 1
    for (int j = gw; j < N; j += NGW) { const float v = sk_dot<16>(av, Bt + (size_t)j * DM, lane);
        if (lane < 8) O[(size_t)(orow0 + lane * ostride) * ldo + j] = f2bf1(v); }
}

__device__ __forceinline__ void dft_tail(const Args& a, int gw, int NGW, int lane) {
    const bf16* dm = (const bf16*)((unsigned char*)a.out + DO_DM); const bf16* eT = (const bf16*)((unsigned char*)a.out + DO_UT); const bf16* oT = eT + (size_t)NCOL * KD;
    bf16* S = (bf16*)((unsigned char*)a.out + DO_S);
    for (int col = gw; col < NCOL; col += NGW) {
        float se[3], so[3];
#pragma unroll
        for (int kx = 0; kx < 3; ++kx) { se[kx] = 0.f; so[kx] = 0.f; }
#pragma unroll
        for (int it = 0; it < 3; ++it) { const int off = it * 512 + lane * 8;
            if (off < KD) { float ev[8], ov[8]; unpack8f(*(const v4u*)(eT + (size_t)col * KD + off), ev); unpack8f(*(const v4u*)(oT + (size_t)col * KD + off), ov);
#pragma unroll
                for (int kx = 0; kx < 3; ++kx) { float c[8], sn[8]; unpack8f(*(const v4u*)(dm + (size_t)(1024 + kx) * KD + off), c); unpack8f(*(const v4u*)(dm + (size_t)(KH + 1024 + kx) * KD + off), sn);
#pragma unroll
                    for (int e = 0; e < 8; ++e) { se[kx] += ev[e] * c[e]; so[kx] += ov[e] * sn[e]; } } } }
        float ve = 0.f, vo = 0.f;
#pragma unroll
        for (int kx = 0; kx < 3; ++kx) { const float te = wave_sum(se[kx]), to = wave_sum(so[kx]); if (lane == kx) { ve = te; vo = to; } }
        if (lane < 3) { const unsigned w = cvt_pk_bf16(ve, vo);
            S[(size_t)(1024 + lane) * NCOL + col] = (bf16)(w & 0xffffu); S[(size_t)(KH + 1024 + lane) * NCOL + col] = (bf16)(w >> 16); }
    }
}
__device__ __forceinline__ void dft_combine(const Args& a, int gw, int NGW, int lane) {
    const bf16* S = (const bf16*)((unsigned char*)a.out + DO_S); bf16* F = (bf16*)(a.ws + WS_F);
    const int ch0 = lane * 8;
    for (int it = gw; it < NB * (NHALF + 1); it += NGW) { const int b = it / (NHALF + 1), k = it - b * (NHALF + 1);
        int k1 = k % QL; float sg = 1.f; if (k1 > QH) { k1 = QL - k1; sg = -1.f; }
        float ar[8], ai[8];
#pragma unroll
        for (int e = 0; e < 8; ++e) { ar[e] = 0.f; ai[e] = 0.f; }
#pragma unroll
        for (int r = 0; r < 4; ++r) { float re[8], im[8];
            unpack8f(*(const v4u*)(S + (size_t)k1 * NCOL + r * 4096 + b * 512 + ch0), re); unpack8f(*(const v4u*)(S + (size_t)(KH + k1) * NCOL + r * 4096 + b * 512 + ch0), im);
            const float ph = (float)((r * k) % LSEQ) * (1.0f / (float)LSEQ); const float c = __builtin_amdgcn_cosf(ph), sn = __builtin_amdgcn_sinf(ph);
#pragma unroll
            for (int e = 0; e < 8; ++e) { const float x = re[e], y = sg * im[e]; ar[e] += c * x + sn * y; ai[e] += c * y - sn * x; } }
        *(v4u*)(F + (size_t)row_of(b, k) * DM + ch0) = pack8f(ar); *(v4u*)(F + (size_t)row_of(b, k) * DM + 512 + ch0) = pack8f(ai);
        if (k >= 1 && k < NHALF) {
#pragma unroll
            for (int e = 0; e < 8; ++e) ai[e] = -ai[e];
            *(v4u*)(F + (size_t)row_of(b, LSEQ - k) * DM + ch0) = pack8f(ar); *(v4u*)(F + (size_t)row_of(b, LSEQ - k) * DM + 512 + ch0) = pack8f(ai); }
    }
}

__device__ __forceinline__ void phase6(const Args& a, int gw, int NGW, int lane) {
    unsigned char* ws = a.ws; const bf16* mix = (const bf16*)(ws + WS_H); bf16* h2 = (bf16*)(ws + WS_H2);
    float g1[2][8], g2[2][8];
#pragma unroll
    for (int j = 0; j < 2; ++j) { load8f(a.in[I_GMIXPOST] + 8 * lane + 512 * j, g1[j]); load8f(a.in[I_GFFNPRE] + 8 * lane + 512 * j, g2[j]); }
    constexpr int NR = R_META + 2 * NB;
    for (int r0 = gw; r0 < NR; r0 += 2 * NGW) {
        float mv[2][2][8], xv[2][2][8];
#pragma unroll
        for (int q = 0; q < 2; ++q) { int ri = (r0 + q * NGW < NR) ? r0 + q * NGW : r0; if (ri >= R_META + NB) ri = R_META;
            const int r = ri < R_META ? ri : EDGE_ROW0 + (ri - R_META) * NMETA;
            const float* src = r < R_META ? a.in[I_X] + (size_t)r * DM : a.in[I_META] + (size_t)(NMETA - 1) * DM;
#pragma unroll
            for (int j = 0; j < 2; ++j) { unpack8f(*(const v4u*)(mix + (size_t)r * DM + 8 * lane + 512 * j), mv[q][j]); load8f(src + 8 * lane + 512 * j, xv[q][j]); } }
#pragma unroll
        for (int q = 0; q < 2; ++q) { const int ri = r0 + q * NGW; if (ri >= NR) continue;
            const size_t orow = ri < R_META ? (size_t)(ri >> 13) * pg8::H2F_PITCH + (ri & 8191) + 1 : (ri < R_META + NB ? (size_t)(ri - R_META) * pg8::H2F_PITCH : (size_t)(ri - R_META - NB) * pg8::H2F_PITCH + SEQ + 1);
            if (ri >= R_META + NB) {
#pragma unroll
                for (int j = 0; j < 2; ++j) *(v4u*)(h2 + orow * DM + 8 * lane + 512 * j) = (v4u){0u, 0u, 0u, 0u};
                continue; }
            float s = 0.f;
#pragma unroll
            for (int j = 0; j < 2; ++j)
#pragma unroll
                for (int e = 0; e < 8; ++e) s += mv[q][j][e] * mv[q][j][e];
            const float r1 = rsqrtf(wave_sum(s) * (1.0f / DM) + RMS_EPS); float s2 = 0.f;
#pragma unroll
            for (int j = 0; j < 2; ++j)
#pragma unroll
                for (int e = 0; e < 8; ++e) { const float hr = xv[q][j][e] + mv[q][j][e] * r1 * g1[j][e]; xv[q][j][e] = hr; s2 += hr * hr; }
            const float r2 = rsqrtf(wave_sum(s2) * (1.0f / DM) + RMS_EPS);
#pragma unroll
            for (int j = 0; j < 2; ++j) { float o[8];
#pragma unroll
                for (int e = 0; e < 8; ++e) o[e] = xv[q][j][e] * r2 * g2[j][e];
                *(v4u*)(h2 + orow * DM + 8 * lane + 512 * j) = pack8f(o); } }
    }
}

__device__ __forceinline__ void phase10(const Args& a, int gw, int NGW, int lane) {
    unsigned char* ws = a.ws; const bf16* mix = (const bf16*)(ws + WS_H); const bf16* ffn = (const bf16*)(ws + WS_MG);
    float g1[2][8], g3[2][8];
#pragma unroll
    for (int j = 0; j < 2; ++j) { load8f(a.in[I_GMIXPOST] + 8 * lane + 512 * j, g1[j]); load8f(a.in[I_GFFNPOST] + 8 * lane + 512 * j, g3[j]); }
    for (int r0 = gw; r0 < R_META; r0 += 2 * NGW) {
        float mv[2][2][8], xv[2][2][8], fv[2][2][8];
#pragma unroll
        for (int q = 0; q < 2; ++q) { const int r = (r0 + q * NGW < R_META) ? r0 + q * NGW : r0;
#pragma unroll
            for (int j = 0; j < 2; ++j) { const size_t off = (size_t)r * DM + 8 * lane + 512 * j;
                unpack8f(*(const v4u*)(mix + off), mv[q][j]); unpack8f(*(const v4u*)(ffn + off), fv[q][j]); load8f_nt(a.in[I_X] + off, xv[q][j]); } }
#pragma unroll
        for (int q = 0; q < 2; ++q) { const int r = r0 + q * NGW; if (r >= R_META) continue;
            float s = 0.f, s3 = 0.f;
#pragma unroll
            for (int j = 0; j < 2; ++j)
#pragma unroll
                for (int e = 0; e < 8; ++e) { s += mv[q][j][e] * mv[q][j][e]; s3 += fv[q][j][e] * fv[q][j][e]; }
            const float r1 = rsqrtf(wave_sum(s) * (1.0f / DM) + RMS_EPS), r3 = rsqrtf(wave_sum(s3) * (1.0f / DM) + RMS_EPS);
#pragma unroll
            for (int j = 0; j < 2; ++j) { float o[8];
#pragma unroll
                for (int e = 0; e < 8; ++e) o[e] = xv[q][j][e] + mv[q][j][e] * r1 * g1[j][e] + fv[q][j][e] * r3 * g3[j][e];
                float* op = a.out + (size_t)r * DM + 8 * lane + 512 * j;
                __builtin_nontemporal_store((f32x4){o[0], o[1], o[2], o[3]}, (f32x4*)op); __builtin_nontemporal_store((f32x4){o[4], o[5], o[6], o[7]}, (f32x4*)(op + 4)); } }
    }
}

#define XB_TMO      128
#define XB_XCNT(j)  (256  + 64 * (j))
#define XB_XSUB(j)  (1280 + 64 * (j))
#define XB_XGEN(j)  (2304 + 64 * (j))
#define XB_TOP      3328
#define XB_TOPGEN   3392
#define XCD_BAR_WORDS 3456
#define XB_SPIN_CAP (1u << 18)

__device__ __forceinline__ unsigned xb_ld(unsigned* p)              { return __hip_atomic_load(p, __ATOMIC_RELAXED, __HIP_MEMORY_SCOPE_AGENT); }
__device__ __forceinline__ unsigned xb_add(unsigned* p, unsigned v) { return __hip_atomic_fetch_add(p, v, __ATOMIC_RELAXED, __HIP_MEMORY_SCOPE_AGENT); }
__device__ __forceinline__ unsigned xb_xcc_id() { return (unsigned)__builtin_amdgcn_s_getreg((3 << 11) | 20) & 0xFu; }
#define XB_SPIN(cond, bar) do { unsigned _sp = 0; while (cond) { __builtin_amdgcn_s_sleep(1); \
    if ((++_sp & 255u) == 0u) { if (xb_ld(&(bar)[XB_TMO])) break; if (_sp > XB_SPIN_CAP) { atomicAdd(&(bar)[XB_TMO], 1u); break; } } } } while (0)

struct XcdBarrier {
    unsigned* bar; unsigned x;
    unsigned nloc, nx;
    unsigned rank;
};

__device__ __forceinline__ XcdBarrier xcd_barrier_post(unsigned* bar) {
    XcdBarrier b; b.bar = bar; b.x = xb_xcc_id(); b.nloc = 0u; b.nx = 0u;
    b.rank = 0u; if (threadIdx.x == 0) b.rank = xb_add(&bar[XB_XCNT(b.x)], 1u);
    return b;
}
__device__ __forceinline__ void xcd_barrier_complete(unsigned* bar, unsigned x, unsigned& nloc, unsigned& nx) {
    const unsigned G = gridDim.x * gridDim.y * gridDim.z;
    unsigned sum, cnt, mine, sp = 0u;
    for (;;) {
        sum = 0u; cnt = 0u; mine = 0u;
#pragma unroll
        for (unsigned j = 0; j < 16; ++j) { const unsigned c = xb_ld(&bar[XB_XCNT(j)]); sum += c; cnt += (c > 0u) ? 1u : 0u; mine = (j == x) ? c : mine; }
        if (sum == G) break;
        __builtin_amdgcn_s_sleep(1);
        if ((++sp & 255u) == 0u) { if (xb_ld(&bar[XB_TMO])) break; if (sp > XB_SPIN_CAP) { atomicAdd(&bar[XB_TMO], 1u); break; } }
    }
    nloc = mine > 0u ? mine : 1u; nx = cnt > 0u ? cnt : 1u;
}

__device__ __forceinline__ void xcd_barrier(XcdBarrier& b) {
    asm volatile("s_waitcnt vmcnt(0)" ::: "memory");
    __syncthreads();
    if (threadIdx.x == 0) {
        unsigned* bar = b.bar;
        __builtin_amdgcn_s_waitcnt(0);
        unsigned nloc = b.nloc, nx = b.nx;
        if (nloc == 0u) { xcd_barrier_complete(bar, b.x, nloc, nx); b.nloc = nloc; b.nx = nx; }
        const unsigned old = xb_add(&bar[XB_XSUB(b.x)], 1u);
        const unsigned gen = old / nloc;
        if (old + 1u == (gen + 1u) * nloc) {
            __builtin_amdgcn_fence(__ATOMIC_RELEASE, "agent");
            asm volatile("s_waitcnt vmcnt(0)" ::: "memory");
            const unsigned og = xb_add(&bar[XB_TOP], 1u);
            const unsigned tg = og / nx;
            if (og + 1u == (tg + 1u) * nx) xb_add(&bar[XB_TOPGEN], 1u);
            else XB_SPIN(xb_ld(&bar[XB_TOPGEN]) == tg, bar);
            __builtin_amdgcn_fence(__ATOMIC_ACQUIRE, "agent");
            xb_add(&bar[XB_XGEN(b.x)], 1u);
            asm volatile("s_waitcnt vmcnt(0)" ::: "memory");
        } else {
            XB_SPIN(xb_ld(&bar[XB_XGEN(b.x)]) == gen, bar);
            __builtin_amdgcn_fence(__ATOMIC_ACQUIRE, "agent");
            asm volatile("s_waitcnt vmcnt(0)" ::: "memory");
        }
    }
    __syncthreads();
}


#ifndef STAGGER_TICKS
#define STAGGER_TICKS 1000
#endif
__device__ __forceinline__ void stagger(int bx, unsigned ticks) {
    const unsigned frac = __brev((unsigned)bx) >> 24;
    const unsigned long long t0 = __builtin_amdgcn_s_memrealtime(), dt = (unsigned long long)ticks * frac / 256;
    while (__builtin_amdgcn_s_memrealtime() - t0 < dt) __builtin_amdgcn_s_sleep(8);
}

constexpr int N_PHASES = 11;
__global__ void __launch_bounds__(NWAVES * 64, 2) fwd_megakernel(Args args) {
    extern __shared__ __attribute__((aligned(16))) unsigned char lds_raw[];
    LAS unsigned char* lds = (LAS unsigned char*)lds_raw;
    cg::grid_group grid = cg::this_grid();
    const int tid = threadIdx.x, lane = tid & 63, wave = __builtin_amdgcn_readfirstlane(tid >> 6);
    const int G = gridDim.x, bx = blockIdx.x;
    const int vcu = (G % 8 == 0) ? (bx % 8) * (G / 8) + bx / 8 : bx;
    const int gw = vcu * NWAVES + wave, NGW = G * NWAVES;
    unsigned char* ws = args.ws;
    const int lo = args.ph_lo, hi = args.ph_hi;
    unsigned* barw = (unsigned*)ws;
    if (args.ph_hi < 0) grid.sync();
    XcdBarrier xbar = xcd_barrier_post(barw);
    int vbx = bx;
    if (G == 256) { if (tid == 0) *(volatile LAS unsigned*)lds = xbar.x + 8u * xbar.rank; __syncthreads(); const unsigned v_ = *(volatile LAS unsigned*)lds; __syncthreads(); if (v_ < 256u) vbx = (int)v_; }
#ifndef PHASE_MASK
#define PHASE_MASK 0x7ff
#endif
#define IN(k) (((PHASE_MASK >> (k)) & 1) && lo <= (k) && (k) < hi)
#define SEAM(k) do { if ((k) + 1 < hi) xcd_barrier(xbar); } while (0)
    using namespace pg8;
    if (IN(0)) { phase0(args, lds, gw, NGW, wave, lane);
        SEAM(0); }
    if (IN(1)) {
        Gemm g{(const bf16_t*)(ws + WS_H), (const bf16_t*)(ws + WS_WIN), DM}; Order S; S.init(256, 0, -1, INC / 256, G, vbx);
        p1_meta(args, gw, NGW, lane);
        EpiProj E{(bf16_t*)(ws + WS_PROJ), args.in[I_BGATES]};
        gemm_phase<EpiProj, Order>(lds, g, S, E); SEAM(1); }
    if (IN(2)) { phase2(args, lds, gw, NGW, wave, lane);
        SEAM(2); }
    if (IN(3)) {
        dft_tail(args, gw, NGW, lane);
        Gemm g{(const bf16_t*)((unsigned char*)args.out + DO_DM), (const bf16_t*)((unsigned char*)args.out + DO_UT), KD}; OrderDft S; S.init(G, vbx);
        EpiDft E{(bf16_t*)((unsigned char*)args.out + DO_S)};
        gemm_phase<EpiDft, OrderDft>(lds, g, S, E);
        xcd_barrier(xbar);
        dft_combine(args, gw, NGW, lane); SEAM(3); }
    if (IN(4)) {
        Gemm g{(const bf16_t*)(ws + WS_F), (const bf16_t*)(ws + WS_WEFF), DM}; Order S; S.init(256, 0, -1, DM / 256, G, vbx);
        p4_edge(args, gw, lane);
        EpiYa E{(bf16_t*)(ws + WS_MG), (const bf16_t*)(ws + WS_PROJ)};
        gemm_phase<EpiYa, Order>(lds, g, S, E); }
    if (IN(5)) {
        Gemm g{(const bf16_t*)(ws + WS_ZB), (const bf16_t*)(ws + WS_WCO), 512}; Order S; S.init(256, 0, -1, DM / 256, G, vbx);
        EpiYb E{(bf16_t*)(ws + WS_MG), (const bf16_t*)(ws + WS_PROJ)};
        gemm_phase<EpiYb, Order>(lds, g, S, E); SEAM(5); }
    if (IN(6)) {
        Gemm g{(const bf16_t*)(ws + WS_MG), (const bf16_t*)(ws + WS_WOUT), DM}; Order S; S.init(256, 0, -1, DM / 256, G, vbx);
        edge_gemm((const bf16*)(ws + WS_MG), (const bf16*)(ws + WS_WOUT), DM, (bf16*)(ws + WS_H), DM, EDGE_ROW0, NMETA, gw, NGW, lane);
        EpiStore E{(bf16_t*)(ws + WS_H), DM, 0, -1, 0};
        gemm_phase<EpiStore, Order>(lds, g, S, E); SEAM(6); }
    if (IN(7)) { phase6(args, gw, NGW, lane);
        SEAM(7); }
    if (IN(8)) {
        Gemm g{(const bf16_t*)(ws + WS_H2), (const bf16_t*)(ws + WS_WUP), DM}; OrderFfn S; S.init(NB * FFN_TPB, 0, -1, 2 * DFF / 256, G, vbx);
        EpiFfn E{(bf16_t*)(ws + WS_ACT), args.in[I_CWFFN], args.in[I_CBFFN], lds + STAGE_BYTES};
        gemm_phase<EpiFfn, OrderFfn>(lds, g, S, E); SEAM(8); }
    if (IN(9)) {
        Gemm g{(const bf16_t*)(ws + WS_ACT), (const bf16_t*)(ws + WS_WDN), DFF}; Order S; S.init(256, 0, -1, DM / 256, G, vbx);
        EpiStore E{(bf16_t*)(ws + WS_MG), DM, 0, -1, 0};
        gemm_phase<EpiStore, Order>(lds, g, S, E); SEAM(9); }
    if (IN(10)) { phase10(args, gw, NGW, lane);
    }
#undef IN
#undef SEAM
}

extern "C" void kernel_launch(void* const* d_in, const int* in_sizes, int n_in, void* d_out, int out_size, void* d_ws, size_t ws_size, hipStream_t stream) {
    static int grid = 0;
    if (grid == 0) {
        if (n_in != 17 || ws_size < WS_NEED || out_size != NB * SEQ * DM) { fprintf(stderr, "kernel_launch: unexpected problem (n_in %d, ws %zu, out %d)\n", n_in, ws_size, out_size); grid = -1; return; }
        int dev = 0, cus = 0, per_cu = 0;
        if (hipGetDevice(&dev) != hipSuccess || hipDeviceGetAttribute(&cus, hipDeviceAttributeMultiprocessorCount, dev) != hipSuccess) { grid = -1; return; }
        if (hipFuncSetAttribute((const void*)fwd_megakernel, hipFuncAttributeMaxDynamicSharedMemorySize, LDS_BYTES) != hipSuccess) { fprintf(stderr, "kernel_launch: hipFuncSetAttribute failed\n"); grid = -1; return; }
        if (hipOccupancyMaxActiveBlocksPerMultiprocessor(&per_cu, (const void*)fwd_megakernel, NWAVES * 64, LDS_BYTES) != hipSuccess || per_cu < 1) { fprintf(stderr, "kernel_launch: occupancy query says %d\n", per_cu); per_cu = 1; }
        (void)hipGetLastError();
        grid = cus * 1;
    }
    if (grid < 0) return;
    if (hipMemsetAsync(d_ws, 0, 16384, stream) != hipSuccess) { fprintf(stderr, "kernel_launch: memset of the barrier words failed\n"); return; }
    Args a{};
    for (int i = 0; i < 17; ++i) a.in[i] = (const float*)d_in[i];
    a.out = (float*)d_out; a.ws = (unsigned char*)d_ws; a.ph_lo = 0; a.ph_hi = N_PHASES;
    void* kargs[] = {&a};
    hipError_t e = hipLaunchCooperativeKernel((const void*)fwd_megakernel, dim3(grid), dim3(NWAVES * 64), kargs, LDS_BYTES, stream);
    if (e != hipSuccess) fprintf(stderr, "kernel_launch: cooperative launch failed: %s (grid %d)\n", hipGetErrorString(e), grid);
}
```

```cpp
#include <hip/hip_runtime.h>
#include <hip/hip_cooperative_groups.h>
#include <cstdio>
#include <cstdint>
namespace cg = cooperative_groups;

constexpr int NB = 8, SEQ = 8192, NMETA = 16, LSEQ = 8208, DM = 1024, DFF = 2816, INC = 4096;
constexpr int R_META = 65536, R_TOT = 65792;
constexpr int NHALF = LSEQ / 2;
constexpr int QL = LSEQ / 4, QH = QL / 2;
constexpr int KD = 1152;
constexpr int KH = 1280, KHT = 5;
constexpr int NCOL = 4 * 4096;
constexpr float RMS_EPS = 1e-6f;
__device__ __forceinline__ int row_of(int b, int pos) { return pos >= NMETA ? b * SEQ + pos - NMETA : R_META + b * NMETA + pos; }

namespace pg8 {
#define PG8_LAS __attribute__((address_space(3)))
typedef unsigned short bf16_t;
typedef short bf16x8 __attribute__((ext_vector_type(8)));
typedef float f32x4 __attribute__((ext_vector_type(4)));
typedef unsigned u32x4 __attribute__((ext_vector_type(4)));
constexpr int BM = 256, BK = 64, HALF = 128, HTB = HALF * BK * 2, STAGE_BYTES = 8 * HTB, NXCD = 8, WGM = 8;

__host__ __device__ __forceinline__ int lds_byte(int r, int c) { const int st = (r >> 4) * 2 + (c >> 5), rr = r & 15, cc = c & 31, ob = rr * 64 + cc * 2; return st * 1024 + (ob ^ (((ob >> 9) & 1) << 5)); }
__host__ __device__ __forceinline__ void stage_rc(int b, int& R, int& C) { const int st = b / 1024, sb = b % 1024, swz = sb ^ (((sb >> 9) & 1) << 5); R = (st >> 1) * 16 + swz / 64; C = (st & 1) * 32 + (swz % 64) / 2; }
__host__ __device__ __forceinline__ int perm32(int rho) { const int n = rho >> 4, i = rho & 15; return 8 * (i >> 2) + 4 * n + (i & 3); }

struct Unit { int pm, pn, arow; };
struct Gemm { const bf16_t* A; const bf16_t* Bt; int K; };

struct Order {
    int nM, nN, nwg, G, c, pm0, nMain, pm_extra;
    __device__ void init(int nMain_, int pm0_, int pm_extra_, int nN_, int G_, int c_) { nMain = nMain_; pm0 = pm0_; pm_extra = pm_extra_; nM = nMain_ + (pm_extra_ >= 0 ? 1 : 0); nN = nN_; nwg = nM * nN; G = G_; c = c_; }
    __device__ bool next(int i, Unit& u) const {
        const long L = (long)i * G + c; if (L >= nwg) return false;
        int wgid = (int)L; { const int q = nwg / NXCD, r = nwg % NXCD, xcd = wgid % NXCD, off = wgid / NXCD; wgid = (xcd < r ? xcd * (q + 1) : r * (q + 1) + (xcd - r) * q) + off; }
        const int nig = WGM * nN, gid = wgid / nig, fm = gid * WGM, gsz = (nM - fm) < WGM ? (nM - fm) : WGM;
        const int t = fm + ((wgid % nig) % gsz); u.pm = (t < nMain) ? pm0 + t : pm_extra; u.pn = (wgid % nig) / gsz; u.arow = u.pm * BM; return true;
    }
    __device__ __forceinline__ void a_ready(const Unit&) const {}
    __device__ __forceinline__ void done(const Unit&) const {}
};
struct OrderDft {
    int G, c;
    __device__ void init(int G_, int c_) { G = G_; c = c_; }
    __device__ bool next(int i, Unit& u) const {
        constexpr int nM = 8, nN = 64, nwg = nM * nN;
        const long L = (long)i * G + c; if (L >= nwg) return false;
        int wgid = (int)L; { const int q = nwg / NXCD, xcd = wgid % NXCD, off = wgid / NXCD; wgid = xcd * q + off; }
        const int t = wgid & 7, pn = wgid >> 3, part = t >> 2;
        u.pm = part * KHT + (t & 3); u.pn = part * 64 + pn; u.arow = u.pm * BM; return true;
    }
    __device__ __forceinline__ void a_ready(const Unit&) const {}
    __device__ __forceinline__ void done(const Unit&) const {}
};
constexpr int H2F_PITCH = 8448, FFN_TPB = 33, FFN_STEP = 254;
struct OrderFfn : Order {
    __device__ bool next(int i, Unit& u) const { if (!Order::next(i, u)) return false; const int b = u.pm / FFN_TPB, t = u.pm - b * FFN_TPB; u.arow = b * H2F_PITCH + FFN_STEP * t; return true; }
};
__device__ __forceinline__ unsigned cvt_pk_bf16(float lo, float hi) { unsigned r; asm volatile("v_cvt_pk_bf16_f32 %0, %1, %2" : "=v"(r) : "v"(lo), "v"(hi)); return r; }
__device__ __forceinline__ u32x4 pack8(const f32x4 v0, const f32x4 v1) { u32x4 w; w.x = cvt_pk_bf16(v0[0], v0[1]); w.y = cvt_pk_bf16(v0[2], v0[3]); w.z = cvt_pk_bf16(v1[0], v1[1]); w.w = cvt_pk_bf16(v1[2], v1[3]); return w; }
__device__ __forceinline__ float bflo(unsigned w) { return __uint_as_float(w << 16); }
__device__ __forceinline__ float bfhi(unsigned w) { return __uint_as_float(w & 0xffff0000u); }
__device__ __forceinline__ void unpack8(const u32x4 w, f32x4& v0, f32x4& v1) { v0 = (f32x4){bflo(w.x), bfhi(w.x), bflo(w.y), bfhi(w.y)}; v1 = (f32x4){bflo(w.z), bfhi(w.z), bflo(w.w), bfhi(w.w)}; }
__device__ __forceinline__ float sigmoidf_(float x) { return __builtin_amdgcn_rcpf(1.0f + __expf(-x)); }
#define EPI_LOOP_AM _Pragma("unroll") for (int ai = 0; ai < 2; ++ai) _Pragma("unroll") for (int m = 0; m < 4; ++m)
#define EPI_LOOP_BJ _Pragma("unroll") for (int bj = 0; bj < 2; ++bj)
typedef const f32x4 (&AccT)[2][2][4][2];

struct EpiProj { static constexpr bool PERM = true, AFTER_DRAIN = false, RPT = true;
    bf16_t* P; const float* bg;
    __device__ __forceinline__ void operator()(AccT acc, const Unit& u, int wr, int wc, int fr, int fq) const {
        const int row0 = u.pm * BM + wr * 64 + fr, colt = u.pn * BM + wc * 32 + 8 * fq;
        const bool gate = u.pn >= 8;
        f32x4 bv[2][2];
        EPI_LOOP_BJ { _Pragma("unroll") for (int n = 0; n < 2; ++n) bv[bj][n] = gate ? *(const f32x4*)(bg + (colt - 2048) + bj * HALF + 4 * n) : (f32x4){0.f, 0.f, 0.f, 0.f}; }
        EPI_LOOP_AM { bf16_t* rowp = P + (size_t)(row0 + ai * HALF + m * 16) * INC + colt;
            EPI_LOOP_BJ { f32x4 v0 = acc[ai][bj][m][0] + bv[bj][0], v1 = acc[ai][bj][m][1] + bv[bj][1];
                if (gate) { _Pragma("unroll") for (int j = 0; j < 4; ++j) { v0[j] = sigmoidf_(v0[j]); v1[j] = sigmoidf_(v1[j]); } }
                *(u32x4*)(rowp + bj * HALF) = pack8(v0, v1); } }
    }
};
struct EpiDft { static constexpr bool PERM = true, AFTER_DRAIN = false, RPT = true;
    bf16_t* S;
    __device__ __forceinline__ void operator()(AccT acc, const Unit& u, int wr, int wc, int fr, int fq) const {
        const int part = u.pm / KHT, kt = u.pm - part * KHT;
        const int row0 = part * KH + kt * BM + wr * 64 + fr, colt = (u.pn & 63) * BM + wc * 32 + 8 * fq;
        EPI_LOOP_AM { bf16_t* rowp = S + (size_t)(row0 + ai * HALF + m * 16) * NCOL + colt;
            EPI_LOOP_BJ { *(u32x4*)(rowp + bj * HALF) = pack8(acc[ai][bj][m][0], acc[ai][bj][m][1]); } }
    }
};
struct EpiYa { static constexpr bool PERM = true, AFTER_DRAIN = false, RPT = true;
    bf16_t* Mg; const bf16_t* P;
    __device__ __forceinline__ void operator()(AccT acc, const Unit& u, int wr, int wc, int fr, int fq) const {
        const int row0 = u.pm * BM + wr * 64 + fr, colt = u.pn * BM + wc * 32 + 8 * fq;
        EPI_LOOP_AM { const size_t row = (size_t)(row0 + ai * HALF + m * 16);
            EPI_LOOP_BJ { const u32x4 gw = *(const u32x4*)(P + row * INC + 2048 + colt + bj * HALF); f32x4 g0, g1; unpack8(gw, g0, g1);
                *(u32x4*)(Mg + row * DM + colt + bj * HALF) = pack8(acc[ai][bj][m][0] * g0, acc[ai][bj][m][1] * g1); }
            asm volatile("" ::: "memory"); }
    }
};
struct EpiYb { static constexpr bool PERM = true, AFTER_DRAIN = false, RPT = false;
    bf16_t* Mg; const bf16_t* P;
    __device__ __forceinline__ void operator()(AccT acc, const Unit& u, int wr, int wc, int fr, int fq) const {
        const int row0 = u.pm * BM + wr * 64 + fr, colt = u.pn * BM + wc * 32 + 8 * fq;
        EPI_LOOP_AM { const size_t row = (size_t)(row0 + ai * HALF + m * 16);
            EPI_LOOP_BJ { const u32x4 gw = *(const u32x4*)(P + row * INC + 3072 + colt + bj * HALF); f32x4 g0, g1; unpack8(gw, g0, g1);
                const u32x4 tw = *(const u32x4*)(Mg + row * DM + colt + bj * HALF); f32x4 t0, t1; unpack8(tw, t0, t1);
                *(u32x4*)(Mg + row * DM + colt + bj * HALF) = pack8(t0 + acc[ai][bj][m][0] * g0, t1 + acc[ai][bj][m][1] * g1); }
            asm volatile("" ::: "memory"); }
    }
};
struct EpiStore { static constexpr bool PERM = true, AFTER_DRAIN = false, RPT = true;
    bf16_t* O; int ldc, pm0, pm_extra, extra_local;
    __device__ __forceinline__ void operator()(AccT acc, const Unit& u, int wr, int wc, int fr, int fq) const {
        const int lt = (u.pm == pm_extra) ? extra_local : u.pm - pm0;
        const int row0 = lt * BM + wr * 64 + fr, colt = u.pn * BM + wc * 32 + 8 * fq;
        EPI_LOOP_AM { bf16_t* rowp = O + (size_t)(row0 + ai * HALF + m * 16) * ldc + colt;
            EPI_LOOP_BJ { *(u32x4*)(rowp + bj * HALF) = pack8(acc[ai][bj][m][0], acc[ai][bj][m][1]); } }
    }
};
struct EpiF32 { static constexpr bool PERM = false, AFTER_DRAIN = false, RPT = true;
    float* C; int ldc, tile_off;
    __device__ __forceinline__ void operator()(AccT acc, const Unit& u, int wr, int wc, int fr, int fq) const {
        const int row0 = (u.pm + tile_off) * BM + wr * 64 + fr, col0 = u.pn * BM + wc * 32 + 4 * fq;
        EPI_LOOP_AM { float* rowp = C + (size_t)(row0 + ai * HALF + m * 16) * ldc + col0;
            EPI_LOOP_BJ { _Pragma("unroll") for (int n = 0; n < 2; ++n) *(f32x4*)(rowp + bj * HALF + n * 16) = acc[ai][bj][m][n]; } }
    }
};

struct EpiFfn { static constexpr bool PERM = true, AFTER_DRAIN = false, RPT = true;
    bf16_t* act; const float* cw; const float* cb; PG8_LAS unsigned char* slab;
    typedef unsigned u32x2 __attribute__((ext_vector_type(2)));
    __device__ __forceinline__ static f32x4 up4(const u32x2 w) { return (f32x4){bflo(w.x), bfhi(w.x), bflo(w.y), bfhi(w.y)}; }
    __device__ __forceinline__ void operator()(AccT acc, const Unit& u, int wr, int wc, int fr, int fq) const {
        const int tid = threadIdx.x, cg8 = tid & 7, rrow = tid >> 3, chunk = cg8 >> 1, hoff = (cg8 & 1) * 8;
        const int b = u.pm / FFN_TPB, t = u.pm - b * FFN_TPB;
#pragma unroll 1
        for (int s = 0; s < 4; ++s) {
            if (wc == s) {
                EPI_LOOP_AM { const int row = ai * HALF + wr * 64 + m * 16 + fr; PG8_LAS unsigned char* rp = slab + row * 128;
                    *(PG8_LAS u32x4*)(rp + ((fq ^ (row & 7)) << 4)) = pack8(acc[ai][0][m][0], acc[ai][0][m][1]);
                    *(PG8_LAS u32x4*)(rp + (((4 + fq) ^ (row & 7)) << 4)) = pack8(acc[ai][1][m][0], acc[ai][1][m][1]); } }
            asm volatile("s_waitcnt lgkmcnt(0)" ::: "memory"); __builtin_amdgcn_s_barrier(); asm volatile("" ::: "memory");
            const int j0 = u.pn * HALF + s * 32 + cg8 * 4;
            const f32x4 ka0 = *(const f32x4*)(cw + j0), ka1 = *(const f32x4*)(cw + 2 * DFF + j0), ka2 = *(const f32x4*)(cw + 4 * DFF + j0), kab = *(const f32x4*)(cb + j0);
            const f32x4 kv0 = *(const f32x4*)(cw + DFF + j0), kv1 = *(const f32x4*)(cw + 3 * DFF + j0), kv2 = *(const f32x4*)(cw + 5 * DFF + j0), kvb = *(const f32x4*)(cb + DFF + j0);
#pragma unroll 1
            for (int i2 = 0; i2 < 4; ++i2) { const int row = rrow + 64 * i2, iloc = FFN_STEP * t + row;
                if (row >= 1 && row <= 254 && iloc <= SEQ) {
                    const PG8_LAS unsigned char* p0 = slab + (row - 1) * 128 + hoff; const PG8_LAS unsigned char* p1 = p0 + 128; const PG8_LAS unsigned char* p2 = p1 + 128;
                    const int s0 = (row - 1) & 7, s1 = row & 7, s2 = (row + 1) & 7;
                    const f32x4 a0 = up4(*(const PG8_LAS u32x2*)(p0 + ((chunk ^ s0) << 4))), a1 = up4(*(const PG8_LAS u32x2*)(p1 + ((chunk ^ s1) << 4))), a2 = up4(*(const PG8_LAS u32x2*)(p2 + ((chunk ^ s2) << 4)));
                    const f32x4 v0 = up4(*(const PG8_LAS u32x2*)(p0 + (((4 + chunk) ^ s0) << 4))), v1 = up4(*(const PG8_LAS u32x2*)(p1 + (((4 + chunk) ^ s1) << 4))), v2 = up4(*(const PG8_LAS u32x2*)(p2 + (((4 + chunk) ^ s2) << 4)));
                    const f32x4 ca = kab + ka0 * a0 + ka1 * a1 + ka2 * a2, cv = kvb + kv0 * v0 + kv1 * v1 + kv2 * v2;
                    f32x4 o;
#pragma unroll
                    for (int e = 0; e < 4; ++e) { const float x = ca[e]; const float z2 = 1.5957691216057308f * (x + 0.044715f * x * x * x); o[e] = x * __builtin_amdgcn_rcpf(1.0f + __expf(-z2)) * cv[e]; }
                    u32x2 w; w.x = cvt_pk_bf16(o[0], o[1]); w.y = cvt_pk_bf16(o[2], o[3]);
                    *(u32x2*)(act + (size_t)(b * SEQ + iloc - 1) * DFF + j0) = w;
                } }
            asm volatile("s_waitcnt lgkmcnt(0)" ::: "memory"); __builtin_amdgcn_s_barrier(); asm volatile("" ::: "memory");
        }
    }
};

template <class Epi, class Sched, bool ALIGN_EPI = true, bool SP2 = true>
__device__ __forceinline__ void gemm_phase(PG8_LAS unsigned char* lds, const Gemm g, const Sched& S, const Epi& E) {
    const int tid = threadIdx.x, wid = __builtin_amdgcn_readfirstlane(tid >> 6), lane = tid & 63, wr = wid >> 2, wc = wid & 3, fr = lane & 15, fq = lane >> 4;
    const int K = g.K, nt = K / BK;
    unsigned voffA[2], voffB[2];
#pragma unroll
    for (int i = 0; i < 2; ++i) { int R, C; stage_rc(tid * 16 + i * 8192, R, C); const int Rb = Epi::PERM ? ((R & ~31) + perm32(R & 31)) : R;
        voffA[i] = (unsigned)(R * K + C) * 2u; voffB[i] = (unsigned)(Rb * K + C) * 2u; }
    const size_t kstep = (size_t)(BK * 2);
    const size_t hstep = (size_t)HALF * K * 2;
    const size_t tstep = 2 * hstep;
    const unsigned ldsw = (unsigned)wid * 1024u;
    const int aoff = lds_byte(wr * 64 + fr, fq * 8), boff = lds_byte(wc * 32 + fr, fq * 8);
#define PG8_SA(b, h) (((b) * 2 + (h)) * HTB)
#define PG8_SB(b, h) ((4 + (b) * 2 + (h)) * HTB)
#define PG8_STAGE(bufoff, gbase, voff) do { _Pragma("unroll") for (int _i = 0; _i < 2; ++_i) \
        __builtin_amdgcn_global_load_lds((const unsigned*)((const char*)(gbase) + (voff)[_i]), (PG8_LAS unsigned*)(lds + (bufoff) + ldsw + _i * 8192), 16, 0, 0); } while (0)
#define PG8_LDA(dst, b, h) do { _Pragma("unroll") for (int m = 0; m < 4; ++m) _Pragma("unroll") for (int k = 0; k < 2; ++k) dst[m][k] = *(const PG8_LAS bf16x8*)(lds + PG8_SA(b, h) + aoff + m * 2048 + k * 1024); } while (0)
#define PG8_LDB(dst, b, h) do { _Pragma("unroll") for (int n = 0; n < 2; ++n) _Pragma("unroll") for (int k = 0; k < 2; ++k) dst[n][k] = *(const PG8_LAS bf16x8*)(lds + PG8_SB(b, h) + boff + n * 2048 + k * 1024); } while (0)
#define PG8_MMA(ai, bj, At, Bt) do { __builtin_amdgcn_s_setprio(1); _Pragma("unroll") for (int m = 0; m < 4; ++m) _Pragma("unroll") for (int n = 0; n < 2; ++n) _Pragma("unroll") for (int k = 0; k < 2; ++k) \
        acc[ai][bj][m][n] = __builtin_amdgcn_mfma_f32_16x16x32_bf16(Bt[n][k], At[m][k], acc[ai][bj][m][n], 0, 0, 0); __builtin_amdgcn_s_setprio(0); } while (0)
#define PG8_WAIT_V(n) asm volatile("s_waitcnt vmcnt(" #n ")" ::: "memory")
#define PG8_WAIT_L(n) asm volatile("s_waitcnt lgkmcnt(" #n ")" ::: "memory")
#define PG8_BAR __builtin_amdgcn_s_barrier()
#define PG8_SCHED __builtin_amdgcn_sched_barrier(0)
    Unit cur, nxt; int ui = 0;
    if (!S.next(0, cur)) return;
    f32x4 acc[2][2][4][2];
#pragma unroll
    for (int a = 0; a < 2; ++a)
#pragma unroll
        for (int b = 0; b < 2; ++b)
#pragma unroll
            for (int m = 0; m < 4; ++m)
#pragma unroll
                for (int n = 0; n < 2; ++n) acc[a][b][m][n] = (f32x4){0.f, 0.f, 0.f, 0.f};
    bf16x8 At[4][2], B0[2][2], B1[2][2];
    const size_t rowb = (size_t)K * 2; const char* cA = (const char*)g.A + (size_t)cur.arow * rowb; const char* cB = (const char*)g.Bt + (size_t)cur.pn * tstep;
    S.a_ready(cur);
    if constexpr (SP2) {
        PG8_STAGE(PG8_SB(0, 0), cB, voffB); PG8_STAGE(PG8_SB(0, 1), cB + hstep, voffB); PG8_STAGE(PG8_SA(0, 0), cA, voffA); PG8_STAGE(PG8_SA(0, 1), cA + hstep, voffA);
        if (wr == 1) PG8_BAR;
        PG8_WAIT_V(2); PG8_BAR;
        PG8_STAGE(PG8_SB(1, 0), cB + kstep, voffB); PG8_STAGE(PG8_SA(1, 0), cA + kstep, voffA); PG8_STAGE(PG8_SB(1, 1), cB + hstep + kstep, voffB);
        PG8_WAIT_V(6); PG8_BAR;
    } else {
        PG8_STAGE(PG8_SB(0, 0), cB, voffB); PG8_STAGE(PG8_SA(0, 0), cA, voffA); PG8_STAGE(PG8_SB(0, 1), cB + hstep, voffB); PG8_STAGE(PG8_SA(0, 1), cA + hstep, voffA);
        if (wr == 1) PG8_BAR;
        PG8_WAIT_V(4); PG8_BAR;
        PG8_STAGE(PG8_SB(1, 0), cB + kstep, voffB); PG8_STAGE(PG8_SA(1, 0), cA + kstep, voffA); PG8_STAGE(PG8_SB(1, 1), cB + hstep + kstep, voffB);
        PG8_WAIT_V(6); PG8_BAR;
    }
    for (;;) {
        const bool has_next = S.next(ui + 1, nxt);
        const char* nA = has_next ? (const char*)g.A + (size_t)nxt.arow * rowb : cA; const char* nB = has_next ? (const char*)g.Bt + (size_t)nxt.pn * tstep : cB;
        for (int t = 0; t < nt; t += 2) {
            const bool last = (t == nt - 2);
            const char* a1 = cA + (size_t)(t + 1) * kstep;
            const char* a2 = last ? nA : cA + (size_t)(t + 2) * kstep; const char* b2 = last ? nB : cB + (size_t)(t + 2) * kstep;
            const char* a3 = a2 + kstep; const char* b3 = b2 + kstep;
            if (last && has_next) S.a_ready(nxt);
            if constexpr (SP2) {
            PG8_LDB(B0, 0, 0); PG8_LDB(B1, 0, 1); PG8_SCHED; PG8_LDA(At, 0, 0); PG8_STAGE(PG8_SA(1, 1), a1 + hstep, voffA);
            PG8_WAIT_V(8); PG8_WAIT_L(0); PG8_BAR; PG8_MMA(0, 0, At, B0); PG8_MMA(0, 1, At, B1); PG8_BAR; PG8_SCHED;
            PG8_LDA(At, 0, 1); PG8_STAGE(PG8_SB(0, 0), b2, voffB); PG8_STAGE(PG8_SB(0, 1), b2 + hstep, voffB); PG8_STAGE(PG8_SA(0, 0), a2, voffA);
            PG8_WAIT_V(8); PG8_WAIT_L(0); PG8_BAR; PG8_MMA(1, 0, At, B0); PG8_MMA(1, 1, At, B1); PG8_BAR; PG8_SCHED;
            PG8_LDB(B0, 1, 0); PG8_LDB(B1, 1, 1); PG8_SCHED; PG8_LDA(At, 1, 0); PG8_STAGE(PG8_SA(0, 1), a2 + hstep, voffA);
            PG8_WAIT_V(8); PG8_WAIT_L(0); PG8_BAR; PG8_MMA(0, 0, At, B0); PG8_MMA(0, 1, At, B1); PG8_BAR; PG8_SCHED;
            PG8_LDA(At, 1, 1); PG8_STAGE(PG8_SB(1, 0), b3, voffB); PG8_STAGE(PG8_SB(1, 1), b3 + hstep, voffB); PG8_STAGE(PG8_SA(1, 0), a3, voffA);
            PG8_WAIT_V(8); PG8_WAIT_L(0); PG8_BAR; PG8_MMA(1, 0, At, B0); PG8_MMA(1, 1, At, B1); PG8_BAR; PG8_SCHED;
            } else {
            PG8_LDB(B0, 0, 0); PG8_SCHED; PG8_LDA(At, 0, 0); PG8_STAGE(PG8_SA(1, 1), a1 + hstep, voffA);
            PG8_WAIT_L(8); PG8_BAR; PG8_WAIT_L(0); PG8_MMA(0, 0, At, B0); PG8_BAR; PG8_SCHED;
            PG8_LDB(B1, 0, 1); PG8_STAGE(PG8_SB(0, 0), b2, voffB);
            PG8_BAR; PG8_WAIT_L(0); PG8_MMA(0, 1, At, B1); PG8_BAR;
            PG8_LDA(At, 0, 1); PG8_STAGE(PG8_SA(0, 0), a2, voffA);
            PG8_BAR; PG8_WAIT_L(0); PG8_MMA(1, 0, At, B0); PG8_BAR; PG8_SCHED;
            PG8_STAGE(PG8_SB(0, 1), b2 + hstep, voffB);
            PG8_WAIT_V(6); PG8_BAR; PG8_MMA(1, 1, At, B1); PG8_BAR;
            PG8_LDB(B0, 1, 0); PG8_SCHED; PG8_LDA(At, 1, 0); PG8_STAGE(PG8_SA(0, 1), a2 + hstep, voffA);
            PG8_WAIT_L(8); PG8_BAR; PG8_WAIT_L(0); PG8_MMA(0, 0, At, B0); PG8_BAR; PG8_SCHED;
            PG8_LDB(B1, 1, 1); PG8_STAGE(PG8_SB(1, 0), b3, voffB);
            PG8_BAR; PG8_WAIT_L(0); PG8_MMA(0, 1, At, B1); PG8_BAR;
            PG8_LDA(At, 1, 1); PG8_STAGE(PG8_SA(1, 0), a3, voffA);
            PG8_BAR; PG8_WAIT_L(0); PG8_MMA(1, 0, At, B0); PG8_BAR; PG8_SCHED;
            PG8_STAGE(PG8_SB(1, 1), b3 + hstep, voffB);
            PG8_WAIT_V(6); PG8_BAR; PG8_MMA(1, 1, At, B1); PG8_BAR;
            }
        }
        if constexpr (ALIGN_EPI) { if (wr == 0) PG8_BAR; }
        if constexpr (!Epi::AFTER_DRAIN) { E(acc, cur, wr, wc, fr, fq);
            S.done(cur); }
        if (!has_next) break;
#pragma unroll
        for (int a = 0; a < 2; ++a)
#pragma unroll
            for (int b = 0; b < 2; ++b)
#pragma unroll
                for (int m = 0; m < 4; ++m)
#pragma unroll
                    for (int n = 0; n < 2; ++n) acc[a][b][m][n] = (f32x4){0.f, 0.f, 0.f, 0.f};
        cur = nxt; cA = nA; cB = nB; ++ui;
        if constexpr (ALIGN_EPI) { if (wr == 1) PG8_BAR; }
    }
    PG8_WAIT_V(0);
    if constexpr (!ALIGN_EPI) { if (wr == 0) PG8_BAR; }
    PG8_BAR;
    if constexpr (Epi::AFTER_DRAIN) { E.fused(acc, cur, wr, wc, fr, fq, lds, wid, lane); S.done(cur); }
#undef PG8_SA
#undef PG8_SB
#undef PG8_STAGE
#undef PG8_LDA
#undef PG8_LDB
#undef PG8_MMA
#undef PG8_WAIT_V
#undef PG8_WAIT_L
#undef PG8_BAR
#undef PG8_SCHED
}
}

constexpr int NWAVES = 8;
constexpr int LDS_BYTES = 163840;
constexpr size_t MiB = 1u << 20;
constexpr size_t WS_WIN = 1 * MiB, WS_WEFF = 9 * MiB, WS_WCO = 11 * MiB, WS_WOUT = 12 * MiB, WS_WUP = 14 * MiB, WS_WDN = 25 * MiB;
constexpr size_t WS_H = 32 * MiB;
constexpr size_t WS_PROJ = 161 * MiB;
constexpr size_t WS_H2 = 161 * MiB;
constexpr size_t WS_ACT = 300 * MiB;
constexpr size_t WS_ZB = 675 * MiB;
constexpr size_t WS_F = 740 * MiB;
constexpr size_t WS_MG = 869 * MiB;
constexpr size_t WS_NEED = 1000 * MiB;
constexpr size_t DO_DM = 0, DO_UT = 8 * MiB, DO_S = 96 * MiB;
static_assert((size_t)2 * KH * KD * 2 <= DO_UT && DO_UT + (size_t)2 * NCOL * KD * 2 <= DO_S && DO_S + (size_t)2 * KH * NCOL * 2 <= 256 * MiB, "d_out scratch map");
static_assert(WS_H + (size_t)R_TOT * DM * 2 <= WS_PROJ && WS_PROJ + (size_t)R_TOT * INC * 2 <= WS_ZB && WS_ZB + (size_t)R_TOT * 512 * 2 <= WS_F && WS_F + (size_t)R_TOT * DM * 2 <= WS_MG && WS_MG + (size_t)R_TOT * DM * 2 <= WS_NEED, "ws map 1");
static_assert(WS_H2 + (size_t)NB * pg8::H2F_PITCH * DM * 2 <= WS_ACT && WS_ACT + (size_t)65536 * DFF * 2 <= WS_MG, "ws map 2");

#define LAS __attribute__((address_space(3)))
typedef unsigned short bf16;
typedef unsigned v4u __attribute__((ext_vector_type(4)));
typedef unsigned v2u __attribute__((ext_vector_type(2)));
typedef float f32x4 __attribute__((ext_vector_type(4)));
#define LDS_WAIT() asm volatile("s_waitcnt lgkmcnt(0)" ::: "memory")
using pg8::cvt_pk_bf16; using pg8::bflo; using pg8::bfhi;

__device__ __forceinline__ float wave_sum(float v) {
#pragma unroll
    for (int o = 1; o < 64; o <<= 1) v += __shfl_xor(v, o);
    return v;
}
__device__ __forceinline__ void unpack8f(const v4u w, float (&f)[8]) { f[0] = bflo(w.x); f[1] = bfhi(w.x); f[2] = bflo(w.y); f[3] = bfhi(w.y); f[4] = bflo(w.z); f[5] = bfhi(w.z); f[6] = bflo(w.w); f[7] = bfhi(w.w); }
__device__ __forceinline__ v4u pack8f(const float (&f)[8]) { v4u w; w.x = cvt_pk_bf16(f[0], f[1]); w.y = cvt_pk_bf16(f[2], f[3]); w.z = cvt_pk_bf16(f[4], f[5]); w.w = cvt_pk_bf16(f[6], f[7]); return w; }
__device__ __forceinline__ void load8f_nt(const float* p, float (&f)[8]) { const f32x4 a = __builtin_nontemporal_load((const f32x4*)p), b = __builtin_nontemporal_load((const f32x4*)(p + 4)); f[0] = a.x; f[1] = a.y; f[2] = a.z; f[3] = a.w; f[4] = b.x; f[5] = b.y; f[6] = b.z; f[7] = b.w; }
__device__ __forceinline__ void load8f(const float* p, float (&f)[8]) { const f32x4 a = *(const f32x4*)p, b = *(const f32x4*)(p + 4); f[0] = a.x; f[1] = a.y; f[2] = a.z; f[3] = a.w; f[4] = b.x; f[5] = b.y; f[6] = b.z; f[7] = b.w; }

struct Args { const float* in[17]; float* out; unsigned char* ws; int ph_lo, ph_hi; };
enum { I_X = 0, I_META, I_GMIXPRE, I_WIN, I_BGATES, I_WFOURIER, I_CWMIX, I_CBMIX, I_WCONVOUT, I_WOUT, I_GMIXPOST, I_GFFNPRE, I_WUP, I_CWFFN, I_CBFFN, I_WDOWN, I_GFFNPOST };

__device__ __forceinline__ void p0_transpose_item(const float* __restrict__ W, int K, int N, bf16* __restrict__ WT, int k0, int n0, int drow0, LAS float* scr, int lane) {
    f32x4 tv[8];
#pragma unroll
    for (int i = 0; i < 8; ++i) tv[i] = *(const f32x4*)(W + (size_t)(k0 + i * 8 + (lane >> 3)) * N + n0 + 4 * (lane & 7));
#pragma unroll
    for (int i = 0; i < 8; ++i) { LAS float* d = scr + (i * 8 + (lane >> 3)) * 33 + 4 * (lane & 7); d[0] = tv[i].x; d[1] = tv[i].y; d[2] = tv[i].z; d[3] = tv[i].w; }
    LDS_WAIT();
    const int c = lane & 7;
#pragma unroll
    for (int j = 0; j < 4; ++j) { const int n = (lane >> 3) + 8 * j; const LAS float* s = scr + (8 * c) * 33 + n;
        v4u o; o.x = cvt_pk_bf16(s[0 * 33], s[1 * 33]); o.y = cvt_pk_bf16(s[2 * 33], s[3 * 33]); o.z = cvt_pk_bf16(s[4 * 33], s[5 * 33]); o.w = cvt_pk_bf16(s[6 * 33], s[7 * 33]);
        *(v4u*)(WT + (size_t)(drow0 + n) * K + k0 + 8 * c) = o; }
    LDS_WAIT();
}
__device__ __forceinline__ int wup_drow(int n0) { return n0 < DFF ? 256 * (n0 >> 7) + (n0 & 127) : 256 * ((n0 - DFF) >> 7) + 128 + ((n0 - DFF) & 127); }

__device__ __forceinline__ void phase0(const Args& a, LAS unsigned char* lds, int gw, int NGW, int wave, int lane) {
    unsigned char* ws = a.ws;
    LAS float* scr = (LAS float*)(lds + wave * 16384);
    constexpr int T_IN = 16 * 128, T_CO = 8 * 32, T_OUT = 16 * 32, T_UP = 16 * 176, T_DN = 44 * 32, T_ALL = T_IN + T_CO + T_OUT + T_UP + T_DN;
    for (int it = gw; it < T_ALL; it += NGW) {
        int r = it;
        if (r < T_IN) { const int kb = r / 128, nb = r % 128; p0_transpose_item(a.in[I_WIN], DM, INC, (bf16*)(ws + WS_WIN), kb * 64, nb * 32, nb * 32, scr, lane); continue; } r -= T_IN;
        if (r < T_CO) { const int kb = r / 32, nb = r % 32; p0_transpose_item(a.in[I_WCONVOUT], 512, DM, (bf16*)(ws + WS_WCO), kb * 64, nb * 32, nb * 32, scr, lane); continue; } r -= T_CO;
        if (r < T_OUT) { const int kb = r / 32, nb = r % 32; p0_transpose_item(a.in[I_WOUT], DM, DM, (bf16*)(ws + WS_WOUT), kb * 64, nb * 32, nb * 32, scr, lane); continue; } r -= T_OUT;
        if (r < T_UP) { const int kb = r / 176, nb = r % 176; p0_transpose_item(a.in[I_WUP], DM, 2 * DFF, (bf16*)(ws + WS_WUP), kb * 64, nb * 32, wup_drow(nb * 32), scr, lane); continue; } r -= T_UP;
        { const int kb = r / 32, nb = r % 32; p0_transpose_item(a.in[I_WDOWN], DFF, DM, (bf16*)(ws + WS_WDN), kb * 64, nb * 32, nb * 32, scr, lane); }
    }
    { const float* wf = a.in[I_WFOURIER]; bf16* we = (bf16*)(ws + WS_WEFF);
      for (int it = gw; it < 8192; it += NGW) { const int jb = it & 15, c = (it >> 4) & 127, g = it >> 11, j = jb * 64 + lane;
          float ac = 0.f, as = 0.f;
#pragma unroll 32
          for (int cp = 0; cp < 128; ++cp) { const float w = wf[(size_t)(g * 128 + cp) * DM + j]; const float ph = (float)((c * cp) & 127) * (1.0f / 128.0f);
              ac += __builtin_amdgcn_cosf(ph) * w; as += __builtin_amdgcn_sinf(ph) * w; }
          const float s = 0.08838834764831845f;
          we[(size_t)j * DM + g * 128 + c] = (bf16)(cvt_pk_bf16(ac * s, 0.f) & 0xffffu); we[(size_t)j * DM + 512 + g * 128 + c] = (bf16)(cvt_pk_bf16(as * s, 0.f) & 0xffffu); } }
    { bf16* dmat = (bf16*)((unsigned char*)a.out + DO_DM); constexpr int CPR = KD / 8;
      for (int it = gw; it < 2 * KH * CPR / 64; it += NGW) { const int chunk = it * 64 + lane, row = chunk / CPR, ci = chunk - row * CPR, n0 = ci * 8, part = row >= KH, k = row - part * KH;
          int mm = (int)(((unsigned)k * (unsigned)n0) % (unsigned)QL); const int kq = k % QL; float f[8];
#pragma unroll
          for (int i = 0; i < 8; ++i) { const float ph = (float)mm * (1.0f / (float)QL); const float v = part ? -__builtin_amdgcn_sinf(ph) : __builtin_amdgcn_cosf(ph);
              f[i] = (n0 + i <= QH) ? v * 0.011037770f : 0.f; mm += kq; if (mm >= QL) mm -= QL; }
          *(v4u*)(dmat + (size_t)row * KD + n0) = pack8f(f); } }
    { const float* g = a.in[I_GMIXPRE]; bf16* h = (bf16*)(ws + WS_H);
      f32x4 gv[4];
#pragma unroll
      for (int j = 0; j < 4; ++j) gv[j] = ((const f32x4*)g)[lane + 64 * j];
      for (int r0 = gw; r0 < R_TOT; r0 += 2 * NGW) {
          f32x4 v[2][4]; float s2[2];
#pragma unroll
          for (int q = 0; q < 2; ++q) { const int r = r0 + q * NGW; s2[q] = 0.f;
              if (r < R_META + NB * NMETA) { const float* src = r < R_META ? a.in[I_X] + (size_t)r * DM : a.in[I_META] + (size_t)((r - R_META) & 15) * DM;
#pragma unroll
                  for (int j = 0; j < 4; ++j) v[q][j] = ((const f32x4*)src)[lane + 64 * j]; }
              else {
#pragma unroll
                  for (int j = 0; j < 4; ++j) v[q][j] = (f32x4){0.f, 0.f, 0.f, 0.f}; } }
#pragma unroll
          for (int q = 0; q < 2; ++q) {
#pragma unroll
              for (int j = 0; j < 4; ++j) s2[q] += (v[q][j].x * v[q][j].x + v[q][j].y * v[q][j].y) + (v[q][j].z * v[q][j].z + v[q][j].w * v[q][j].w); }
#pragma unroll
          for (int q = 0; q < 2; ++q) { const int r = r0 + q * NGW; if (r >= R_TOT) continue;
              const float rstd = rsqrtf(wave_sum(s2[q]) * (1.0f / DM) + RMS_EPS);
              unsigned long long* o8 = (unsigned long long*)(h + (size_t)r * DM) + lane;
#pragma unroll
              for (int j = 0; j < 4; ++j) { const f32x4 o = v[q][j] * rstd * gv[j]; o8[64 * j] = (unsigned long long)cvt_pk_bf16(o.x, o.y) | ((unsigned long long)cvt_pk_bf16(o.z, o.w) << 32); } }
      } }
}

__device__ __forceinline__ void phase2(const Args& a, LAS unsigned char* lds, int gw, int NGW, int wave, int lane) {
    unsigned char* ws = a.ws; const bf16* proj = (const bf16*)(ws + WS_PROJ);
    { bf16* eT = (bf16*)((unsigned char*)a.out + DO_UT); bf16* oT = eT + (size_t)NCOL * KD;
      LAS bf16* scrE = (LAS bf16*)(lds + wave * 16896); LAS bf16* scrO = scrE + 64 * 66;
      constexpr int NBLK = KD / 64;
      for (int it = gw; it < 4 * NB * 8 * NBLK; it += NGW) { const int nblk = it % NBLK, cb = (it / NBLK) & 7, b = (it / (8 * NBLK)) & 7, r = it / (64 * NBLK);
#pragma unroll
          for (int i = 0; i < 8; ++i) { const int nl = i * 8 + (lane >> 3), mh = nblk * 64 + nl, chunk = lane & 7;
              float e[8], o[8];
#pragma unroll
              for (int j = 0; j < 8; ++j) { e[j] = 0.f; o[j] = 0.f; }
              if (mh <= QH) { unpack8f(*(const v4u*)(proj + (size_t)row_of(b, 4 * mh + r) * INC + cb * 64 + chunk * 8), e);
                  if (mh >= 1 && mh < QH) { float u2[8]; unpack8f(*(const v4u*)(proj + (size_t)row_of(b, LSEQ - 4 * mh + r) * INC + cb * 64 + chunk * 8), u2);
#pragma unroll
                      for (int j = 0; j < 8; ++j) { o[j] = e[j] - u2[j]; e[j] = e[j] + u2[j]; } } }
              LAS bf16* dE = scrE + (chunk * 8) * 66 + nl; LAS bf16* dO = scrO + (chunk * 8) * 66 + nl;
#pragma unroll
              for (int j = 0; j < 8; ++j) { const unsigned w = cvt_pk_bf16(e[j], o[j]); dE[j * 66] = (bf16)(w & 0xffffu); dO[j * 66] = (bf16)(w >> 16); } }
          LDS_WAIT();
#pragma unroll
          for (int i = 0; i < 8; ++i) { const int ch = i * 8 + (lane >> 3), nc = lane & 7; const size_t off = (size_t)(r * 4096 + b * 512 + cb * 64 + ch) * KD + nblk * 64 + nc * 8;
              const LAS unsigned* se = (const LAS unsigned*)(scrE + ch * 66 + nc * 8); const LAS unsigned* so = (const LAS unsigned*)(scrO + ch * 66 + nc * 8);
              v4u w; w.x = se[0]; w.y = se[1]; w.z = se[2]; w.w = se[3]; *(v4u*)(eT + off) = w;
              w.x = so[0]; w.y = so[1]; w.z = so[2]; w.w = so[3]; *(v4u*)(oT + off) = w; }
          LDS_WAIT(); } }
    { bf16* zb = (bf16*)(ws + WS_ZB); const float* cw = a.in[I_CWMIX]; const float* cbias = a.in[I_CBMIX];
      float w0[8], w1[8], w2[8], bb[8]; const int ch0 = lane * 8;
      load8f(cw + ch0, w0); load8f(cw + 512 + ch0, w1); load8f(cw + 1024 + ch0, w2); load8f(cbias + ch0, bb);
      for (int it = gw; it < NB * LSEQ; it += NGW) { const int b = it / LSEQ, p = it - b * LSEQ; const size_t r = (size_t)row_of(b, p);
          float cc[8], vv[8], bg[8], acc[8];
          unpack8f(*(const v4u*)(proj + r * INC + 512 + ch0), cc); unpack8f(*(const v4u*)(proj + r * INC + 1536 + ch0), vv); unpack8f(*(const v4u*)(proj + r * INC + 1024 + ch0), bg);
#pragma unroll
          for (int e = 0; e < 8; ++e) acc[e] = bb[e] + w1[e] * (cc[e] * vv[e]);
          if (p > 0) { const size_t rp = (size_t)row_of(b, p - 1); unpack8f(*(const v4u*)(proj + rp * INC + 512 + ch0), cc); unpack8f(*(const v4u*)(proj + rp * INC + 1536 + ch0), vv);
#pragma unroll
              for (int e = 0; e < 8; ++e) acc[e] += w0[e] * (cc[e] * vv[e]); }
          if (p < LSEQ - 1) { const size_t rn = (size_t)row_of(b, p + 1); unpack8f(*(const v4u*)(proj + rn * INC + 512 + ch0), cc); unpack8f(*(const v4u*)(proj + rn * INC + 1536 + ch0), vv);
#pragma unroll
              for (int e = 0; e < 8; ++e) acc[e] += w2[e] * (cc[e] * vv[e]); }
#pragma unroll
          for (int e = 0; e < 8; ++e) acc[e] *= bg[e];
          *(v4u*)(zb + r * 512 + ch0) = pack8f(acc); } }
}

template <int EPL> __device__ __forceinline__ void sk_load(unsigned (&a)[8][EPL / 2], const bf16* A, int lda, int row0, int rstride, int lane) {
#pragma unroll
    for (int r = 0; r < 8; ++r) { const v4u* p = (const v4u*)(A + (size_t)(row0 + r * rstride) * lda + lane * EPL);
#pragma unroll
        for (int i = 0; i < EPL / 8; ++i) { const v4u w = p[i]; a[r][4 * i] = w.x; a[r][4 * i + 1] = w.y; a[r][4 * i + 2] = w.z; a[r][4 * i + 3] = w.w; } }
}
template <int EPL> __device__ __forceinline__ float sk_dot(const unsigned (&a)[8][EPL / 2], const bf16* btrow, int lane) {
    unsigned b[EPL / 2];
#pragma unroll
    for (int i = 0; i < EPL / 8; ++i) { const v4u w = ((const v4u*)(btrow + lane * EPL))[i]; b[4 * i] = w.x; b[4 * i + 1] = w.y; b[4 * i + 2] = w.z; b[4 * i + 3] = w.w; }
    float acc[8];
#pragma unroll
    for (int r = 0; r < 8; ++r) acc[r] = 0.f;
#pragma unroll
    for (int i = 0; i < EPL / 2; ++i) { const float bl = bflo(b[i]), bh = bfhi(b[i]);
#pragma unroll
        for (int r = 0; r < 8; ++r) acc[r] += bflo(a[r][i]) * bl + bfhi(a[r][i]) * bh; }
    float res = 0.f;
#pragma unroll
    for (int r = 0; r < 8; ++r) { const float t = wave_sum(acc[r]); res = (lane == r) ? t : res; }
    return res;
}
__device__ __forceinline__ bf16 f2bf1(float v) { return (bf16)(cvt_pk_bf16(v, 0.f) & 0xffffu); }
__device__ __forceinline__ float bf2f1(bf16 h) { return __uint_as_float((unsigned)h << 16); }
constexpr int EDGE_ROW0 = R_META + NMETA - 1;

__device__ __forceinline__ void p1_meta(const Args& a, int gw, int NGW, int lane) {
    unsigned char* ws = a.ws; const bf16* h = (const bf16*)(ws + WS_H); const bf16* wt = (const bf16*)(ws + WS_WIN); bf16* proj = (bf16*)(ws + WS_PROJ); const float* bg = a.in[I_BGATES];
#pragma unroll 1
    for (int rg = 0; rg < 2; ++rg) { unsigned av[8][8]; sk_load<16>(av, h, DM, R_META + rg * 8, 1, lane);
#pragma unroll 1
        for (int j = gw; j < INC; j += NGW) { float v = sk_dot<16>(av, wt + (size_t)j * DM, lane);
            if (lane < 8) { if (j >= 2048) v = pg8::sigmoidf_(v + bg[j - 2048]); const bf16 o = f2bf1(v); const int pp = rg * 8 + lane;
#pragma unroll
                for (int b = 0; b < NB; ++b) proj[(size_t)(R_META + b * NMETA + pp) * INC + j] = o; } } }
}
__device__ __forceinline__ void p4_edge(const Args& a, int gw, int lane) {
    if (gw >= DM) return;
    unsigned char* ws = a.ws; const bf16* proj = (const bf16*)(ws + WS_PROJ); bf16* mg = (bf16*)(ws + WS_MG);
    unsigned aF[8][8], aZ[8][4]; sk_load<16>(aF, (const bf16*)(ws + WS_F), DM, EDGE_ROW0, NMETA, lane); sk_load<8>(aZ, (const bf16*)(ws + WS_ZB), 512, EDGE_ROW0, NMETA, lane);
    const int j = gw;
    const float ya = sk_dot<16>(aF, (const bf16*)(ws + WS_WEFF) + (size_t)j * DM, lane), yb = sk_dot<8>(aZ, (const bf16*)(ws + WS_WCO) + (size_t)j * 512, lane);
    if (lane < 8) { const size_t r = (size_t)(EDGE_ROW0 + lane * NMETA); mg[r * DM + j] = f2bf1(bf2f1(proj[r * INC + 2048 + j]) * ya + bf2f1(proj[r * INC + 3072 + j]) * yb); }
}
__device__ __forceinline__ void edge_gemm(const bf16* A, const bf16* Bt, int N, bf16* O, int ldo, int orow0, int ostride, int gw, int NGW, int lane) {
    if (gw >= N) return;
    unsigned av[8][8]; sk_load<16>(av, A, DM, EDGE_ROW0, NMETA, lane);
#pragma unroll 1
    for (int j = gw; j < N; j += NGW) { const float v = sk_dot<16>(av, Bt + (size_t)j * DM, lane);
        if (lane < 8) O[(size_t)(orow0 + lane * ostride) * ldo + j] = f2bf1(v); }
}

__device__ __forceinline__ void dft_tail(const Args& a, int gw, int NGW, int lane) {
    const bf16* dm = (const bf16*)((unsigned char*)a.out + DO_DM); const bf16* eT = (const bf16*)((unsigned char*)a.out + DO_UT); const bf16* oT = eT + (size_t)NCOL * KD;
    bf16* S = (bf16*)((unsigned char*)a.out + DO_S);
    for (int col = gw; col < NCOL; col += NGW) {
        float se[3], so[3];
#pragma unroll
        for (int kx = 0; kx < 3; ++kx) { se[kx] = 0.f; so[kx] = 0.f; }
#pragma unroll
        for (int it = 0; it < 3; ++it) { const int off = it * 512 + lane * 8;
            if (off < KD) { float ev[8], ov[8]; unpack8f(*(const v4u*)(eT + (size_t)col * KD + off), ev); unpack8f(*(const v4u*)(oT + (size_t)col * KD + off), ov);
#pragma unroll
                for (int kx = 0; kx < 3; ++kx) { float c[8], sn[8]; unpack8f(*(const v4u*)(dm + (size_t)(1024 + kx) * KD + off), c); unpack8f(*(const v4u*)(dm + (size_t)(KH + 1024 + kx) * KD + off), sn);
#pragma unroll
                    for (int e = 0; e < 8; ++e) { se[kx] += ev[e] * c[e]; so[kx] += ov[e] * sn[e]; } } } }
        float ve = 0.f, vo = 0.f;
#pragma unroll
        for (int kx = 0; kx < 3; ++kx) { const float te = wave_sum(se[kx]), to = wave_sum(so[kx]); if (lane == kx) { ve = te; vo = to; } }
        if (lane < 3) { const unsigned w = cvt_pk_bf16(ve, vo);
            S[(size_t)(1024 + lane) * NCOL + col] = (bf16)(w & 0xffffu); S[(size_t)(KH + 1024 + lane) * NCOL + col] = (bf16)(w >> 16); }
    }
}
__device__ __forceinline__ void dft_combine(const Args& a, int gw, int NGW, int lane) {
    const bf16* S = (const bf16*)((unsigned char*)a.out + DO_S); bf16* F = (bf16*)(a.ws + WS_F);
    const int ch0 = lane * 8;
    for (int it = gw; it < NB * (NHALF + 1); it += NGW) { const int b = it / (NHALF + 1), k = it - b * (NHALF + 1);
        int k1 = k % QL; float sg = 1.f; if (k1 > QH) { k1 = QL - k1; sg = -1.f; }
        float ar[8], ai[8];
#pragma unroll
        for (int e = 0; e < 8; ++e) { ar[e] = 0.f; ai[e] = 0.f; }
#pragma unroll
        for (int r = 0; r < 4; ++r) { float re[8], im[8];
            unpack8f(*(const v4u*)(S + (size_t)k1 * NCOL + r * 4096 + b * 512 + ch0), re); unpack8f(*(const v4u*)(S + (size_t)(KH + k1) * NCOL + r * 4096 + b * 512 + ch0), im);
            const float ph = (float)((r * k) % LSEQ) * (1.0f / (float)LSEQ); const float c = __builtin_amdgcn_cosf(ph), sn = __builtin_amdgcn_sinf(ph);
#pragma unroll
            for (int e = 0; e < 8; ++e) { const float x = re[e], y = sg * im[e]; ar[e] += c * x + sn * y; ai[e] += c * y - sn * x; } }
        *(v4u*)(F + (size_t)row_of(b, k) * DM + ch0) = pack8f(ar); *(v4u*)(F + (size_t)row_of(b, k) * DM + 512 + ch0) = pack8f(ai);
        if (k >= 1 && k < NHALF) {
#pragma unroll
            for (int e = 0; e < 8; ++e) ai[e] = -ai[e];
            *(v4u*)(F + (size_t)row_of(b, LSEQ - k) * DM + ch0) = pack8f(ar); *(v4u*)(F + (size_t)row_of(b, LSEQ - k) * DM + 512 + ch0) = pack8f(ai); }
    }
}

__device__ __forceinline__ void phase6(const Args& a, int gw, int NGW, int lane) {
    unsigned char* ws = a.ws; const bf16* mix = (const bf16*)(ws + WS_H); bf16* h2 = (bf16*)(ws + WS_H2); bf16* hres = (bf16*)(ws + WS_F);
    float g1[2][8], g2[2][8];
#pragma unroll
    for (int j = 0; j < 2; ++j) { load8f(a.in[I_GMIXPOST] + 8 * lane + 512 * j, g1[j]); load8f(a.in[I_GFFNPRE] + 8 * lane + 512 * j, g2[j]); }
    constexpr int NR = R_META + 2 * NB;
    for (int r0 = gw; r0 < NR; r0 += 2 * NGW) {
        float mv[2][2][8], xv[2][2][8];
#pragma unroll
        for (int q = 0; q < 2; ++q) { int ri = (r0 + q * NGW < NR) ? r0 + q * NGW : r0; if (ri >= R_META + NB) ri = R_META;
            const int r = ri < R_META ? ri : EDGE_ROW0 + (ri - R_META) * NMETA;
            const float* src = r < R_META ? a.in[I_X] + (size_t)r * DM : a.in[I_META] + (size_t)(NMETA - 1) * DM;
#pragma unroll
            for (int j = 0; j < 2; ++j) { unpack8f(*(const v4u*)(mix + (size_t)r * DM + 8 * lane + 512 * j), mv[q][j]); load8f(src + 8 * lane + 512 * j, xv[q][j]); } }
#pragma unroll
        for (int q = 0; q < 2; ++q) { const int ri = r0 + q * NGW; if (ri >= NR) continue;
            const size_t orow = ri < R_META ? (size_t)(ri >> 13) * pg8::H2F_PITCH + (ri & 8191) + 1 : (ri < R_META + NB ? (size_t)(ri - R_META) * pg8::H2F_PITCH : (size_t)(ri - R_META - NB) * pg8::H2F_PITCH + SEQ + 1);
            if (ri >= R_META + NB) {
#pragma unroll
                for (int j = 0; j < 2; ++j) *(v4u*)(h2 + orow * DM + 8 * lane + 512 * j) = (v4u){0u, 0u, 0u, 0u};
                continue; }
            float s = 0.f;
#pragma unroll
            for (int j = 0; j < 2; ++j)
#pragma unroll
                for (int e = 0; e < 8; ++e) s += mv[q][j][e] * mv[q][j][e];
            const float r1 = rsqrtf(wave_sum(s) * (1.0f / DM) + RMS_EPS); float s2 = 0.f;
#pragma unroll
            for (int j = 0; j < 2; ++j)
#pragma unroll
                for (int e = 0; e < 8; ++e) { const float hr = xv[q][j][e] + mv[q][j][e] * r1 * g1[j][e]; xv[q][j][e] = hr; s2 += hr * hr; }
            const float r2 = rsqrtf(wave_sum(s2) * (1.0f / DM) + RMS_EPS);
#pragma unroll
            for (int j = 0; j < 2; ++j) { float o[8];
#pragma unroll
                for (int e = 0; e < 8; ++e) o[e] = xv[q][j][e] * r2 * g2[j][e];
                *(v4u*)(h2 + orow * DM + 8 * lane + 512 * j) = pack8f(o);
                if (ri < R_META) *(v4u*)(hres + (size_t)ri * DM + 8 * lane + 512 * j) = pack8f(xv[q][j]); } }
    }
}

__device__ __forceinline__ void phase10(const Args& a, int gw, int NGW, int lane) {
    unsigned char* ws = a.ws; const bf16* hres = (const bf16*)(ws + WS_F); const bf16* ffn = (const bf16*)(ws + WS_MG);
    float g3[2][8];
#pragma unroll
    for (int j = 0; j < 2; ++j) load8f(a.in[I_GFFNPOST] + 8 * lane + 512 * j, g3[j]);
    for (int r0 = gw; r0 < R_META; r0 += 4 * NGW) {
        float hv[4][2][8], fv[4][2][8];
#pragma unroll
        for (int q = 0; q < 4; ++q) { const int r = (r0 + q * NGW < R_META) ? r0 + q * NGW : r0;
#pragma unroll
            for (int j = 0; j < 2; ++j) { const size_t off = (size_t)r * DM + 8 * lane + 512 * j; unpack8f(*(const v4u*)(hres + off), hv[q][j]); unpack8f(*(const v4u*)(ffn + off), fv[q][j]); } }
#pragma unroll
        for (int q = 0; q < 4; ++q) { const int r = r0 + q * NGW; if (r >= R_META) continue;
            float s3 = 0.f;
#pragma unroll
            for (int j = 0; j < 2; ++j)
#pragma unroll
                for (int e = 0; e < 8; ++e) s3 += fv[q][j][e] * fv[q][j][e];
            const float r3 = rsqrtf(wave_sum(s3) * (1.0f / DM) + RMS_EPS);
#pragma unroll
            for (int j = 0; j < 2; ++j) { float o[8];
#pragma unroll
                for (int e = 0; e < 8; ++e) o[e] = hv[q][j][e] + fv[q][j][e] * r3 * g3[j][e];
                float* op = a.out + (size_t)r * DM + 8 * lane + 512 * j;
                __builtin_nontemporal_store((f32x4){o[0], o[1], o[2], o[3]}, (f32x4*)op); __builtin_nontemporal_store((f32x4){o[4], o[5], o[6], o[7]}, (f32x4*)(op + 4)); } }
    }
}

#define XB_TMO      128
#define XB_XCNT(j)  (256  + 64 * (j))
#define XB_XSUB(j)  (1280 + 64 * (j))
#define XB_XGEN(j)  (2304 + 64 * (j))
#define XB_TOP      3328
#define XB_TOPGEN   3392
#define XCD_BAR_WORDS 3456
#define XB_SPIN_CAP (1u << 18)

__device__ __forceinline__ unsigned xb_ld(unsigned* p)              { return __hip_atomic_load(p, __ATOMIC_RELAXED, __HIP_MEMORY_SCOPE_AGENT); }
__device__ __forceinline__ unsigned xb_add(unsigned* p, unsigned v) { return __hip_atomic_fetch_add(p, v, __ATOMIC_RELAXED, __HIP_MEMORY_SCOPE_AGENT); }
__device__ __forceinline__ unsigned xb_xcc_id() { return (unsigned)__builtin_amdgcn_s_getreg((3 << 11) | 20) & 0xFu; }
#define XB_SPIN(cond, bar) do { unsigned _sp = 0; while (cond) { __builtin_amdgcn_s_sleep(1); \
    if ((++_sp & 255u) == 0u) { if (xb_ld(&(bar)[XB_TMO])) break; if (_sp > XB_SPIN_CAP) { atomicAdd(&(bar)[XB_TMO], 1u); break; } } } } while (0)

struct XcdBarrier {
    unsigned* bar; unsigned x;
    unsigned nloc, nx;
    unsigned rank;
};

__device__ __forceinline__ XcdBarrier xcd_barrier_post(unsigned* bar) {
    XcdBarrier b; b.bar = bar; b.x = xb_xcc_id(); b.nloc = 0u; b.nx = 0u;
    b.rank = 0u; if (threadIdx.x == 0) b.rank = xb_add(&bar[XB_XCNT(b.x)], 1u);
    return b;
}
__device__ __forceinline__ void xcd_barrier_complete(unsigned* bar, unsigned x, unsigned& nloc, unsigned& nx) {
    const unsigned G = gridDim.x * gridDim.y * gridDim.z;
    unsigned sum, cnt, mine, sp = 0u;
    for (;;) {
        sum = 0u; cnt = 0u; mine = 0u;
#pragma unroll
        for (unsigned j = 0; j < 16; ++j) { const unsigned c = xb_ld(&bar[XB_XCNT(j)]); sum += c; cnt += (c > 0u) ? 1u : 0u; mine = (j == x) ? c : mine; }
        if (sum == G) break;
        __builtin_amdgcn_s_sleep(1);
        if ((++sp & 255u) == 0u) { if (xb_ld(&bar[XB_TMO])) break; if (sp > XB_SPIN_CAP) { atomicAdd(&bar[XB_TMO], 1u); break; } }
    }
    nloc = mine > 0u ? mine : 1u; nx = cnt > 0u ? cnt : 1u;
}

__device__ __forceinline__ void xcd_barrier(XcdBarrier& b) {
    asm volatile("s_waitcnt vmcnt(0)" ::: "memory");
    __syncthreads();
    if (threadIdx.x == 0) {
        unsigned* bar = b.bar;
        __builtin_amdgcn_s_waitcnt(0);
        unsigned nloc = b.nloc, nx = b.nx;
        if (nloc == 0u) { xcd_barrier_complete(bar, b.x, nloc, nx); b.nloc = nloc; b.nx = nx; }
        const unsigned old = xb_add(&bar[XB_XSUB(b.x)], 1u);
        const unsigned gen = old / nloc;
        if (old + 1u == (gen + 1u) * nloc) {
            __builtin_amdgcn_fence(__ATOMIC_RELEASE, "agent");
            asm volatile("s_waitcnt vmcnt(0)" ::: "memory");
            const unsigned og = xb_add(&bar[XB_TOP], 1u);
            const unsigned tg = og / nx;
            if (og + 1u == (tg + 1u) * nx) xb_add(&bar[XB_TOPGEN], 1u);
            else XB_SPIN(xb_ld(&bar[XB_TOPGEN]) == tg, bar);
            __builtin_amdgcn_fence(__ATOMIC_ACQUIRE, "agent");
            xb_add(&bar[XB_XGEN(b.x)], 1u);
            asm volatile("s_waitcnt vmcnt(0)" ::: "memory");
        } else {
            XB_SPIN(xb_ld(&bar[XB_XGEN(b.x)]) == gen, bar);
            __builtin_amdgcn_fence(__ATOMIC_ACQUIRE, "agent");
            asm volatile("s_waitcnt vmcnt(0)" ::: "memory");
        }
    }
    __syncthreads();
}


#ifndef STAGGER_TICKS
#define STAGGER_TICKS 1000
#endif
__device__ __forceinline__ void stagger(int bx, unsigned ticks) {
    const unsigned frac = __brev((unsigned)bx) >> 24;
    const unsigned long long t0 = __builtin_amdgcn_s_memrealtime(), dt = (unsigned long long)ticks * frac / 256;
    while (__builtin_amdgcn_s_memrealtime() - t0 < dt) __builtin_amdgcn_s_sleep(8);
}

constexpr int N_PHASES = 11;
__global__ void __launch_bounds__(NWAVES * 64, 2) fwd_megakernel(Args args) {
    extern __shared__ __attribute__((aligned(16))) unsigned char lds_raw[];
    LAS unsigned char* lds = (LAS unsigned char*)lds_raw;
    cg::grid_group grid = cg::this_grid();
    const int tid = threadIdx.x, lane = tid & 63, wave = __builtin_amdgcn_readfirstlane(tid >> 6);
    const int G = gridDim.x, bx = blockIdx.x;
    const int vcu = (G % 8 == 0) ? (bx % 8) * (G / 8) + bx / 8 : bx;
    const int gw = vcu * NWAVES + wave, NGW = G * NWAVES;
    unsigned char* ws = args.ws;
    const int lo = args.ph_lo, hi = args.ph_hi;
    unsigned* barw = (unsigned*)ws;
    if (args.ph_hi < 0) grid.sync();
    XcdBarrier xbar = xcd_barrier_post(barw);
    int vbx = bx;
    if (G == 256) { if (tid == 0) *(volatile LAS unsigned*)lds = xbar.x + 8u * xbar.rank; __syncthreads(); const unsigned v_ = *(volatile LAS unsigned*)lds; __syncthreads(); if (v_ < 256u) vbx = (int)v_; }
#ifndef PHASE_MASK
#define PHASE_MASK 0x7ff
#endif
#define IN(k) (((PHASE_MASK >> (k)) & 1) && lo <= (k) && (k) < hi)
#define SEAM(k) do { if ((k) + 1 < hi) xcd_barrier(xbar); } while (0)
    using namespace pg8;
    if (IN(0)) { phase0(args, lds, gw, NGW, wave, lane);
        SEAM(0); }
    if (IN(1)) {
        Gemm g{(const bf16_t*)(ws + WS_H), (const bf16_t*)(ws + WS_WIN), DM}; Order S; S.init(256, 0, -1, INC / 256, G, vbx);
        p1_meta(args, gw, NGW, lane);
        EpiProj E{(bf16_t*)(ws + WS_PROJ), args.in[I_BGATES]};
        gemm_phase<EpiProj, Order>(lds, g, S, E); SEAM(1); }
    if (IN(2)) { phase2(args, lds, gw, NGW, wave, lane);
        SEAM(2); }
    if (IN(3)) {
        dft_tail(args, gw, NGW, lane);
        Gemm g{(const bf16_t*)((unsigned char*)args.out + DO_DM), (const bf16_t*)((unsigned char*)args.out + DO_UT), KD}; OrderDft S; S.init(G, vbx);
        EpiDft E{(bf16_t*)((unsigned char*)args.out + DO_S)};
        gemm_phase<EpiDft, OrderDft>(lds, g, S, E);
        xcd_barrier(xbar);
        dft_combine(args, gw, NGW, lane); SEAM(3); }
    if (IN(4)) {
        Gemm g{(const bf16_t*)(ws + WS_F), (const bf16_t*)(ws + WS_WEFF), DM}; Order S; S.init(256, 0, -1, DM / 256, G, vbx);
        p4_edge(args, gw, lane);
        EpiYa E{(bf16_t*)(ws + WS_MG), (const bf16_t*)(ws + WS_PROJ)};
        gemm_phase<EpiYa, Order>(lds, g, S, E); }
    if (IN(5)) {
        Gemm g{(const bf16_t*)(ws + WS_ZB), (const bf16_t*)(ws + WS_WCO), 512}; Order S; S.init(256, 0, -1, DM / 256, G, vbx);
        EpiYb E{(bf16_t*)(ws + WS_MG), (const bf16_t*)(ws + WS_PROJ)};
        gemm_phase<EpiYb, Order>(lds, g, S, E); SEAM(5); }
    if (IN(6)) {
        Gemm g{(const bf16_t*)(ws + WS_MG), (const bf16_t*)(ws + WS_WOUT), DM}; Order S; S.init(256, 0, -1, DM / 256, G, vbx);
        edge_gemm((const bf16*)(ws + WS_MG), (const bf16*)(ws + WS_WOUT), DM, (bf16*)(ws + WS_H), DM, EDGE_ROW0, NMETA, gw, NGW, lane);
        EpiStore E{(bf16_t*)(ws + WS_H), DM, 0, -1, 0};
        gemm_phase<EpiStore, Order>(lds, g, S, E); SEAM(6); }
    if (IN(7)) { phase6(args, gw, NGW, lane);
        SEAM(7); }
    if (IN(8)) {
        Gemm g{(const bf16_t*)(ws + WS_H2), (const bf16_t*)(ws + WS_WUP), DM}; OrderFfn S; S.init(NB * FFN_TPB, 0, -1, 2 * DFF / 256, G, vbx);
        EpiFfn E{(bf16_t*)(ws + WS_ACT), args.in[I_CWFFN], args.in[I_CBFFN], lds + STAGE_BYTES};
        gemm_phase<EpiFfn, OrderFfn>(lds, g, S, E); SEAM(8); }
    if (IN(9)) {
        Gemm g{(const bf16_t*)(ws + WS_ACT), (const bf16_t*)(ws + WS_WDN), DFF}; Order S; S.init(256, 0, -1, DM / 256, G, vbx);
        EpiStore E{(bf16_t*)(ws + WS_MG), DM, 0, -1, 0};
        gemm_phase<EpiStore, Order>(lds, g, S, E); SEAM(9); }
    if (IN(10)) { phase10(args, gw, NGW, lane);
    }
#undef IN
#undef SEAM
}

extern "C" void kernel_launch(void* const* d_in, const int* in_sizes, int n_in, void* d_out, int out_size, void* d_ws, size_t ws_size, hipStream_t stream) {
    static int grid = 0;
    if (grid == 0) {
        if (n_in != 17 || ws_size < WS_NEED || out_size != NB * SEQ * DM) { fprintf(stderr, "kernel_launch: unexpected problem (n_in %d, ws %zu, out %d)\n", n_in, ws_size, out_size); grid = -1; return; }
        int dev = 0, cus = 0, per_cu = 0;
        if (hipGetDevice(&dev) != hipSuccess || hipDeviceGetAttribute(&cus, hipDeviceAttributeMultiprocessorCount, dev) != hipSuccess) { grid = -1; return; }
        if (hipFuncSetAttribute((const void*)fwd_megakernel, hipFuncAttributeMaxDynamicSharedMemorySize, LDS_BYTES) != hipSuccess) { fprintf(stderr, "kernel_launch: hipFuncSetAttribute failed\n"); grid = -1; return; }
        if (hipOccupancyMaxActiveBlocksPerMultiprocessor(&per_cu, (const void*)fwd_megakernel, NWAVES * 64, LDS_BYTES) != hipSuccess || per_cu < 1) { fprintf(stderr, "kernel_launch: occupancy query says %d\n", per_cu); per_cu = 1; }
        (void)hipGetLastError();
        grid = cus * 1;
    }
    if (grid < 0) return;
    if (hipMemsetAsync(d_ws, 0, 16384, stream) != hipSuccess) { fprintf(stderr, "kernel_launch: memset of the barrier words failed\n"); return; }
    Args a{};
    for (int i = 0; i < 17; ++i) a.in[i] = (const float*)d_in[i];
    a.out = (float*)d_out; a.ws = (unsigned char*)d_ws; a.ph_lo = 0; a.ph_hi = N_PHASES;
    void* kargs[] = {&a};
    hipError_t e = hipLaunchCooperativeKernel((const void*)fwd_megakernel, dim3(grid), dim3(NWAVES * 64), kargs, LDS_BYTES, stream);
    if (e != hipSuccess) fprintf(stderr, "kernel_launch: cooperative launch failed: %s (grid %d)\n", hipGetErrorString(e), grid);
}
```

```cpp
#include <hip/hip_runtime.h>
#include <hip/hip_cooperative_groups.h>
#include <cstdio>
#include <cstdint>
namespace cg = cooperative_groups;

constexpr int NB = 8, SEQ = 8192, NMETA = 16, LSEQ = 8208, DM = 1024, DFF = 2816, INC = 4096;
constexpr int R_META = 65536, R_TOT = 65792;
constexpr int NHALF = LSEQ / 2;
constexpr int QL = LSEQ / 4, QH = QL / 2;
constexpr int KD = 1152;
constexpr int KH = 1280, KHT = 5;
constexpr int NCOL = 4 * 4096;
constexpr float RMS_EPS = 1e-6f;
__device__ __forceinline__ int row_of(int b, int pos) { return pos >= NMETA ? b * SEQ + pos - NMETA : R_META + b * NMETA + pos; }

namespace pg8 {
#define PG8_LAS __attribute__((address_space(3)))
typedef unsigned short bf16_t;
typedef short bf16x8 __attribute__((ext_vector_type(8)));
typedef float f32x4 __attribute__((ext_vector_type(4)));
typedef unsigned u32x4 __attribute__((ext_vector_type(4)));
constexpr int BM = 256, BK = 64, HALF = 128, HTB = HALF * BK * 2, STAGE_BYTES = 8 * HTB, NXCD = 8, WGM = 8;

__host__ __device__ __forceinline__ int lds_byte(int r, int c) { const int st = (r >> 4) * 2 + (c >> 5), rr = r & 15, cc = c & 31, ob = rr * 64 + cc * 2; return st * 1024 + (ob ^ (((ob >> 9) & 1) << 5)); }
__host__ __device__ __forceinline__ void stage_rc(int b, int& R, int& C) { const int st = b / 1024, sb = b % 1024, swz = sb ^ (((sb >> 9) & 1) << 5); R = (st >> 1) * 16 + swz / 64; C = (st & 1) * 32 + (swz % 64) / 2; }
__host__ __device__ __forceinline__ int perm32(int rho) { const int n = rho >> 4, i = rho & 15; return 8 * (i >> 2) + 4 * n + (i & 3); }

struct Unit { int pm, pn, arow; };
struct Gemm { const bf16_t* A; const bf16_t* Bt; int K; };

struct Order {
    int nM, nN, nwg, G, c, pm0, nMain, pm_extra;
    __device__ void init(int nMain_, int pm0_, int pm_extra_, int nN_, int G_, int c_) { nMain = nMain_; pm0 = pm0_; pm_extra = pm_extra_; nM = nMain_ + (pm_extra_ >= 0 ? 1 : 0); nN = nN_; nwg = nM * nN; G = G_; c = c_; }
    __device__ bool next(int i, Unit& u) const {
        const long L = (long)i * G + c; if (L >= nwg) return false;
        int wgid = (int)L; { const int q = nwg / NXCD, r = nwg % NXCD, xcd = wgid % NXCD, off = wgid / NXCD; wgid = (xcd < r ? xcd * (q + 1) : r * (q + 1) + (xcd - r) * q) + off; }
        const int nig = WGM * nN, gid = wgid / nig, fm = gid * WGM, gsz = (nM - fm) < WGM ? (nM - fm) : WGM;
        const int t = fm + ((wgid % nig) % gsz); u.pm = (t < nMain) ? pm0 + t : pm_extra; u.pn = (wgid % nig) / gsz; u.arow = u.pm * BM; return true;
    }
    __device__ __forceinline__ void a_ready(const Unit&) const {}
    __device__ __forceinline__ void done(const Unit&) const {}
};
struct OrderDft {
    int G, c;
    __device__ void init(int G_, int c_) { G = G_; c = c_; }
    __device__ bool next(int i, Unit& u) const {
        constexpr int nM = 8, nN = 64, nwg = nM * nN;
        const long L = (long)i * G + c; if (L >= nwg) return false;
        int wgid = (int)L; { const int q = nwg / NXCD, xcd = wgid % NXCD, off = wgid / NXCD; wgid = xcd * q + off; }
        const int t = wgid & 7, pn = wgid >> 3, part = t >> 2;
        u.pm = part * KHT + (t & 3); u.pn = part * 64 + pn; u.arow = u.pm * BM; return true;
    }
    __device__ __forceinline__ void a_ready(const Unit&) const {}
    __device__ __forceinline__ void done(const Unit&) const {}
};
constexpr int H2F_PITCH = 8448, FFN_TPB = 33, FFN_STEP = 254;
struct OrderFfn : Order {
    __device__ bool next(int i, Unit& u) const { if (!Order::next(i, u)) return false; const int b = u.pm / FFN_TPB, t = u.pm - b * FFN_TPB; u.arow = b * H2F_PITCH + FFN_STEP * t; return true; }
};
__device__ __forceinline__ unsigned cvt_pk_bf16(float lo, float hi) { unsigned r; asm volatile("v_cvt_pk_bf16_f32 %0, %1, %2" : "=v"(r) : "v"(lo), "v"(hi)); return r; }
__device__ __forceinline__ u32x4 pack8(const f32x4 v0, const f32x4 v1) { u32x4 w; w.x = cvt_pk_bf16(v0[0], v0[1]); w.y = cvt_pk_bf16(v0[2], v0[3]); w.z = cvt_pk_bf16(v1[0], v1[1]); w.w = cvt_pk_bf16(v1[2], v1[3]); return w; }
__device__ __forceinline__ float bflo(unsigned w) { return __uint_as_float(w << 16); }
__device__ __forceinline__ float bfhi(unsigned w) { return __uint_as_float(w & 0xffff0000u); }
__device__ __forceinline__ void unpack8(const u32x4 w, f32x4& v0, f32x4& v1) { v0 = (f32x4){bflo(w.x), bfhi(w.x), bflo(w.y), bfhi(w.y)}; v1 = (f32x4){bflo(w.z), bfhi(w.z), bflo(w.w), bfhi(w.w)}; }
__device__ __forceinline__ float sigmoidf_(float x) { return __builtin_amdgcn_rcpf(1.0f + __expf(-x)); }
#define EPI_LOOP_AM _Pragma("unroll") for (int ai = 0; ai < 2; ++ai) _Pragma("unroll") for (int m = 0; m < 4; ++m)
#define EPI_LOOP_BJ _Pragma("unroll") for (int bj = 0; bj < 2; ++bj)
typedef const f32x4 (&AccT)[2][2][4][2];

struct EpiProj { static constexpr bool PERM = true, AFTER_DRAIN = false, RPT = true;
    bf16_t* P; const float* bg;
    __device__ __forceinline__ void operator()(AccT acc, const Unit& u, int wr, int wc, int fr, int fq) const {
        const int row0 = u.pm * BM + wr * 64 + fr, colt = u.pn * BM + wc * 32 + 8 * fq;
        const bool gate = u.pn >= 8;
        f32x4 bv[2][2];
        EPI_LOOP_BJ { _Pragma("unroll") for (int n = 0; n < 2; ++n) bv[bj][n] = gate ? *(const f32x4*)(bg + (colt - 2048) + bj * HALF + 4 * n) : (f32x4){0.f, 0.f, 0.f, 0.f}; }
        EPI_LOOP_AM { bf16_t* rowp = P + (size_t)(row0 + ai * HALF + m * 16) * INC + colt;
            EPI_LOOP_BJ { f32x4 v0 = acc[ai][bj][m][0] + bv[bj][0], v1 = acc[ai][bj][m][1] + bv[bj][1];
                if (gate) { _Pragma("unroll") for (int j = 0; j < 4; ++j) { v0[j] = sigmoidf_(v0[j]); v1[j] = sigmoidf_(v1[j]); } }
                *(u32x4*)(rowp + bj * HALF) = pack8(v0, v1); } }
    }
};
struct EpiDft { static constexpr bool PERM = true, AFTER_DRAIN = false, RPT = true;
    bf16_t* S;
    __device__ __forceinline__ void operator()(AccT acc, const Unit& u, int wr, int wc, int fr, int fq) const {
        const int part = u.pm / KHT, kt = u.pm - part * KHT;
        const int row0 = part * KH + kt * BM + wr * 64 + fr, colt = (u.pn & 63) * BM + wc * 32 + 8 * fq;
        EPI_LOOP_AM { bf16_t* rowp = S + (size_t)(row0 + ai * HALF + m * 16) * NCOL + colt;
            EPI_LOOP_BJ { *(u32x4*)(rowp + bj * HALF) = pack8(acc[ai][bj][m][0], acc[ai][bj][m][1]); } }
    }
};
struct EpiYa { static constexpr bool PERM = true, AFTER_DRAIN = false, RPT = true;
    bf16_t* Mg; const bf16_t* P;
    __device__ __forceinline__ void operator()(AccT acc, const Unit& u, int wr, int wc, int fr, int fq) const {
        const int row0 = u.pm * BM + wr * 64 + fr, colt = u.pn * BM + wc * 32 + 8 * fq;
        EPI_LOOP_AM { const size_t row = (size_t)(row0 + ai * HALF + m * 16);
            EPI_LOOP_BJ { const u32x4 gw = *(const u32x4*)(P + row * INC + 2048 + colt + bj * HALF); f32x4 g0, g1; unpack8(gw, g0, g1);
                *(u32x4*)(Mg + row * DM + colt + bj * HALF) = pack8(acc[ai][bj][m][0] * g0, acc[ai][bj][m][1] * g1); }
            asm volatile("" ::: "memory"); }
    }
};
struct EpiYb { static constexpr bool PERM = true, AFTER_DRAIN = false, RPT = false;
    bf16_t* Mg; const bf16_t* P;
    __device__ __forceinline__ void operator()(AccT acc, const Unit& u, int wr, int wc, int fr, int fq) const {
        const int row0 = u.pm * BM + wr * 64 + fr, colt = u.pn * BM + wc * 32 + 8 * fq;
        EPI_LOOP_AM { const size_t row = (size_t)(row0 + ai * HALF + m * 16);
            EPI_LOOP_BJ { const u32x4 gw = *(const u32x4*)(P + row * INC + 3072 + colt + bj * HALF); f32x4 g0, g1; unpack8(gw, g0, g1);
                const u32x4 tw = *(const u32x4*)(Mg + row * DM + colt + bj * HALF); f32x4 t0, t1; unpack8(tw, t0, t1);
                *(u32x4*)(Mg + row * DM + colt + bj * HALF) = pack8(t0 + acc[ai][bj][m][0] * g0, t1 + acc[ai][bj][m][1] * g1); }
            asm volatile("" ::: "memory"); }
    }
};
struct EpiStore { static constexpr bool PERM = true, AFTER_DRAIN = false, RPT = true;
    bf16_t* O; int ldc, pm0, pm_extra, extra_local;
    __device__ __forceinline__ void operator()(AccT acc, const Unit& u, int wr, int wc, int fr, int fq) const {
        const int lt = (u.pm == pm_extra) ? extra_local : u.pm - pm0;
        const int row0 = lt * BM + wr * 64 + fr, colt = u.pn * BM + wc * 32 + 8 * fq;
        EPI_LOOP_AM { bf16_t* rowp = O + (size_t)(row0 + ai * HALF + m * 16) * ldc + colt;
            EPI_LOOP_BJ { *(u32x4*)(rowp + bj * HALF) = pack8(acc[ai][bj][m][0], acc[ai][bj][m][1]); } }
    }
};
struct EpiF32 { static constexpr bool PERM = false, AFTER_DRAIN = false, RPT = true;
    float* C; int ldc, tile_off;
    __device__ __forceinline__ void operator()(AccT acc, const Unit& u, int wr, int wc, int fr, int fq) const {
        const int row0 = (u.pm + tile_off) * BM + wr * 64 + fr, col0 = u.pn * BM + wc * 32 + 4 * fq;
        EPI_LOOP_AM { float* rowp = C + (size_t)(row0 + ai * HALF + m * 16) * ldc + col0;
            EPI_LOOP_BJ { _Pragma("unroll") for (int n = 0; n < 2; ++n) *(f32x4*)(rowp + bj * HALF + n * 16) = acc[ai][bj][m][n]; } }
    }
};

struct EpiFfn { static constexpr bool PERM = true, AFTER_DRAIN = false, RPT = true;
    bf16_t* act; const float* cw; const float* cb; PG8_LAS unsigned char* slab;
    typedef unsigned u32x2 __attribute__((ext_vector_type(2)));
    __device__ __forceinline__ static f32x4 up4(const u32x2 w) { return (f32x4){bflo(w.x), bfhi(w.x), bflo(w.y), bfhi(w.y)}; }
    __device__ __forceinline__ void operator()(AccT acc, const Unit& u, int wr, int wc, int fr, int fq) const {
        const int tid = threadIdx.x, cg8 = tid & 7, rrow = tid >> 3, chunk = cg8 >> 1, hoff = (cg8 & 1) * 8;
        const int b = u.pm / FFN_TPB, t = u.pm - b * FFN_TPB;
#pragma unroll 1
        for (int s = 0; s < 4; ++s) {
            if (wc == s) {
                EPI_LOOP_AM { const int row = ai * HALF + wr * 64 + m * 16 + fr; PG8_LAS unsigned char* rp = slab + row * 128;
                    *(PG8_LAS u32x4*)(rp + ((fq ^ (row & 7)) << 4)) = pack8(acc[ai][0][m][0], acc[ai][0][m][1]);
                    *(PG8_LAS u32x4*)(rp + (((4 + fq) ^ (row & 7)) << 4)) = pack8(acc[ai][1][m][0], acc[ai][1][m][1]); } }
            asm volatile("s_waitcnt lgkmcnt(0)" ::: "memory"); __builtin_amdgcn_s_barrier(); asm volatile("" ::: "memory");
            const int j0 = u.pn * HALF + s * 32 + cg8 * 4;
            const f32x4 ka0 = *(const f32x4*)(cw + j0), ka1 = *(const f32x4*)(cw + 2 * DFF + j0), ka2 = *(const f32x4*)(cw + 4 * DFF + j0), kab = *(const f32x4*)(cb + j0);
            const f32x4 kv0 = *(const f32x4*)(cw + DFF + j0), kv1 = *(const f32x4*)(cw + 3 * DFF + j0), kv2 = *(const f32x4*)(cw + 5 * DFF + j0), kvb = *(const f32x4*)(cb + DFF + j0);
#pragma unroll 1
            for (int i2 = 0; i2 < 4; ++i2) { const int row = rrow + 64 * i2, iloc = FFN_STEP * t + row;
                if (row >= 1 && row <= 254 && iloc <= SEQ) {
                    const PG8_LAS unsigned char* p0 = slab + (row - 1) * 128 + hoff; const PG8_LAS unsigned char* p1 = p0 + 128; const PG8_LAS unsigned char* p2 = p1 + 128;
                    const int s0 = (row - 1) & 7, s1 = row & 7, s2 = (row + 1) & 7;
                    const f32x4 a0 = up4(*(const PG8_LAS u32x2*)(p0 + ((chunk ^ s0) << 4))), a1 = up4(*(const PG8_LAS u32x2*)(p1 + ((chunk ^ s1) << 4))), a2 = up4(*(const PG8_LAS u32x2*)(p2 + ((chunk ^ s2) << 4)));
                    const f32x4 v0 = up4(*(const PG8_LAS u32x2*)(p0 + (((4 + chunk) ^ s0) << 4))), v1 = up4(*(const PG8_LAS u32x2*)(p1 + (((4 + chunk) ^ s1) << 4))), v2 = up4(*(const PG8_LAS u32x2*)(p2 + (((4 + chunk) ^ s2) << 4)));
                    const f32x4 ca = kab + ka0 * a0 + ka1 * a1 + ka2 * a2, cv = kvb + kv0 * v0 + kv1 * v1 + kv2 * v2;
                    f32x4 o;
#pragma unroll
                    for (int e = 0; e < 4; ++e) { const float x = ca[e]; const float z2 = 1.5957691216057308f * (x + 0.044715f * x * x * x); o[e] = x * __builtin_amdgcn_rcpf(1.0f + __expf(-z2)) * cv[e]; }
                    u32x2 w; w.x = cvt_pk_bf16(o[0], o[1]); w.y = cvt_pk_bf16(o[2], o[3]);
                    *(u32x2*)(act + (size_t)(b * SEQ + iloc - 1) * DFF + j0) = w;
                } }
            asm volatile("s_waitcnt lgkmcnt(0)" ::: "memory"); __builtin_amdgcn_s_barrier(); asm volatile("" ::: "memory");
        }
    }
};

struct EpiFfnD { static constexpr bool PERM = true, AFTER_DRAIN = true, RPT = true;
    bf16_t* act; const float* cw; const float* cb;
    typedef unsigned u32x2 __attribute__((ext_vector_type(2)));
    __device__ __forceinline__ static f32x4 up4(const u32x2 w) { return (f32x4){bflo(w.x), bfhi(w.x), bflo(w.y), bfhi(w.y)}; }
    __device__ __forceinline__ void operator()(AccT, const Unit&, int, int, int, int) const {}
    __device__ __forceinline__ void fused(AccT acc, const Unit& u, int wr, int wc, int fr, int fq, PG8_LAS unsigned char* lds, int wid, int lane) const {
        const int tid = threadIdx.x, cgp = tid & 31, rseg = tid >> 5;
        const int b = u.pm / FFN_TPB, t = u.pm - b * FFN_TPB;
        const int j0 = u.pn * HALF + 4 * cgp;
        const f32x4 ka0 = *(const f32x4*)(cw + j0), ka1 = *(const f32x4*)(cw + 2 * DFF + j0), ka2 = *(const f32x4*)(cw + 4 * DFF + j0), kab = *(const f32x4*)(cb + j0);
        const f32x4 kv0 = *(const f32x4*)(cw + DFF + j0), kv1 = *(const f32x4*)(cw + 3 * DFF + j0), kv2 = *(const f32x4*)(cw + 5 * DFF + j0), kvb = *(const f32x4*)(cb + DFF + j0);
        EPI_LOOP_AM { const int row = ai * HALF + wr * 64 + m * 16 + fr; PG8_LAS unsigned char* rp = lds + row * 512;
            EPI_LOOP_BJ { const int c16 = bj * 16 + wc * 4 + fq; *(PG8_LAS u32x4*)(rp + ((c16 ^ (row & 7)) << 4)) = pack8(acc[ai][bj][m][0], acc[ai][bj][m][1]); } }
        asm volatile("s_waitcnt lgkmcnt(0)" ::: "memory"); __builtin_amdgcn_s_barrier(); asm volatile("" ::: "memory");
        const int ca16 = cgp >> 1, hoff = (cgp & 1) * 8, r0 = 16 * rseg;
        auto rd = [&](int row, int c16) -> f32x4 { return up4(*(const PG8_LAS u32x2*)(lds + row * 512 + ((c16 ^ (row & 7)) << 4) + hoff)); };
        const int rm = r0 > 0 ? r0 - 1 : 0;
        f32x4 a0 = rd(rm, ca16), v0 = rd(rm, 16 + ca16), a1 = rd(r0, ca16), v1 = rd(r0, 16 + ca16);
#pragma unroll 4
        for (int i = 0; i < 16; ++i) { const int row = r0 + i, rn = row < 255 ? row + 1 : 255;
            const f32x4 a2 = rd(rn, ca16), v2 = rd(rn, 16 + ca16);
            const int iloc = FFN_STEP * t + row;
            if (row >= 1 && row <= 254 && iloc <= SEQ) {
                const f32x4 ca = kab + ka0 * a0 + ka1 * a1 + ka2 * a2, cv = kvb + kv0 * v0 + kv1 * v1 + kv2 * v2;
                f32x4 o;
#pragma unroll
                for (int e = 0; e < 4; ++e) { const float x = ca[e]; const float arg = x * __builtin_fmaf(x * x, -0.102943242f, -2.302208198f); o[e] = x * __builtin_amdgcn_rcpf(1.0f + __builtin_amdgcn_exp2f(arg)) * cv[e]; }
                u32x2 w; w.x = cvt_pk_bf16(o[0], o[1]); w.y = cvt_pk_bf16(o[2], o[3]);
                *(u32x2*)(act + (size_t)(b * SEQ + iloc - 1) * DFF + j0) = w; }
            a0 = a1; v0 = v1; a1 = a2; v1 = v2; }
        asm volatile("s_waitcnt lgkmcnt(0)" ::: "memory"); __builtin_amdgcn_s_barrier(); asm volatile("" ::: "memory");
    }
};
struct OneUnit { Unit u;
    __device__ bool next(int i, Unit& o) const { if (i) return false; o = u; return true; }
    __device__ __forceinline__ void a_ready(const Unit&) const {}
    __device__ __forceinline__ void done(const Unit&) const {}
};

template <class Epi, class Sched, bool ALIGN_EPI = true, bool SP2 = true>
__device__ __forceinline__ void gemm_phase(PG8_LAS unsigned char* lds, const Gemm g, const Sched& S, const Epi& E) {
    const int tid = threadIdx.x, wid = __builtin_amdgcn_readfirstlane(tid >> 6), lane = tid & 63, wr = wid >> 2, wc = wid & 3, fr = lane & 15, fq = lane >> 4;
    const int K = g.K, nt = K / BK;
    unsigned voffA[2], voffB[2];
#pragma unroll
    for (int i = 0; i < 2; ++i) { int R, C; stage_rc(tid * 16 + i * 8192, R, C); const int Rb = Epi::PERM ? ((R & ~31) + perm32(R & 31)) : R;
        voffA[i] = (unsigned)(R * K + C) * 2u; voffB[i] = (unsigned)(Rb * K + C) * 2u; }
    const size_t kstep = (size_t)(BK * 2);
    const size_t hstep = (size_t)HALF * K * 2;
    const size_t tstep = 2 * hstep;
    const unsigned ldsw = (unsigned)wid * 1024u;
    const int aoff = lds_byte(wr * 64 + fr, fq * 8), boff = lds_byte(wc * 32 + fr, fq * 8);
#define PG8_SA(b, h) (((b) * 2 + (h)) * HTB)
#define PG8_SB(b, h) ((4 + (b) * 2 + (h)) * HTB)
#define PG8_STAGE(bufoff, gbase, voff) do { _Pragma("unroll") for (int _i = 0; _i < 2; ++_i) \
        __builtin_amdgcn_global_load_lds((const unsigned*)((const char*)(gbase) + (voff)[_i]), (PG8_LAS unsigned*)(lds + (bufoff) + ldsw + _i * 8192), 16, 0, 0); } while (0)
#define PG8_LDA(dst, b, h) do { _Pragma("unroll") for (int m = 0; m < 4; ++m) _Pragma("unroll") for (int k = 0; k < 2; ++k) dst[m][k] = *(const PG8_LAS bf16x8*)(lds + PG8_SA(b, h) + aoff + m * 2048 + k * 1024); } while (0)
#define PG8_LDB(dst, b, h) do { _Pragma("unroll") for (int n = 0; n < 2; ++n) _Pragma("unroll") for (int k = 0; k < 2; ++k) dst[n][k] = *(const PG8_LAS bf16x8*)(lds + PG8_SB(b, h) + boff + n * 2048 + k * 1024); } while (0)
#define PG8_MMA(ai, bj, At, Bt) do { __builtin_amdgcn_s_setprio(1); _Pragma("unroll") for (int m = 0; m < 4; ++m) _Pragma("unroll") for (int n = 0; n < 2; ++n) _Pragma("unroll") for (int k = 0; k < 2; ++k) \
        acc[ai][bj][m][n] = __builtin_amdgcn_mfma_f32_16x16x32_bf16(Bt[n][k], At[m][k], acc[ai][bj][m][n], 0, 0, 0); __builtin_amdgcn_s_setprio(0); } while (0)
#define PG8_WAIT_V(n) asm volatile("s_waitcnt vmcnt(" #n ")" ::: "memory")
#define PG8_WAIT_L(n) asm volatile("s_waitcnt lgkmcnt(" #n ")" ::: "memory")
#define PG8_BAR __builtin_amdgcn_s_barrier()
#define PG8_SCHED __builtin_amdgcn_sched_barrier(0)
    Unit cur, nxt; int ui = 0;
    if (!S.next(0, cur)) return;
    f32x4 acc[2][2][4][2];
#pragma unroll
    for (int a = 0; a < 2; ++a)
#pragma unroll
        for (int b = 0; b < 2; ++b)
#pragma unroll
            for (int m = 0; m < 4; ++m)
#pragma unroll
                for (int n = 0; n < 2; ++n) acc[a][b][m][n] = (f32x4){0.f, 0.f, 0.f, 0.f};
    bf16x8 At[4][2], B0[2][2], B1[2][2];
    const size_t rowb = (size_t)K * 2; const char* cA = (const char*)g.A + (size_t)cur.arow * rowb; const char* cB = (const char*)g.Bt + (size_t)cur.pn * tstep;
    S.a_ready(cur);
    if constexpr (SP2) {
        PG8_STAGE(PG8_SB(0, 0), cB, voffB); PG8_STAGE(PG8_SB(0, 1), cB + hstep, voffB); PG8_STAGE(PG8_SA(0, 0), cA, voffA); PG8_STAGE(PG8_SA(0, 1), cA + hstep, voffA);
        if (wr == 1) PG8_BAR;
        PG8_WAIT_V(2); PG8_BAR;
        PG8_STAGE(PG8_SB(1, 0), cB + kstep, voffB); PG8_STAGE(PG8_SA(1, 0), cA + kstep, voffA); PG8_STAGE(PG8_SB(1, 1), cB + hstep + kstep, voffB);
        PG8_WAIT_V(6); PG8_BAR;
    } else {
        PG8_STAGE(PG8_SB(0, 0), cB, voffB); PG8_STAGE(PG8_SA(0, 0), cA, voffA); PG8_STAGE(PG8_SB(0, 1), cB + hstep, voffB); PG8_STAGE(PG8_SA(0, 1), cA + hstep, voffA);
        if (wr == 1) PG8_BAR;
        PG8_WAIT_V(4); PG8_BAR;
        PG8_STAGE(PG8_SB(1, 0), cB + kstep, voffB); PG8_STAGE(PG8_SA(1, 0), cA + kstep, voffA); PG8_STAGE(PG8_SB(1, 1), cB + hstep + kstep, voffB);
        PG8_WAIT_V(6); PG8_BAR;
    }
    for (;;) {
        const bool has_next = S.next(ui + 1, nxt);
        const char* nA = has_next ? (const char*)g.A + (size_t)nxt.arow * rowb : cA; const char* nB = has_next ? (const char*)g.Bt + (size_t)nxt.pn * tstep : cB;
        for (int t = 0; t < nt; t += 2) {
            const bool last = (t == nt - 2);
            const char* a1 = cA + (size_t)(t + 1) * kstep;
            const char* a2 = last ? nA : cA + (size_t)(t + 2) * kstep; const char* b2 = last ? nB : cB + (size_t)(t + 2) * kstep;
            const char* a3 = a2 + kstep; const char* b3 = b2 + kstep;
            if (last && has_next) S.a_ready(nxt);
            if constexpr (SP2) {
            PG8_LDB(B0, 0, 0); PG8_LDB(B1, 0, 1); PG8_SCHED; PG8_LDA(At, 0, 0); PG8_STAGE(PG8_SA(1, 1), a1 + hstep, voffA);
            PG8_WAIT_V(8); PG8_WAIT_L(0); PG8_BAR; PG8_MMA(0, 0, At, B0); PG8_MMA(0, 1, At, B1); PG8_BAR; PG8_SCHED;
            PG8_LDA(At, 0, 1); PG8_STAGE(PG8_SB(0, 0), b2, voffB); PG8_STAGE(PG8_SB(0, 1), b2 + hstep, voffB); PG8_STAGE(PG8_SA(0, 0), a2, voffA);
            PG8_WAIT_V(8); PG8_WAIT_L(0); PG8_BAR; PG8_MMA(1, 0, At, B0); PG8_MMA(1, 1, At, B1); PG8_BAR; PG8_SCHED;
            PG8_LDB(B0, 1, 0); PG8_LDB(B1, 1, 1); PG8_SCHED; PG8_LDA(At, 1, 0); PG8_STAGE(PG8_SA(0, 1), a2 + hstep, voffA);
            PG8_WAIT_V(8); PG8_WAIT_L(0); PG8_BAR; PG8_MMA(0, 0, At, B0); PG8_MMA(0, 1, At, B1); PG8_BAR; PG8_SCHED;
            PG8_LDA(At, 1, 1); PG8_STAGE(PG8_SB(1, 0), b3, voffB); PG8_STAGE(PG8_SB(1, 1), b3 + hstep, voffB); PG8_STAGE(PG8_SA(1, 0), a3, voffA);
            PG8_WAIT_V(8); PG8_WAIT_L(0); PG8_BAR; PG8_MMA(1, 0, At, B0); PG8_MMA(1, 1, At, B1); PG8_BAR; PG8_SCHED;
            } else {
            PG8_LDB(B0, 0, 0); PG8_SCHED; PG8_LDA(At, 0, 0); PG8_STAGE(PG8_SA(1, 1), a1 + hstep, voffA);
            PG8_WAIT_L(8); PG8_BAR; PG8_WAIT_L(0); PG8_MMA(0, 0, At, B0); PG8_BAR; PG8_SCHED;
            PG8_LDB(B1, 0, 1); PG8_STAGE(PG8_SB(0, 0), b2, voffB);
            PG8_BAR; PG8_WAIT_L(0); PG8_MMA(0, 1, At, B1); PG8_BAR;
            PG8_LDA(At, 0, 1); PG8_STAGE(PG8_SA(0, 0), a2, voffA);
            PG8_BAR; PG8_WAIT_L(0); PG8_MMA(1, 0, At, B0); PG8_BAR; PG8_SCHED;
            PG8_STAGE(PG8_SB(0, 1), b2 + hstep, voffB);
            PG8_WAIT_V(6); PG8_BAR; PG8_MMA(1, 1, At, B1); PG8_BAR;
            PG8_LDB(B0, 1, 0); PG8_SCHED; PG8_LDA(At, 1, 0); PG8_STAGE(PG8_SA(0, 1), a2 + hstep, voffA);
            PG8_WAIT_L(8); PG8_BAR; PG8_WAIT_L(0); PG8_MMA(0, 0, At, B0); PG8_BAR; PG8_SCHED;
            PG8_LDB(B1, 1, 1); PG8_STAGE(PG8_SB(1, 0), b3, voffB);
            PG8_BAR; PG8_WAIT_L(0); PG8_MMA(0, 1, At, B1); PG8_BAR;
            PG8_LDA(At, 1, 1); PG8_STAGE(PG8_SA(1, 0), a3, voffA);
            PG8_BAR; PG8_WAIT_L(0); PG8_MMA(1, 0, At, B0); PG8_BAR; PG8_SCHED;
            PG8_STAGE(PG8_SB(1, 1), b3 + hstep, voffB);
            PG8_WAIT_V(6); PG8_BAR; PG8_MMA(1, 1, At, B1); PG8_BAR;
            }
        }
        if constexpr (ALIGN_EPI) { if (wr == 0) PG8_BAR; }
        if constexpr (!Epi::AFTER_DRAIN) { E(acc, cur, wr, wc, fr, fq);
            S.done(cur); }
        if (!has_next) break;
#pragma unroll
        for (int a = 0; a < 2; ++a)
#pragma unroll
            for (int b = 0; b < 2; ++b)
#pragma unroll
                for (int m = 0; m < 4; ++m)
#pragma unroll
                    for (int n = 0; n < 2; ++n) acc[a][b][m][n] = (f32x4){0.f, 0.f, 0.f, 0.f};
        cur = nxt; cA = nA; cB = nB; ++ui;
        if constexpr (ALIGN_EPI) { if (wr == 1) PG8_BAR; }
    }
    PG8_WAIT_V(0);
    if constexpr (!ALIGN_EPI) { if (wr == 0) PG8_BAR; }
    PG8_BAR;
    if constexpr (Epi::AFTER_DRAIN) { E.fused(acc, cur, wr, wc, fr, fq, lds, wid, lane); S.done(cur); }
#undef PG8_SA
#undef PG8_SB
#undef PG8_STAGE
#undef PG8_LDA
#undef PG8_LDB
#undef PG8_MMA
#undef PG8_WAIT_V
#undef PG8_WAIT_L
#undef PG8_BAR
#undef PG8_SCHED
}
}

constexpr int NWAVES = 8;
constexpr int LDS_BYTES = 163840;
constexpr size_t MiB = 1u << 20;
constexpr size_t WS_WIN = 1 * MiB, WS_WEFF = 9 * MiB, WS_WCO = 11 * MiB, WS_WOUT = 12 * MiB, WS_WUP = 14 * MiB, WS_WDN = 25 * MiB;
constexpr size_t WS_H = 32 * MiB;
constexpr size_t WS_PROJ = 161 * MiB;
constexpr size_t WS_H2 = 161 * MiB;
constexpr size_t WS_ACT = 300 * MiB;
constexpr size_t WS_ZB = 675 * MiB;
constexpr size_t WS_F = 740 * MiB;
constexpr size_t WS_MG = 869 * MiB;
constexpr size_t WS_NEED = 1000 * MiB;
constexpr size_t DO_DM = 0, DO_UT = 8 * MiB, DO_S = 96 * MiB;
static_assert((size_t)2 * KH * KD * 2 <= DO_UT && DO_UT + (size_t)2 * NCOL * KD * 2 <= DO_S && DO_S + (size_t)2 * KH * NCOL * 2 <= 256 * MiB, "d_out scratch map");
static_assert(WS_H + (size_t)R_TOT * DM * 2 <= WS_PROJ && WS_PROJ + (size_t)R_TOT * INC * 2 <= WS_ZB && WS_ZB + (size_t)R_TOT * 512 * 2 <= WS_F && WS_F + (size_t)R_TOT * DM * 2 <= WS_MG && WS_MG + (size_t)R_TOT * DM * 2 <= WS_NEED, "ws map 1");
static_assert(WS_H2 + (size_t)NB * pg8::H2F_PITCH * DM * 2 <= WS_ACT && WS_ACT + (size_t)65536 * DFF * 2 <= WS_MG, "ws map 2");

#define LAS __attribute__((address_space(3)))
typedef unsigned short bf16;
typedef unsigned v4u __attribute__((ext_vector_type(4)));
typedef unsigned v2u __attribute__((ext_vector_type(2)));
typedef float f32x4 __attribute__((ext_vector_type(4)));
#define LDS_WAIT() asm volatile("s_waitcnt lgkmcnt(0)" ::: "memory")
using pg8::cvt_pk_bf16; using pg8::bflo; using pg8::bfhi;

__device__ __forceinline__ float wave_sum(float v) {
#pragma unroll
    for (int o = 1; o < 64; o <<= 1) v += __shfl_xor(v, o);
    return v;
}
__device__ __forceinline__ void unpack8f(const v4u w, float (&f)[8]) { f[0] = bflo(w.x); f[1] = bfhi(w.x); f[2] = bflo(w.y); f[3] = bfhi(w.y); f[4] = bflo(w.z); f[5] = bfhi(w.z); f[6] = bflo(w.w); f[7] = bfhi(w.w); }
__device__ __forceinline__ v4u pack8f(const float (&f)[8]) { v4u w; w.x = cvt_pk_bf16(f[0], f[1]); w.y = cvt_pk_bf16(f[2], f[3]); w.z = cvt_pk_bf16(f[4], f[5]); w.w = cvt_pk_bf16(f[6], f[7]); return w; }
__device__ __forceinline__ void load8f_nt(const float* p, float (&f)[8]) { const f32x4 a = __builtin_nontemporal_load((const f32x4*)p), b = __builtin_nontemporal_load((const f32x4*)(p + 4)); f[0] = a.x; f[1] = a.y; f[2] = a.z; f[3] = a.w; f[4] = b.x; f[5] = b.y; f[6] = b.z; f[7] = b.w; }
__device__ __forceinline__ void load8f(const float* p, float (&f)[8]) { const f32x4 a = *(const f32x4*)p, b = *(const f32x4*)(p + 4); f[0] = a.x; f[1] = a.y; f[2] = a.z; f[3] = a.w; f[4] = b.x; f[5] = b.y; f[6] = b.z; f[7] = b.w; }

struct Args { const float* in[17]; float* out; unsigned char* ws; int ph_lo, ph_hi; };
enum { I_X = 0, I_META, I_GMIXPRE, I_WIN, I_BGATES, I_WFOURIER, I_CWMIX, I_CBMIX, I_WCONVOUT, I_WOUT, I_GMIXPOST, I_GFFNPRE, I_WUP, I_CWFFN, I_CBFFN, I_WDOWN, I_GFFNPOST };

__device__ __forceinline__ void p0_transpose_item(const float* __restrict__ W, int K, int N, bf16* __restrict__ WT, int k0, int n0, int drow0, LAS float* scr, int lane) {
    f32x4 tv[8];
#pragma unroll
    for (int i = 0; i < 8; ++i) tv[i] = *(const f32x4*)(W + (size_t)(k0 + i * 8 + (lane >> 3)) * N + n0 + 4 * (lane & 7));
#pragma unroll
    for (int i = 0; i < 8; ++i) { LAS float* d = scr + (i * 8 + (lane >> 3)) * 33 + 4 * (lane & 7); d[0] = tv[i].x; d[1] = tv[i].y; d[2] = tv[i].z; d[3] = tv[i].w; }
    LDS_WAIT();
    const int c = lane & 7;
#pragma unroll
    for (int j = 0; j < 4; ++j) { const int n = (lane >> 3) + 8 * j; const LAS float* s = scr + (8 * c) * 33 + n;
        v4u o; o.x = cvt_pk_bf16(s[0 * 33], s[1 * 33]); o.y = cvt_pk_bf16(s[2 * 33], s[3 * 33]); o.z = cvt_pk_bf16(s[4 * 33], s[5 * 33]); o.w = cvt_pk_bf16(s[6 * 33], s[7 * 33]);
        *(v4u*)(WT + (size_t)(drow0 + n) * K + k0 + 8 * c) = o; }
    LDS_WAIT();
}
__device__ __forceinline__ int wup_drow(int n0) { return n0 < DFF ? 256 * (n0 >> 7) + (n0 & 127) : 256 * ((n0 - DFF) >> 7) + 128 + ((n0 - DFF) & 127); }

__device__ __forceinline__ void phase0(const Args& a, LAS unsigned char* lds, int gw, int NGW, int wave, int lane) {
    unsigned char* ws = a.ws;
    LAS float* scr = (LAS float*)(lds + wave * 16384);
    constexpr int T_IN = 16 * 128, T_CO = 8 * 32, T_OUT = 16 * 32, T_UP = 16 * 176, T_DN = 44 * 32, T_ALL = T_IN + T_CO + T_OUT + T_UP + T_DN;
    for (int it = gw; it < T_ALL; it += NGW) {
        int r = it;
        if (r < T_IN) { const int kb = r / 128, nb = r % 128; p0_transpose_item(a.in[I_WIN], DM, INC, (bf16*)(ws + WS_WIN), kb * 64, nb * 32, nb * 32, scr, lane); continue; } r -= T_IN;
        if (r < T_CO) { const int kb = r / 32, nb = r % 32; p0_transpose_item(a.in[I_WCONVOUT], 512, DM, (bf16*)(ws + WS_WCO), kb * 64, nb * 32, nb * 32, scr, lane); continue; } r -= T_CO;
        if (r < T_OUT) { const int kb = r / 32, nb = r % 32; p0_transpose_item(a.in[I_WOUT], DM, DM, (bf16*)(ws + WS_WOUT), kb * 64, nb * 32, nb * 32, scr, lane); continue; } r -= T_OUT;
        if (r < T_UP) { const int kb = r / 176, nb = r % 176; p0_transpose_item(a.in[I_WUP], DM, 2 * DFF, (bf16*)(ws + WS_WUP), kb * 64, nb * 32, wup_drow(nb * 32), scr, lane); continue; } r -= T_UP;
        { const int kb = r / 32, nb = r % 32; p0_transpose_item(a.in[I_WDOWN], DFF, DM, (bf16*)(ws + WS_WDN), kb * 64, nb * 32, nb * 32, scr, lane); }
    }
    { const float* wf = a.in[I_WFOURIER]; bf16* we = (bf16*)(ws + WS_WEFF);
      for (int it = gw; it < 8192; it += NGW) { const int jb = it & 15, c = (it >> 4) & 127, g = it >> 11, j = jb * 64 + lane;
          float ac = 0.f, as = 0.f;
#pragma unroll 32
          for (int cp = 0; cp < 128; ++cp) { const float w = wf[(size_t)(g * 128 + cp) * DM + j]; const float ph = (float)((c * cp) & 127) * (1.0f / 128.0f);
              ac += __builtin_amdgcn_cosf(ph) * w; as += __builtin_amdgcn_sinf(ph) * w; }
          const float s = 0.08838834764831845f;
          we[(size_t)j * DM + g * 128 + c] = (bf16)(cvt_pk_bf16(ac * s, 0.f) & 0xffffu); we[(size_t)j * DM + 512 + g * 128 + c] = (bf16)(cvt_pk_bf16(as * s, 0.f) & 0xffffu); } }
    { bf16* dmat = (bf16*)((unsigned char*)a.out + DO_DM); constexpr int CPR = KD / 8;
      for (int it = gw; it < 2 * KH * CPR / 64; it += NGW) { const int chunk = it * 64 + lane, row = chunk / CPR, ci = chunk - row * CPR, n0 = ci * 8, part = row >= KH, k = row - part * KH;
          int mm = (int)(((unsigned)k * (unsigned)n0) % (unsigned)QL); const int kq = k % QL; float f[8];
#pragma unroll
          for (int i = 0; i < 8; ++i) { const float ph = (float)mm * (1.0f / (float)QL); const float v = part ? -__builtin_amdgcn_sinf(ph) : __builtin_amdgcn_cosf(ph);
              f[i] = (n0 + i <= QH) ? v * 0.011037770f : 0.f; mm += kq; if (mm >= QL) mm -= QL; }
          *(v4u*)(dmat + (size_t)row * KD + n0) = pack8f(f); } }
    { const float* g = a.in[I_GMIXPRE]; bf16* h = (bf16*)(ws + WS_H);
      f32x4 gv[4];
#pragma unroll
      for (int j = 0; j < 4; ++j) gv[j] = ((const f32x4*)g)[lane + 64 * j];
      for (int r0 = gw; r0 < R_TOT; r0 += 2 * NGW) {
          f32x4 v[2][4]; float s2[2];
#pragma unroll
          for (int q = 0; q < 2; ++q) { const int r = r0 + q * NGW; s2[q] = 0.f;
              if (r < R_META + NB * NMETA) { const float* src = r < R_META ? a.in[I_X] + (size_t)r * DM : a.in[I_META] + (size_t)((r - R_META) & 15) * DM;
#pragma unroll
                  for (int j = 0; j < 4; ++j) v[q][j] = ((const f32x4*)src)[lane + 64 * j]; }
              else {
#pragma unroll
                  for (int j = 0; j < 4; ++j) v[q][j] = (f32x4){0.f, 0.f, 0.f, 0.f}; } }
#pragma unroll
          for (int q = 0; q < 2; ++q) {
#pragma unroll
              for (int j = 0; j < 4; ++j) s2[q] += (v[q][j].x * v[q][j].x + v[q][j].y * v[q][j].y) + (v[q][j].z * v[q][j].z + v[q][j].w * v[q][j].w); }
#pragma unroll
          for (int q = 0; q < 2; ++q) { const int r = r0 + q * NGW; if (r >= R_TOT) continue;
              const float rstd = rsqrtf(wave_sum(s2[q]) * (1.0f / DM) + RMS_EPS);
              unsigned long long* o8 = (unsigned long long*)(h + (size_t)r * DM) + lane;
#pragma unroll
              for (int j = 0; j < 4; ++j) { const f32x4 o = v[q][j] * rstd * gv[j]; o8[64 * j] = (unsigned long long)cvt_pk_bf16(o.x, o.y) | ((unsigned long long)cvt_pk_bf16(o.z, o.w) << 32); } }
      } }
}

__device__ __forceinline__ void phase2(const Args& a, LAS unsigned char* lds, int gw, int NGW, int wave, int lane) {
    unsigned char* ws = a.ws; const bf16* proj = (const bf16*)(ws + WS_PROJ);
    { bf16* eT = (bf16*)((unsigned char*)a.out + DO_UT); bf16* oT = eT + (size_t)NCOL * KD;
      LAS bf16* scrE = (LAS bf16*)(lds + wave * 16896); LAS bf16* scrO = scrE + 64 * 66;
      constexpr int NBLK = KD / 64;
      for (int it = gw; it < 4 * NB * 8 * NBLK; it += NGW) { const int nblk = it % NBLK, cb = (it / NBLK) & 7, b = (it / (8 * NBLK)) & 7, r = it / (64 * NBLK);
#pragma unroll
          for (int i = 0; i < 8; ++i) { const int nl = i * 8 + (lane >> 3), mh = nblk * 64 + nl, chunk = lane & 7;
              float e[8], o[8];
#pragma unroll
              for (int j = 0; j < 8; ++j) { e[j] = 0.f; o[j] = 0.f; }
              if (mh <= QH) { unpack8f(*(const v4u*)(proj + (size_t)row_of(b, 4 * mh + r) * INC + cb * 64 + chunk * 8), e);
                  if (mh >= 1 && mh < QH) { float u2[8]; unpack8f(*(const v4u*)(proj + (size_t)row_of(b, LSEQ - 4 * mh + r) * INC + cb * 64 + chunk * 8), u2);
#pragma unroll
                      for (int j = 0; j < 8; ++j) { o[j] = e[j] - u2[j]; e[j] = e[j] + u2[j]; } } }
              LAS bf16* dE = scrE + (chunk * 8) * 66 + nl; LAS bf16* dO = scrO + (chunk * 8) * 66 + nl;
#pragma unroll
              for (int j = 0; j < 8; ++j) { const unsigned w = cvt_pk_bf16(e[j], o[j]); dE[j * 66] = (bf16)(w & 0xffffu); dO[j * 66] = (bf16)(w >> 16); } }
          LDS_WAIT();
#pragma unroll
          for (int i = 0; i < 8; ++i) { const int ch = i * 8 + (lane >> 3), nc = lane & 7; const size_t off = (size_t)(r * 4096 + b * 512 + cb * 64 + ch) * KD + nblk * 64 + nc * 8;
              const LAS unsigned* se = (const LAS unsigned*)(scrE + ch * 66 + nc * 8); const LAS unsigned* so = (const LAS unsigned*)(scrO + ch * 66 + nc * 8);
              v4u w; w.x = se[0]; w.y = se[1]; w.z = se[2]; w.w = se[3]; *(v4u*)(eT + off) = w;
              w.x = so[0]; w.y = so[1]; w.z = so[2]; w.w = so[3]; *(v4u*)(oT + off) = w; }
          LDS_WAIT(); } }
    { bf16* zb = (bf16*)(ws + WS_ZB); const float* cw = a.in[I_CWMIX]; const float* cbias = a.in[I_CBMIX];
      float w0[8], w1[8], w2[8], bb[8]; const int ch0 = lane * 8;
      load8f(cw + ch0, w0); load8f(cw + 512 + ch0, w1); load8f(cw + 1024 + ch0, w2); load8f(cbias + ch0, bb);
      for (int it = gw; it < NB * LSEQ; it += NGW) { const int b = it / LSEQ, p = it - b * LSEQ; const size_t r = (size_t)row_of(b, p);
          float cc[8], vv[8], bg[8], acc[8];
          unpack8f(*(const v4u*)(proj + r * INC + 512 + ch0), cc); unpack8f(*(const v4u*)(proj + r * INC + 1536 + ch0), vv); unpack8f(*(const v4u*)(proj + r * INC + 1024 + ch0), bg);
#pragma unroll
          for (int e = 0; e < 8; ++e) acc[e] = bb[e] + w1[e] * (cc[e] * vv[e]);
          if (p > 0) { const size_t rp = (size_t)row_of(b, p - 1); unpack8f(*(const v4u*)(proj + rp * INC + 512 + ch0), cc); unpack8f(*(const v4u*)(proj + rp * INC + 1536 + ch0), vv);
#pragma unroll
              for (int e = 0; e < 8; ++e) acc[e] += w0[e] * (cc[e] * vv[e]); }
          if (p < LSEQ - 1) { const size_t rn = (size_t)row_of(b, p + 1); unpack8f(*(const v4u*)(proj + rn * INC + 512 + ch0), cc); unpack8f(*(const v4u*)(proj + rn * INC + 1536 + ch0), vv);
#pragma unroll
              for (int e = 0; e < 8; ++e) acc[e] += w2[e] * (cc[e] * vv[e]); }
#pragma unroll
          for (int e = 0; e < 8; ++e) acc[e] *= bg[e];
          *(v4u*)(zb + r * 512 + ch0) = pack8f(acc); } }
}

template <int EPL> __device__ __forceinline__ void sk_load(unsigned (&a)[8][EPL / 2], const bf16* A, int lda, int row0, int rstride, int lane) {
#pragma unroll
    for (int r = 0; r < 8; ++r) { const v4u* p = (const v4u*)(A + (size_t)(row0 + r * rstride) * lda + lane * EPL);
#pragma unroll
        for (int i = 0; i < EPL / 8; ++i) { const v4u w = p[i]; a[r][4 * i] = w.x; a[r][4 * i + 1] = w.y; a[r][4 * i + 2] = w.z; a[r][4 * i + 3] = w.w; } }
}
template <int EPL> __device__ __forceinline__ float sk_dot(const unsigned (&a)[8][EPL / 2], const bf16* btrow, int lane) {
    unsigned b[EPL / 2];
#pragma unroll
    for (int i = 0; i < EPL / 8; ++i) { const v4u w = ((const v4u*)(btrow + lane * EPL))[i]; b[4 * i] = w.x; b[4 * i + 1] = w.y; b[4 * i + 2] = w.z; b[4 * i + 3] = w.w; }
    float acc[8];
#pragma unroll
    for (int r = 0; r < 8; ++r) acc[r] = 0.f;
#pragma unroll
    for (int i = 0; i < EPL / 2; ++i) { const float bl = bflo(b[i]), bh = bfhi(b[i]);
#pragma unroll
        for (int r = 0; r < 8; ++r) acc[r] += bflo(a[r][i]) * bl + bfhi(a[r][i]) * bh; }
    float res = 0.f;
#pragma unroll
    for (int r = 0; r < 8; ++r) { const float t = wave_sum(acc[r]); res = (lane == r) ? t : res; }
    return res;
}
__device__ __forceinline__ bf16 f2bf1(float v) { return (bf16)(cvt_pk_bf16(v, 0.f) & 0xffffu); }
__device__ __forceinline__ float bf2f1(bf16 h) { return __uint_as_float((unsigned)h << 16); }
constexpr int EDGE_ROW0 = R_META + NMETA - 1;

__device__ __forceinline__ void p1_meta(const Args& a, int gw, int NGW, int lane) {
    unsigned char* ws = a.ws; const bf16* h = (const bf16*)(ws + WS_H); const bf16* wt = (const bf16*)(ws + WS_WIN); bf16* proj = (bf16*)(ws + WS_PROJ); const float* bg = a.in[I_BGATES];
#pragma unroll 1
    for (int rg = 0; rg < 2; ++rg) { unsigned av[8][8]; sk_load<16>(av, h, DM, R_META + rg * 8, 1, lane);
#pragma unroll 1
        for (int j = gw; j < INC; j += NGW) { float v = sk_dot<16>(av, wt + (size_t)j * DM, lane);
            if (lane < 8) { if (j >= 2048) v = pg8::sigmoidf_(v + bg[j - 2048]); const bf16 o = f2bf1(v); const int pp = rg * 8 + lane;
#pragma unroll
                for (int b = 0; b < NB; ++b) proj[(size_t)(R_META + b * NMETA + pp) * INC + j] = o; } } }
}
__device__ __forceinline__ void p4_edge(const Args& a, int gw, int lane) {
    if (gw >= DM) return;
    unsigned char* ws = a.ws; const bf16* proj = (const bf16*)(ws + WS_PROJ); bf16* mg = (bf16*)(ws + WS_MG);
    unsigned aF[8][8], aZ[8][4]; sk_load<16>(aF, (const bf16*)(ws + WS_F), DM, EDGE_ROW0, NMETA, lane); sk_load<8>(aZ, (const bf16*)(ws + WS_ZB), 512, EDGE_ROW0, NMETA, lane);
    const int j = gw;
    const float ya = sk_dot<16>(aF, (const bf16*)(ws + WS_WEFF) + (size_t)j * DM, lane), yb = sk_dot<8>(aZ, (const bf16*)(ws + WS_WCO) + (size_t)j * 512, lane);
    if (lane < 8) { const size_t r = (size_t)(EDGE_ROW0 + lane * NMETA); mg[r * DM + j] = f2bf1(bf2f1(proj[r * INC + 2048 + j]) * ya + bf2f1(proj[r * INC + 3072 + j]) * yb); }
}
__device__ __forceinline__ void edge_gemm(const bf16* A, const bf16* Bt, int N, bf16* O, int ldo, int orow0, int ostride, int gw, int NGW, int lane) {
    if (gw >= N) return;
    unsigned av[8][8]; sk_load<16>(av, A, DM, EDGE_ROW0, NMETA, lane);
#pragma unroll 1
    for (int j = gw; j < N; j += NGW) { const float v = sk_dot<16>(av, Bt + (size_t)j * DM, lane);
        if (lane < 8) O[(size_t)(orow0 + lane * ostride) * ldo + j] = f2bf1(v); }
}

__device__ __forceinline__ void dft_tail(const Args& a, int gw, int NGW, int lane) {
    const bf16* dm = (const bf16*)((unsigned char*)a.out + DO_DM); const bf16* eT = (const bf16*)((unsigned char*)a.out + DO_UT); const bf16* oT = eT + (size_t)NCOL * KD;
    bf16* S = (bf16*)((unsigned char*)a.out + DO_S);
    for (int col = gw; col < NCOL; col += NGW) {
        float se[3], so[3];
#pragma unroll
        for (int kx = 0; kx < 3; ++kx) { se[kx] = 0.f; so[kx] = 0.f; }
#pragma unroll
        for (int it = 0; it < 3; ++it) { const int off = it * 512 + lane * 8;
            if (off < KD) { float ev[8], ov[8]; unpack8f(*(const v4u*)(eT + (size_t)col * KD + off), ev); unpack8f(*(const v4u*)(oT + (size_t)col * KD + off), ov);
#pragma unroll
                for (int kx = 0; kx < 3; ++kx) { float c[8], sn[8]; unpack8f(*(const v4u*)(dm + (size_t)(1024 + kx) * KD + off), c); unpack8f(*(const v4u*)(dm + (size_t)(KH + 1024 + kx) * KD + off), sn);
#pragma unroll
                    for (int e = 0; e < 8; ++e) { se[kx] += ev[e] * c[e]; so[kx] += ov[e] * sn[e]; } } } }
        float ve = 0.f, vo = 0.f;
#pragma unroll
        for (int kx = 0; kx < 3; ++kx) { const float te = wave_sum(se[kx]), to = wave_sum(so[kx]); if (lane == kx) { ve = te; vo = to; } }
        if (lane < 3) { const unsigned w = cvt_pk_bf16(ve, vo);
            S[(size_t)(1024 + lane) * NCOL + col] = (bf16)(w & 0xffffu); S[(size_t)(KH + 1024 + lane) * NCOL + col] = (bf16)(w >> 16); }
    }
}
__device__ __forceinline__ void dft_combine(const Args& a, int gw, int NGW, int lane) {
    const bf16* S = (const bf16*)((unsigned char*)a.out + DO_S); bf16* F = (bf16*)(a.ws + WS_F);
    const int ch0 = lane * 8;
    for (int it = gw; it < NB * (NHALF + 1); it += NGW) { const int b = it / (NHALF + 1), k = it - b * (NHALF + 1);
        int k1 = k % QL; float sg = 1.f; if (k1 > QH) { k1 = QL - k1; sg = -1.f; }
        float ar[8], ai[8];
#pragma unroll
        for (int e = 0; e < 8; ++e) { ar[e] = 0.f; ai[e] = 0.f; }
#pragma unroll
        for (int r = 0; r < 4; ++r) { float re[8], im[8];
            unpack8f(*(const v4u*)(S + (size_t)k1 * NCOL + r * 4096 + b * 512 + ch0), re); unpack8f(*(const v4u*)(S + (size_t)(KH + k1) * NCOL + r * 4096 + b * 512 + ch0), im);
            const float ph = (float)((r * k) % LSEQ) * (1.0f / (float)LSEQ); const float c = __builtin_amdgcn_cosf(ph), sn = __builtin_amdgcn_sinf(ph);
#pragma unroll
            for (int e = 0; e < 8; ++e) { const float x = re[e], y = sg * im[e]; ar[e] += c * x + sn * y; ai[e] += c * y - sn * x; } }
        *(v4u*)(F + (size_t)row_of(b, k) * DM + ch0) = pack8f(ar); *(v4u*)(F + (size_t)row_of(b, k) * DM + 512 + ch0) = pack8f(ai);
        if (k >= 1 && k < NHALF) {
#pragma unroll
            for (int e = 0; e < 8; ++e) ai[e] = -ai[e];
            *(v4u*)(F + (size_t)row_of(b, LSEQ - k) * DM + ch0) = pack8f(ar); *(v4u*)(F + (size_t)row_of(b, LSEQ - k) * DM + 512 + ch0) = pack8f(ai); }
    }
}

__device__ __forceinline__ void phase6(const Args& a, int gw, int NGW, int lane) {
    unsigned char* ws = a.ws; const bf16* mix = (const bf16*)(ws + WS_H); bf16* h2 = (bf16*)(ws + WS_H2); bf16* hres = (bf16*)(ws + WS_F);
    float g1[2][8], g2[2][8];
#pragma unroll
    for (int j = 0; j < 2; ++j) { load8f(a.in[I_GMIXPOST] + 8 * lane + 512 * j, g1[j]); load8f(a.in[I_GFFNPRE] + 8 * lane + 512 * j, g2[j]); }
    constexpr int NR = R_META + 2 * NB;
    for (int r0 = gw; r0 < NR; r0 += 2 * NGW) {
        float mv[2][2][8], xv[2][2][8];
#pragma unroll
        for (int q = 0; q < 2; ++q) { int ri = (r0 + q * NGW < NR) ? r0 + q * NGW : r0; if (ri >= R_META + NB) ri = R_META;
            const int r = ri < R_META ? ri : EDGE_ROW0 + (ri - R_META) * NMETA;
            const float* src = r < R_META ? a.in[I_X] + (size_t)r * DM : a.in[I_META] + (size_t)(NMETA - 1) * DM;
#pragma unroll
            for (int j = 0; j < 2; ++j) { unpack8f(*(const v4u*)(mix + (size_t)r * DM + 8 * lane + 512 * j), mv[q][j]); load8f(src + 8 * lane + 512 * j, xv[q][j]); } }
#pragma unroll
        for (int q = 0; q < 2; ++q) { const int ri = r0 + q * NGW; if (ri >= NR) continue;
            const size_t orow = ri < R_META ? (size_t)(ri >> 13) * pg8::H2F_PITCH + (ri & 8191) + 1 : (ri < R_META + NB ? (size_t)(ri - R_META) * pg8::H2F_PITCH : (size_t)(ri - R_META - NB) * pg8::H2F_PITCH + SEQ + 1);
            if (ri >= R_META + NB) {
#pragma unroll
                for (int j = 0; j < 2; ++j) *(v4u*)(h2 + orow * DM + 8 * lane + 512 * j) = (v4u){0u, 0u, 0u, 0u};
                continue; }
            float s = 0.f;
#pragma unroll
            for (int j = 0; j < 2; ++j)
#pragma unroll
                for (int e = 0; e < 8; ++e) s += mv[q][j][e] * mv[q][j][e];
            const float r1 = rsqrtf(wave_sum(s) * (1.0f / DM) + RMS_EPS); float s2 = 0.f;
#pragma unroll
            for (int j = 0; j < 2; ++j)
#pragma unroll
                for (int e = 0; e < 8; ++e) { const float hr = xv[q][j][e] + mv[q][j][e] * r1 * g1[j][e]; xv[q][j][e] = hr; s2 += hr * hr; }
            const float r2 = rsqrtf(wave_sum(s2) * (1.0f / DM) + RMS_EPS);
#pragma unroll
            for (int j = 0; j < 2; ++j) { float o[8];
#pragma unroll
                for (int e = 0; e < 8; ++e) o[e] = xv[q][j][e] * r2 * g2[j][e];
                *(v4u*)(h2 + orow * DM + 8 * lane + 512 * j) = pack8f(o);
                if (ri < R_META) *(v4u*)(hres + (size_t)ri * DM + 8 * lane + 512 * j) = pack8f(xv[q][j]); } }
    }
}

__device__ __forceinline__ void phase10(const Args& a, int gw, int NGW, int lane) {
    unsigned char* ws = a.ws; const bf16* hres = (const bf16*)(ws + WS_F); const bf16* ffn = (const bf16*)(ws + WS_MG);
    float g3[2][8];
#pragma unroll
    for (int j = 0; j < 2; ++j) load8f(a.in[I_GFFNPOST] + 8 * lane + 512 * j, g3[j]);
    for (int r0 = gw; r0 < R_META; r0 += 4 * NGW) {
        float hv[4][2][8], fv[4][2][8];
#pragma unroll
        for (int q = 0; q < 4; ++q) { const int r = (r0 + q * NGW < R_META) ? r0 + q * NGW : r0;
#pragma unroll
            for (int j = 0; j < 2; ++j) { const size_t off = (size_t)r * DM + 8 * lane + 512 * j; unpack8f(*(const v4u*)(hres + off), hv[q][j]); unpack8f(*(const v4u*)(ffn + off), fv[q][j]); } }
#pragma unroll
        for (int q = 0; q < 4; ++q) { const int r = r0 + q * NGW; if (r >= R_META) continue;
            float s3 = 0.f;
#pragma unroll
            for (int j = 0; j < 2; ++j)
#pragma unroll
                for (int e = 0; e < 8; ++e) s3 += fv[q][j][e] * fv[q][j][e];
            const float r3 = rsqrtf(wave_sum(s3) * (1.0f / DM) + RMS_EPS);
#pragma unroll
            for (int j = 0; j < 2; ++j) { float o[8];
#pragma unroll
                for (int e = 0; e < 8; ++e) o[e] = hv[q][j][e] + fv[q][j][e] * r3 * g3[j][e];
                float* op = a.out + (size_t)r * DM + 8 * lane + 512 * j;
                __builtin_nontemporal_store((f32x4){o[0], o[1], o[2], o[3]}, (f32x4*)op); __builtin_nontemporal_store((f32x4){o[4], o[5], o[6], o[7]}, (f32x4*)(op + 4)); } }
    }
}

#define XB_TMO      128
#define XB_XCNT(j)  (256  + 64 * (j))
#define XB_XSUB(j)  (1280 + 64 * (j))
#define XB_XGEN(j)  (2304 + 64 * (j))
#define XB_TOP      3328
#define XB_TOPGEN   3392
#define XCD_BAR_WORDS 3456
#define XB_SPIN_CAP (1u << 18)

__device__ __forceinline__ unsigned xb_ld(unsigned* p)              { return __hip_atomic_load(p, __ATOMIC_RELAXED, __HIP_MEMORY_SCOPE_AGENT); }
__device__ __forceinline__ unsigned xb_add(unsigned* p, unsigned v) { return __hip_atomic_fetch_add(p, v, __ATOMIC_RELAXED, __HIP_MEMORY_SCOPE_AGENT); }
__device__ __forceinline__ unsigned xb_xcc_id() { return (unsigned)__builtin_amdgcn_s_getreg((3 << 11) | 20) & 0xFu; }
#define XB_SPIN(cond, bar) do { unsigned _sp = 0; while (cond) { __builtin_amdgcn_s_sleep(1); \
    if ((++_sp & 255u) == 0u) { if (xb_ld(&(bar)[XB_TMO])) break; if (_sp > XB_SPIN_CAP) { atomicAdd(&(bar)[XB_TMO], 1u); break; } } } } while (0)

struct XcdBarrier {
    unsigned* bar; unsigned x;
    unsigned nloc, nx;
    unsigned rank;
};

__device__ __forceinline__ XcdBarrier xcd_barrier_post(unsigned* bar) {
    XcdBarrier b; b.bar = bar; b.x = xb_xcc_id(); b.nloc = 0u; b.nx = 0u;
    b.rank = 0u; if (threadIdx.x == 0) b.rank = xb_add(&bar[XB_XCNT(b.x)], 1u);
    return b;
}
__device__ __forceinline__ void xcd_barrier_complete(unsigned* bar, unsigned x, unsigned& nloc, unsigned& nx) {
    const unsigned G = gridDim.x * gridDim.y * gridDim.z;
    unsigned sum, cnt, mine, sp = 0u;
    for (;;) {
        sum = 0u; cnt = 0u; mine = 0u;
#pragma unroll
        for (unsigned j = 0; j < 16; ++j) { const unsigned c = xb_ld(&bar[XB_XCNT(j)]); sum += c; cnt += (c > 0u) ? 1u : 0u; mine = (j == x) ? c : mine; }
        if (sum == G) break;
        __builtin_amdgcn_s_sleep(1);
        if ((++sp & 255u) == 0u) { if (xb_ld(&bar[XB_TMO])) break; if (sp > XB_SPIN_CAP) { atomicAdd(&bar[XB_TMO], 1u); break; } }
    }
    nloc = mine > 0u ? mine : 1u; nx = cnt > 0u ? cnt : 1u;
}

__device__ __forceinline__ void xcd_barrier(XcdBarrier& b) {
    asm volatile("s_waitcnt vmcnt(0)" ::: "memory");
    __syncthreads();
    if (threadIdx.x == 0) {
        unsigned* bar = b.bar;
        __builtin_amdgcn_s_waitcnt(0);
        unsigned nloc = b.nloc, nx = b.nx;
        if (nloc == 0u) { xcd_barrier_complete(bar, b.x, nloc, nx); b.nloc = nloc; b.nx = nx; }
        const unsigned old = xb_add(&bar[XB_XSUB(b.x)], 1u);
        const unsigned gen = old / nloc;
        if (old + 1u == (gen + 1u) * nloc) {
            __builtin_amdgcn_fence(__ATOMIC_RELEASE, "agent");
            asm volatile("s_waitcnt vmcnt(0)" ::: "memory");
            const unsigned og = xb_add(&bar[XB_TOP], 1u);
            const unsigned tg = og / nx;
            if (og + 1u == (tg + 1u) * nx) xb_add(&bar[XB_TOPGEN], 1u);
            else XB_SPIN(xb_ld(&bar[XB_TOPGEN]) == tg, bar);
            __builtin_amdgcn_fence(__ATOMIC_ACQUIRE, "agent");
            xb_add(&bar[XB_XGEN(b.x)], 1u);
            asm volatile("s_waitcnt vmcnt(0)" ::: "memory");
        } else {
            XB_SPIN(xb_ld(&bar[XB_XGEN(b.x)]) == gen, bar);
            __builtin_amdgcn_fence(__ATOMIC_ACQUIRE, "agent");
            asm volatile("s_waitcnt vmcnt(0)" ::: "memory");
        }
    }
    __syncthreads();
}


#ifndef STAGGER_TICKS
#define STAGGER_TICKS 1000
#endif
__device__ __forceinline__ void stagger(int bx, unsigned ticks) {
    const unsigned frac = __brev((unsigned)bx) >> 24;
    const unsigned long long t0 = __builtin_amdgcn_s_memrealtime(), dt = (unsigned long long)ticks * frac / 256;
    while (__builtin_amdgcn_s_memrealtime() - t0 < dt) __builtin_amdgcn_s_sleep(8);
}

constexpr int N_PHASES = 11;
__global__ void __launch_bounds__(NWAVES * 64, 2) fwd_megakernel(Args args) {
    extern __shared__ __attribute__((aligned(16))) unsigned char lds_raw[];
    LAS unsigned char* lds = (LAS unsigned char*)lds_raw;
    cg::grid_group grid = cg::this_grid();
    const int tid = threadIdx.x, lane = tid & 63, wave = __builtin_amdgcn_readfirstlane(tid >> 6);
    const int G = gridDim.x, bx = blockIdx.x;
    const int vcu = (G % 8 == 0) ? (bx % 8) * (G / 8) + bx / 8 : bx;
    const int gw = vcu * NWAVES + wave, NGW = G * NWAVES;
    unsigned char* ws = args.ws;
    const int lo = args.ph_lo, hi = args.ph_hi;
    unsigned* barw = (unsigned*)ws;
    if (args.ph_hi < 0) grid.sync();
    XcdBarrier xbar = xcd_barrier_post(barw);
    int vbx = bx;
    if (G == 256) { if (tid == 0) *(volatile LAS unsigned*)lds = xbar.x + 8u * xbar.rank; __syncthreads(); const unsigned v_ = *(volatile LAS unsigned*)lds; __syncthreads(); if (v_ < 256u) vbx = (int)v_; }
#ifndef PHASE_MASK
#define PHASE_MASK 0x7ff
#endif
#define IN(k) (((PHASE_MASK >> (k)) & 1) && lo <= (k) && (k) < hi)
#define SEAM(k) do { if ((k) + 1 < hi) xcd_barrier(xbar); } while (0)
    using namespace pg8;
    if (IN(0)) { phase0(args, lds, gw, NGW, wave, lane);
        SEAM(0); }
    if (IN(1)) {
        Gemm g{(const bf16_t*)(ws + WS_H), (const bf16_t*)(ws + WS_WIN), DM}; Order S; S.init(256, 0, -1, INC / 256, G, vbx);
        p1_meta(args, gw, NGW, lane);
        EpiProj E{(bf16_t*)(ws + WS_PROJ), args.in[I_BGATES]};
        gemm_phase<EpiProj, Order>(lds, g, S, E); SEAM(1); }
    if (IN(2)) { phase2(args, lds, gw, NGW, wave, lane);
        SEAM(2); }
    if (IN(3)) {
        dft_tail(args, gw, NGW, lane);
        Gemm g{(const bf16_t*)((unsigned char*)args.out + DO_DM), (const bf16_t*)((unsigned char*)args.out + DO_UT), KD}; OrderDft S; S.init(G, vbx);
        EpiDft E{(bf16_t*)((unsigned char*)args.out + DO_S)};
        gemm_phase<EpiDft, OrderDft>(lds, g, S, E);
        xcd_barrier(xbar);
        dft_combine(args, gw, NGW, lane); SEAM(3); }
    if (IN(4)) {
        Gemm g{(const bf16_t*)(ws + WS_F), (const bf16_t*)(ws + WS_WEFF), DM}; Order S; S.init(256, 0, -1, DM / 256, G, vbx);
        p4_edge(args, gw, lane);
        EpiYa E{(bf16_t*)(ws + WS_MG), (const bf16_t*)(ws + WS_PROJ)};
        gemm_phase<EpiYa, Order>(lds, g, S, E); }
    if (IN(5)) {
        Gemm g{(const bf16_t*)(ws + WS_ZB), (const bf16_t*)(ws + WS_WCO), 512}; Order S; S.init(256, 0, -1, DM / 256, G, vbx);
        EpiYb E{(bf16_t*)(ws + WS_MG), (const bf16_t*)(ws + WS_PROJ)};
        gemm_phase<EpiYb, Order>(lds, g, S, E); SEAM(5); }
    if (IN(6)) {
        Gemm g{(const bf16_t*)(ws + WS_MG), (const bf16_t*)(ws + WS_WOUT), DM}; Order S; S.init(256, 0, -1, DM / 256, G, vbx);
        edge_gemm((const bf16*)(ws + WS_MG), (const bf16*)(ws + WS_WOUT), DM, (bf16*)(ws + WS_H), DM, EDGE_ROW0, NMETA, gw, NGW, lane);
        EpiStore E{(bf16_t*)(ws + WS_H), DM, 0, -1, 0};
        gemm_phase<EpiStore, Order>(lds, g, S, E); SEAM(6); }
    if (IN(7)) { phase6(args, gw, NGW, lane);
        SEAM(7); }
    if (IN(8)) {
        Gemm g{(const bf16_t*)(ws + WS_H2), (const bf16_t*)(ws + WS_WUP), DM}; OrderFfn S; S.init(NB * FFN_TPB, 0, -1, 2 * DFF / 256, G, vbx);
        EpiFfnD E{(bf16_t*)(ws + WS_ACT), args.in[I_CWFFN], args.in[I_CBFFN]};
#pragma unroll 1
        for (int i = 0; ; ++i) { OneUnit S1; if (!S.next(i, S1.u)) break; gemm_phase<EpiFfnD, OneUnit>(lds, g, S1, E); }
        SEAM(8); }
    if (IN(9)) {
        Gemm g{(const bf16_t*)(ws + WS_ACT), (const bf16_t*)(ws + WS_WDN), DFF}; Order S; S.init(256, 0, -1, DM / 256, G, vbx);
        EpiStore E{(bf16_t*)(ws + WS_MG), DM, 0, -1, 0};
        gemm_phase<EpiStore, Order>(lds, g, S, E); SEAM(9); }
    if (IN(10)) { phase10(args, gw, NGW, lane);
    }
#undef IN
#undef SEAM
}

extern "C" void kernel_launch(void* const* d_in, const int* in_sizes, int n_in, void* d_out, int out_size, void* d_ws, size_t ws_size, hipStream_t stream) {
    static int grid = 0;
    if (grid == 0) {
        if (n_in != 17 || ws_size < WS_NEED || out_size != NB * SEQ * DM) { fprintf(stderr, "kernel_launch: unexpected problem (n_in %d, ws %zu, out %d)\n", n_in, ws_size, out_size); grid = -1; return; }
        int dev = 0, cus = 0, per_cu = 0;
        if (hipGetDevice(&dev) != hipSuccess || hipDeviceGetAttribute(&cus, hipDeviceAttributeMultiprocessorCount, dev) != hipSuccess) { grid = -1; return; }
        if (hipFuncSetAttribute((const void*)fwd_megakernel, hipFuncAttributeMaxDynamicSharedMemorySize, LDS_BYTES) != hipSuccess) { fprintf(stderr, "kernel_launch: hipFuncSetAttribute failed\n"); grid = -1; return; }
        if (hipOccupancyMaxActiveBlocksPerMultiprocessor(&per_cu, (const void*)fwd_megakernel, NWAVES * 64, LDS_BYTES) != hipSuccess || per_cu < 1) { fprintf(stderr, "kernel_launch: occupancy query says %d\n", per_cu); per_cu = 1; }
        (void)hipGetLastError();
        grid = cus * 1;
    }
    if (grid < 0) return;
    if (hipMemsetAsync(d_ws, 0, 16384, stream) != hipSuccess) { fprintf(stderr, "kernel_launch: memset of the barrier words failed\n"); return; }
    Args a{};
    for (int i = 0; i < 17; ++i) a.in[i] = (const float*)d_in[i];
    a.out = (float*)d_out; a.ws = (unsigned char*)d_ws; a.ph_lo = 0; a.ph_hi = N_PHASES;
    void* kargs[] = {&a};
    hipError_t e = hipLaunchCooperativeKernel((const void*)fwd_megakernel, dim3(grid), dim3(NWAVES * 64), kargs, LDS_BYTES, stream);
    if (e != hipSuccess) fprintf(stderr, "kernel_launch: cooperative launch failed: %s (grid %d)\n", hipGetErrorString(e), grid);
}
```
